# Optimizing an MI355X kernel written in HIP

```python
import jax, jax.numpy as jnp
from jax import lax
import numpy as np


D_MODEL = 2048
BATCH = 4
SEQ = 4096
DEPTH = 4

CHUNK = 64
N_MIXERS = 2
N_POOL_LAYERS = (DEPTH + N_MIXERS - 1) // N_MIXERS
N_LRU_LAYERS = DEPTH // N_MIXERS
POOL_WINDOWS = (2, 4, 8, 16)
POOL_GROUPS = 4
POOL_GROUP_DIM = D_MODEL // POOL_GROUPS
LRU_WIDTH = D_MODEL
LRU_HEADS = 16
LRU_HEAD_DIM = LRU_WIDTH // LRU_HEADS
CONV_WIDTH = 4
LRU_C = 8.0
FFN_DIM = 256 * ((8 * D_MODEL // 3 + 255) // 256)
MEM_LEN = 256
XATTN_HEADS = 4
XATTN_HEAD_DIM = D_MODEL // XATTN_HEADS
MACARON_WEIGHT = 0.5
EPS = 1e-6

kernel_name = 'hybrid_pool_rglru_macaron_memxattn'


def rmsnorm(x, g):
    xf = x.astype(jnp.float32)
    y = xf * lax.rsqrt(jnp.mean(xf * xf, axis=-1, keepdims=True) + EPS)
    return (y * g.astype(jnp.float32)).astype(x.dtype)


def swiglu(u, w_gate, w_up, w_down):
    return (jax.nn.silu(u @ w_gate) * (u @ w_up)) @ w_down


def pool_mixer(u, w_group, scale):
    b, s, d = u.shape
    uf = u.astype(jnp.float32).reshape(b, s, POOL_GROUPS, POOL_GROUP_DIM)
    cs = jnp.concatenate([jnp.zeros((b, 1, POOL_GROUPS, POOL_GROUP_DIM), jnp.float32),
                          jnp.cumsum(uf, axis=1)], axis=1)
    pos = jnp.arange(1, s + 1, dtype=jnp.float32)[None, :, None]
    outs = []
    for g, w in enumerate(POOL_WINDOWS):
        c = cs[:, :, g]
        lower = jnp.concatenate([jnp.zeros((b, w - 1, POOL_GROUP_DIM), jnp.float32),
                                 c[:, :s + 1 - w]], axis=1)
        count = jnp.minimum(pos, float(w))
        outs.append((c[:, 1:] - lower) / count - uf[:, :, g])
    pooled = jnp.stack(outs, axis=2).astype(u.dtype)
    y = jnp.einsum('bsgi,gij->bsgj', pooled, w_group).reshape(b, s, d)
    return y * scale


def rglru_block(u, w_in, conv_w, conv_b, w_a, b_a, w_x, b_x, lam, w_out):
    b, s, _ = u.shape
    proj = u @ w_in
    gate, xr = proj[..., :LRU_WIDTH], proj[..., LRU_WIDTH:]
    xp = jnp.pad(xr, ((0, 0), (CONV_WIDTH - 1, 0), (0, 0)))
    xc = conv_b
    for k in range(CONV_WIDTH):
        xc = xc + xp[:, k:k + s] * conv_w[k]
    xh = xc.reshape(b, s, LRU_HEADS, LRU_HEAD_DIM)
    r = jax.nn.sigmoid((jnp.einsum('bshi,hij->bshj', xh, w_a).reshape(b, s, LRU_WIDTH) + b_a).astype(jnp.float32))
    ig = jax.nn.sigmoid((jnp.einsum('bshi,hij->bshj', xh, w_x).reshape(b, s, LRU_WIDTH) + b_x).astype(jnp.float32))
    log_a = -LRU_C * r * jax.nn.softplus(-lam.astype(jnp.float32))
    a = jnp.exp(log_a)
    bterm = jnp.sqrt(-jnp.expm1(2.0 * log_a)) * ig * xc.astype(jnp.float32)

    def combine(lhs, rhs):
        a1, b1 = lhs
        a2, b2 = rhs
        return a1 * a2, a2 * b1 + b2

    _, h = lax.associative_scan(combine, (a, bterm), axis=1)
    y = h.astype(u.dtype) * jax.nn.gelu(gate)
    return y @ w_out


def mem_cross_attention(u, m, w_q, w_k, w_v, w_o):
    b, s, d = u.shape
    ml = m.shape[1]
    q = (u @ w_q).reshape(b, s, XATTN_HEADS, XATTN_HEAD_DIM)
    k = (m @ w_k).reshape(b, ml, XATTN_HEADS, XATTN_HEAD_DIM)
    v = (m @ w_v).reshape(b, ml, XATTN_HEADS, XATTN_HEAD_DIM)
    scores = jnp.einsum('bshd,bmhd->bhsm', q, k).astype(jnp.float32) * (XATTN_HEAD_DIM ** -0.5)
    p = jax.nn.softmax(scores, axis=-1).astype(v.dtype)
    o = jnp.einsum('bhsm,bmhd->bshd', p, v).reshape(b, s, d)
    return o @ w_o


def setup_inputs(seed: int = 0) -> dict:
    key = jax.random.key(seed)
    ks = jax.random.split(key, 26)
    f32 = jnp.float32

    def nrm(k, shape, fan_in):
        return jax.random.normal(k, shape, f32) * (fan_in ** -0.5)

    def gain(k, shape):
        return 1.0 + 0.02 * jax.random.normal(k, shape, f32)

    a8 = jax.random.uniform(ks[16], (N_LRU_LAYERS, LRU_WIDTH), f32, 0.9, 0.999)
    s_lam = a8 ** (1.0 / LRU_C)
    lru_lambda = jnp.log(s_lam) - jnp.log1p(-s_lam)
    return {
        'x': jax.random.normal(ks[0], (BATCH, SEQ, D_MODEL), f32),
        'mem': jax.random.normal(ks[1], (BATCH, MEM_LEN, D_MODEL), f32),
        'ffn_norm': gain(ks[2], (DEPTH, 2, D_MODEL)),
        'w_ffn_gate': nrm(ks[3], (DEPTH, 2, D_MODEL, FFN_DIM), D_MODEL),
        'w_ffn_up': nrm(ks[4], (DEPTH, 2, D_MODEL, FFN_DIM), D_MODEL),
        'w_ffn_down': nrm(ks[5], (DEPTH, 2, FFN_DIM, D_MODEL), FFN_DIM),
        'mix_norm': gain(ks[6], (DEPTH, D_MODEL)),
        'pool_w': nrm(ks[7], (N_POOL_LAYERS, POOL_GROUPS, POOL_GROUP_DIM, POOL_GROUP_DIM), POOL_GROUP_DIM),
        'pool_scale': gain(ks[8], (N_POOL_LAYERS, D_MODEL)),
        'lru_w_in': nrm(ks[9], (N_LRU_LAYERS, D_MODEL, 2 * LRU_WIDTH), D_MODEL),
        'lru_conv_w': nrm(ks[10], (N_LRU_LAYERS, CONV_WIDTH, LRU_WIDTH), CONV_WIDTH),
        'lru_conv_b': 0.01 * jax.random.normal(ks[11], (N_LRU_LAYERS, LRU_WIDTH), f32),
        'lru_w_a': nrm(ks[12], (N_LRU_LAYERS, LRU_HEADS, LRU_HEAD_DIM, LRU_HEAD_DIM), LRU_HEAD_DIM),
        'lru_b_a': 0.01 * jax.random.normal(ks[13], (N_LRU_LAYERS, LRU_WIDTH), f32),
        'lru_w_x': nrm(ks[14], (N_LRU_LAYERS, LRU_HEADS, LRU_HEAD_DIM, LRU_HEAD_DIM), LRU_HEAD_DIM),
        'lru_b_x': 0.01 * jax.random.normal(ks[15], (N_LRU_LAYERS, LRU_WIDTH), f32),
        'lru_lambda': lru_lambda,
        'lru_w_out': nrm(ks[17], (N_LRU_LAYERS, LRU_WIDTH, D_MODEL), LRU_WIDTH),
        'xattn_norm': gain(ks[18], (DEPTH, D_MODEL)),
        'mem_norm': gain(ks[19], (D_MODEL,)),
        'w_q': nrm(ks[20], (DEPTH, D_MODEL, D_MODEL), D_MODEL),
        'w_k': nrm(ks[21], (DEPTH, D_MODEL, D_MODEL), D_MODEL),
        'w_v': nrm(ks[22], (DEPTH, D_MODEL, D_MODEL), D_MODEL),
        'w_o': nrm(ks[23], (DEPTH, D_MODEL, D_MODEL), D_MODEL),
        'final_norm': gain(ks[24], (D_MODEL,)),
    }


def reference(x, mem, ffn_norm, w_ffn_gate, w_ffn_up, w_ffn_down, mix_norm, pool_w, pool_scale,
              lru_w_in, lru_conv_w, lru_conv_b, lru_w_a, lru_b_a, lru_w_x, lru_b_x, lru_lambda,
              lru_w_out, xattn_norm, mem_norm, w_q, w_k, w_v, w_o, final_norm):
    m = rmsnorm(mem, mem_norm)
    h = x
    for i in range(DEPTH):
        h = h + MACARON_WEIGHT * swiglu(rmsnorm(h, ffn_norm[i, 0]), w_ffn_gate[i, 0], w_ffn_up[i, 0], w_ffn_down[i, 0])
        u = rmsnorm(h, mix_norm[i])
        j = i // N_MIXERS
        if i % N_MIXERS == 0:
            h = h + pool_mixer(u, pool_w[j], pool_scale[j])
        else:
            h = h + rglru_block(u, lru_w_in[j], lru_conv_w[j], lru_conv_b[j], lru_w_a[j], lru_b_a[j],
                                lru_w_x[j], lru_b_x[j], lru_lambda[j], lru_w_out[j])
        h = h + mem_cross_attention(rmsnorm(h, xattn_norm[i]), m, w_q[i], w_k[i], w_v[i], w_o[i])
        h = h + MACARON_WEIGHT * swiglu(rmsnorm(h, ffn_norm[i, 1]), w_ffn_gate[i, 1], w_ffn_up[i, 1], w_ffn_down[i, 1])
    return rmsnorm(h, final_norm)
```

```cpp
#include <hip/hip_runtime.h>
#include <cstdio>
#include <cstdint>

#ifndef MK_SINGLE
#define MK_SINGLE 1
#endif

#define LAS __attribute__((address_space(3)))
#define GAS __attribute__((address_space(1)))
typedef unsigned short bf16_t;
typedef short bf16x8 __attribute__((ext_vector_type(8)));
typedef float f32x4 __attribute__((ext_vector_type(4)));
typedef float f32x2 __attribute__((ext_vector_type(2)));
typedef unsigned u32x4 __attribute__((ext_vector_type(4)));
typedef unsigned u32x2 __attribute__((ext_vector_type(2)));
typedef GAS unsigned gu32;
#define LDS_WAIT() asm volatile("s_waitcnt lgkmcnt(0)" ::: "memory")
#define VM_WAIT() asm volatile("s_waitcnt vmcnt(0)" ::: "memory")

__device__ __forceinline__ unsigned cvt_pk_bf16(float lo, float hi) { unsigned r; asm volatile("v_cvt_pk_bf16_f32 %0, %1, %2" : "=v"(r) : "v"(lo), "v"(hi)); return r; }
__device__ __forceinline__ float wave_sum(float v) {
#pragma unroll
    for (int o = 1; o < 64; o <<= 1) v += __shfl_xor(v, o);
    return v;
}
__device__ __forceinline__ float fast_sigmoid(float x) { return __builtin_amdgcn_rcpf(1.0f + __builtin_amdgcn_exp2f(-1.44269504089f * x)); }

constexpr int BATCH = 4, SEQ = 4096, D = 2048, DEPTH = 4, FF = 5632, MEML = 256, NH = 4, HD = 512, LH = 16;
constexpr int M = BATCH * SEQ;
constexpr int MM = BATCH * MEML;
constexpr float EPS = 1e-6f;

namespace pg8 {
constexpr int BM = 256, BK = 64, HALF = 128, HTB = HALF * BK * 2, STAGE_BYTES = 8 * HTB, NXCD = 8, WGM = 8;
__host__ __device__ __forceinline__ int lds_byte(int r, int c) { const int st = (r >> 4) * 2 + (c >> 5), rr = r & 15, cc = c & 31, ob = rr * 64 + cc * 2; return st * 1024 + (ob ^ (((ob >> 9) & 1) << 5)); }
__host__ __device__ __forceinline__ void stage_rc(int b, int& R, int& C) { const int st = b / 1024, sb = b % 1024, swz = sb ^ (((sb >> 9) & 1) << 5); R = (st >> 1) * 16 + swz / 64; C = (st & 1) * 32 + (swz % 64) / 2; }
__host__ __device__ __forceinline__ int perm32(int rho) { const int n = rho >> 4, i = rho & 15; return 8 * (i >> 2) + 4 * n + (i & 3); }

struct Unit { int pm, pn; const char* a; const char* b; };

template <int MR, int NC, int K_, int LDA, int LDB, int APM, int APN, int ASH, int BPN, int BPM, int BSH>
struct Sched {
    static constexpr int K = K_, lda = LDA, ldb = LDB;
    const char* A; const char* B; int G, c;
    __device__ __forceinline__ bool next(int i, Unit& u) const {
        constexpr int nM = MR / BM, nN = NC / BM, nwg = nM * nN;
        const int L = i * G + c; if (L >= nwg) return false;
        int wgid = L; { constexpr int q = nwg / NXCD, r = nwg % NXCD; const int xcd = wgid % NXCD, off = wgid / NXCD; wgid = (xcd < r ? xcd * (q + 1) : r * (q + 1) + (xcd - r) * q) + off; }
        constexpr int nig = WGM * nN; const int gid = wgid / nig, fm = gid * WGM, gsz = (nM - fm) < WGM ? (nM - fm) : WGM;
        u.pm = fm + ((wgid % nig) % gsz); u.pn = (wgid % nig) / gsz;
        u.a = A + (size_t)u.pm * APM + (size_t)(u.pn >> ASH) * APN; u.b = B + (size_t)u.pn * BPN + (size_t)(u.pm >> BSH) * BPM; return true;
    }
};

__device__ __forceinline__ float row_rstd(const float* part, int row, int fq) {
    const f32x4* p = (const f32x4*)(part + (size_t)row * 32 + fq * 8);
    const f32x4 a = p[0], b = p[1];
    float s = ((a.x + a.y) + (a.z + a.w)) + ((b.x + b.y) + (b.z + b.w));
    s += __shfl_xor(s, 16); s += __shfl_xor(s, 32);
    return rsqrtf(s * (1.0f / 2048.0f) + EPS);
}

struct EpiSwiGLU {
    static constexpr bool PERM = true, AFTER_DRAIN = false;
    bf16_t* O; const float* part;
    __device__ __forceinline__ void operator()(const f32x4 (&acc)[2][2][4][2], const Unit& u, int wr, int wc, int fr, int fq) const {
        const int row0 = u.pm * BM + wr * 64 + fr, col0 = u.pn * HALF + wc * 32 + 8 * fq;
#pragma unroll
        for (int ai = 0; ai < 2; ++ai)
#pragma unroll
            for (int m = 0; m < 4; ++m) { const int row = row0 + ai * HALF + m * 16; const float rs = row_rstd(part, row, fq);
                float o[8];
#pragma unroll
                for (int n = 0; n < 2; ++n)
#pragma unroll
                    for (int j = 0; j < 4; ++j) { const float g = acc[ai][0][m][n][j] * rs, up = acc[ai][1][m][n][j] * rs; o[n * 4 + j] = g * fast_sigmoid(g) * up; }
                u32x4 w; w.x = cvt_pk_bf16(o[0], o[1]); w.y = cvt_pk_bf16(o[2], o[3]); w.z = cvt_pk_bf16(o[4], o[5]); w.w = cvt_pk_bf16(o[6], o[7]);
                *(u32x4*)(O + (size_t)row * FF + col0) = w; }
    }
};
struct EpiResid {
    static constexpr bool PERM = true, AFTER_DRAIN = false;
    float* h; bf16_t* hb; float* part; float alpha;
    __device__ __forceinline__ void operator()(const f32x4 (&acc)[2][2][4][2], const Unit& u, int wr, int wc, int fr, int fq) const {
        const int row0 = u.pm * BM + wr * 64 + fr, col0 = u.pn * BM + wc * 32 + 8 * fq;
#pragma unroll
        for (int ai = 0; ai < 2; ++ai)
#pragma unroll
            for (int m = 0; m < 4; ++m) { const int row = row0 + ai * HALF + m * 16; float* hp = h + (size_t)row * D + col0; bf16_t* bp = hb + (size_t)row * D + col0; float ss = 0.f;
#pragma unroll
                for (int bj = 0; bj < 2; ++bj) { f32x4 x0 = *(const f32x4*)(hp + bj * HALF), x1 = *(const f32x4*)(hp + bj * HALF + 4);
                    x0 = x0 + acc[ai][bj][m][0] * alpha; x1 = x1 + acc[ai][bj][m][1] * alpha;
                    *(f32x4*)(hp + bj * HALF) = x0; *(f32x4*)(hp + bj * HALF + 4) = x1;
                    u32x4 w; w.x = cvt_pk_bf16(x0[0], x0[1]); w.y = cvt_pk_bf16(x0[2], x0[3]); w.z = cvt_pk_bf16(x1[0], x1[1]); w.w = cvt_pk_bf16(x1[2], x1[3]);
                    *(u32x4*)(bp + bj * HALF) = w;
                    ss += ((x0[0] * x0[0] + x0[1] * x0[1]) + (x0[2] * x0[2] + x0[3] * x0[3])) + ((x1[0] * x1[0] + x1[1] * x1[1]) + (x1[2] * x1[2] + x1[3] * x1[3])); }
                ss += __shfl_xor(ss, 16); ss += __shfl_xor(ss, 32);
                if (fq == 0) part[(size_t)row * 32 + u.pn * 4 + wc] = ss;
                if (m & 1) asm volatile("" ::: "memory"); }
    }
};
struct EpiRowScale {
    static constexpr bool PERM = true, AFTER_DRAIN = false;
    bf16_t* O; int ldo; const float* part;
    __device__ __forceinline__ void operator()(const f32x4 (&acc)[2][2][4][2], const Unit& u, int wr, int wc, int fr, int fq) const {
        const int row0 = u.pm * BM + wr * 64 + fr, col0 = u.pn * BM + wc * 32 + 8 * fq;
#pragma unroll
        for (int ai = 0; ai < 2; ++ai)
#pragma unroll
            for (int m = 0; m < 4; ++m) { const int row = row0 + ai * HALF + m * 16; const float rs = row_rstd(part, row, fq); bf16_t* rp = O + (size_t)row * ldo + col0;
#pragma unroll
                for (int bj = 0; bj < 2; ++bj) { const f32x4 v0 = acc[ai][bj][m][0] * rs, v1 = acc[ai][bj][m][1] * rs;
                    u32x4 w; w.x = cvt_pk_bf16(v0[0], v0[1]); w.y = cvt_pk_bf16(v0[2], v0[3]); w.z = cvt_pk_bf16(v1[0], v1[1]); w.w = cvt_pk_bf16(v1[2], v1[3]);
                    *(u32x4*)(rp + bj * HALF) = w; } }
    }
};
struct EpiPlain {
    static constexpr bool PERM = true, AFTER_DRAIN = false;
    bf16_t* O; int ldo;
    __device__ __forceinline__ void operator()(const f32x4 (&acc)[2][2][4][2], const Unit& u, int wr, int wc, int fr, int fq) const {
        const int row0 = u.pm * BM + wr * 64 + fr, col0 = u.pn * BM + wc * 32 + 8 * fq;
#pragma unroll
        for (int ai = 0; ai < 2; ++ai)
#pragma unroll
            for (int m = 0; m < 4; ++m) { bf16_t* rp = O + (size_t)(row0 + ai * HALF + m * 16) * ldo + col0;
#pragma unroll
                for (int bj = 0; bj < 2; ++bj) { const f32x4 v0 = acc[ai][bj][m][0], v1 = acc[ai][bj][m][1];
                    u32x4 w; w.x = cvt_pk_bf16(v0[0], v0[1]); w.y = cvt_pk_bf16(v0[2], v0[3]); w.z = cvt_pk_bf16(v1[0], v1[1]); w.w = cvt_pk_bf16(v1[2], v1[3]);
                    *(u32x4*)(rp + bj * HALF) = w; } }
    }
};
struct EpiLruIn {
    static constexpr bool PERM = true, AFTER_DRAIN = false;
    bf16_t* gg; float* xr; const float* part;
    __device__ __forceinline__ void operator()(const f32x4 (&acc)[2][2][4][2], const Unit& u, int wr, int wc, int fr, int fq) const {
        const int row0 = u.pm * BM + wr * 64 + fr; const bool isg = u.pn < 8; const int col0 = (isg ? u.pn : u.pn - 8) * BM + wc * 32 + 8 * fq;
#pragma unroll
        for (int ai = 0; ai < 2; ++ai)
#pragma unroll
            for (int m = 0; m < 4; ++m) { const int row = row0 + ai * HALF + m * 16; const float rs = row_rstd(part, row, fq);
#pragma unroll
                for (int bj = 0; bj < 2; ++bj) { const f32x4 v0 = acc[ai][bj][m][0] * rs, v1 = acc[ai][bj][m][1] * rs;
                    if (isg) { float o[8];
#pragma unroll
                        for (int j = 0; j < 8; ++j) { const float x = j < 4 ? v0[j] : v1[j - 4]; o[j] = x * fast_sigmoid(1.5957691216f * (x + 0.044715f * x * x * x)); }
                        u32x4 w; w.x = cvt_pk_bf16(o[0], o[1]); w.y = cvt_pk_bf16(o[2], o[3]); w.z = cvt_pk_bf16(o[4], o[5]); w.w = cvt_pk_bf16(o[6], o[7]);
                        *(u32x4*)(gg + (size_t)row * D + col0 + bj * HALF) = w; }
                    else { float* xp = xr + (size_t)row * D + col0 + bj * HALF; *(f32x4*)xp = v0; *(f32x4*)(xp + 4) = v1; } } }
    }
};
struct EpiGates {
    static constexpr bool PERM = true, AFTER_DRAIN = false;
    float* A; float* Bt; const float* xc; const float* ba; const float* bx; const float* sp8;
    __device__ __forceinline__ void operator()(const f32x4 (&acc)[2][2][4][2], const Unit& u, int wr, int wc, int fr, int fq) const {
        const int row0 = u.pm * BM + wr * 64 + fr, c0 = u.pn * HALF + wc * 32 + 8 * fq;
        f32x4 bav[2], bxv[2], spv[2];
#pragma unroll
        for (int n = 0; n < 2; ++n) { bav[n] = *(const f32x4*)(ba + c0 + 4 * n); bxv[n] = *(const f32x4*)(bx + c0 + 4 * n); spv[n] = *(const f32x4*)(sp8 + c0 + 4 * n); }
#pragma unroll
        for (int ai = 0; ai < 2; ++ai)
#pragma unroll
            for (int m = 0; m < 4; ++m) { const int row = row0 + ai * HALF + m * 16; const float* xp = xc + (size_t)row * D + c0;
#pragma unroll
                for (int n = 0; n < 2; ++n) { const f32x4 xv = *(const f32x4*)(xp + 4 * n); f32x4 av, bv;
#pragma unroll
                    for (int j = 0; j < 4; ++j) { const float r = fast_sigmoid(acc[ai][0][m][n][j] + bav[n][j]), ig = fast_sigmoid(acc[ai][1][m][n][j] + bxv[n][j]);
                        const float la = -r * spv[n][j], t = 2.0f * la;
                        const float a = __builtin_amdgcn_exp2f(1.44269504089f * la);
                        const float ser = -t * (1.0f + 0.5f * t * (1.0f + (1.0f / 3.0f) * t * (1.0f + 0.25f * t * (1.0f + 0.2f * t * (1.0f + (1.0f / 6.0f) * t)))));
                        const float om = t > -0.3f ? ser : 1.0f - __builtin_amdgcn_exp2f(1.44269504089f * t);
                        av[j] = a; bv[j] = sqrtf(om) * ig * xv[j]; }
                    *(f32x4*)(A + (size_t)row * D + c0 + 4 * n) = av; *(f32x4*)(Bt + (size_t)row * D + c0 + 4 * n) = bv; }
                if (m & 1) asm volatile("" ::: "memory"); }
    }
};
struct EpiSoftmax {
    static constexpr bool PERM = true, AFTER_DRAIN = true;
    bf16_t* P;
    __device__ __forceinline__ void fused(f32x4 (&acc)[2][2][4][2], const Unit& u, int wr, int wc, int fr, int fq, LAS unsigned char* lds, int wid, int lane) const {
        LAS float* X = (LAS float*)lds; LAS float* Y = (LAS float*)(lds + 4096);
#pragma unroll
        for (int ai = 0; ai < 2; ++ai)
#pragma unroll
            for (int m = 0; m < 4; ++m) { float mx = -3.0e38f;
#pragma unroll
                for (int bj = 0; bj < 2; ++bj)
#pragma unroll
                    for (int n = 0; n < 2; ++n) { const f32x4 x = acc[ai][bj][m][n]; mx = fmaxf(mx, fmaxf(fmaxf(x[0], x[1]), fmaxf(x[2], x[3]))); }
                mx = fmaxf(mx, __shfl_xor(mx, 16)); mx = fmaxf(mx, __shfl_xor(mx, 32));
                if (fq == 0) X[(ai * HALF + wr * 64 + m * 16 + fr) * 4 + wc] = mx; }
        LDS_WAIT(); __builtin_amdgcn_s_barrier(); asm volatile("" ::: "memory");
#pragma unroll
        for (int ai = 0; ai < 2; ++ai)
#pragma unroll
            for (int m = 0; m < 4; ++m) { const int r = ai * HALF + wr * 64 + m * 16 + fr; const f32x4 v = *(const LAS f32x4*)(X + r * 4);
                const float mx = fmaxf(fmaxf(v[0], v[1]), fmaxf(v[2], v[3])) * 1.44269504089f; float s = 0.f;
#pragma unroll
                for (int bj = 0; bj < 2; ++bj)
#pragma unroll
                    for (int n = 0; n < 2; ++n)
#pragma unroll
                        for (int j = 0; j < 4; ++j) { const float p = __builtin_amdgcn_exp2f(acc[ai][bj][m][n][j] * 1.44269504089f - mx); acc[ai][bj][m][n][j] = p; s += p; }
                s += __shfl_xor(s, 16); s += __shfl_xor(s, 32);
                if (fq == 0) Y[r * 4 + wc] = s; }
        LDS_WAIT(); __builtin_amdgcn_s_barrier(); asm volatile("" ::: "memory");
#pragma unroll
        for (int ai = 0; ai < 2; ++ai)
#pragma unroll
            for (int m = 0; m < 4; ++m) { const int r = ai * HALF + wr * 64 + m * 16 + fr; const f32x4 v = *(const LAS f32x4*)(Y + r * 4);
                const float inv = 1.0f / ((v[0] + v[1]) + (v[2] + v[3])); bf16_t* rp = P + (size_t)(u.pm * BM + r) * 1024 + u.pn * BM + wc * 32 + 8 * fq;
#pragma unroll
                for (int bj = 0; bj < 2; ++bj) { const f32x4 v0 = acc[ai][bj][m][0] * inv, v1 = acc[ai][bj][m][1] * inv;
                    u32x4 w; w.x = cvt_pk_bf16(v0[0], v0[1]); w.y = cvt_pk_bf16(v0[2], v0[3]); w.z = cvt_pk_bf16(v1[0], v1[1]); w.w = cvt_pk_bf16(v1[2], v1[3]);
                    *(u32x4*)(rp + bj * HALF) = w; } }
    }
};

template <class Epi, bool ALIGN_EPI, class SchedT>
__device__ __forceinline__ void gemm_phase(LAS unsigned char* lds, const SchedT& S, const Epi& E) {
    int tid_ = threadIdx.x; asm volatile("" : "+v"(tid_));
    const int tid = tid_, wid = __builtin_amdgcn_readfirstlane(tid >> 6), lane = tid & 63, wr = wid >> 2, wc = wid & 3, fr = lane & 15, fq = lane >> 4;
    constexpr int K = SchedT::K, nt = K / BK;
    static_assert(K % 128 == 0 && K >= 256, "K multiple of 128, >= 256");
    unsigned voffA[2], voffB[2];
#pragma unroll
    for (int i = 0; i < 2; ++i) { int R, C; stage_rc(tid * 16 + i * 8192, R, C); const int Rb = Epi::PERM ? ((R & ~31) + perm32(R & 31)) : R;
        voffA[i] = (unsigned)(R * SchedT::lda + C) * 2u; voffB[i] = (unsigned)(Rb * SchedT::ldb + C) * 2u; }
    constexpr size_t kstep = (size_t)(BK * 2);
    constexpr size_t hstepA = (size_t)HALF * SchedT::lda * 2, hstepB = (size_t)HALF * SchedT::ldb * 2;
    const unsigned ldsw = (unsigned)wid * 1024u;
    const int aoff = lds_byte(wr * 64 + fr, fq * 8), boff = lds_byte(wc * 32 + fr, fq * 8);
#define PG8_SA(b, h) (((b) * 2 + (h)) * HTB)
#define PG8_SB(b, h) ((4 + (b) * 2 + (h)) * HTB)
#define PG8_STAGE(bufoff, gbase, voff) do { _Pragma("unroll") for (int _i = 0; _i < 2; ++_i) \
        __builtin_amdgcn_global_load_lds((const unsigned*)((const char*)(gbase) + (voff)[_i]), (LAS unsigned*)(lds + (bufoff) + ldsw + _i * 8192), 16, 0, 0); } while (0)
#define PG8_LDA(dst, b, h) do { _Pragma("unroll") for (int m = 0; m < 4; ++m) _Pragma("unroll") for (int k = 0; k < 2; ++k) dst[m][k] = *(const LAS bf16x8*)(lds + PG8_SA(b, h) + aoff + m * 2048 + k * 1024); } while (0)
#define PG8_LDB(dst, b, h) do { _Pragma("unroll") for (int n = 0; n < 2; ++n) _Pragma("unroll") for (int k = 0; k < 2; ++k) dst[n][k] = *(const LAS bf16x8*)(lds + PG8_SB(b, h) + boff + n * 2048 + k * 1024); } while (0)
#define PG8_MMA(ai, bj, At, Bt) do { __builtin_amdgcn_s_setprio(1); _Pragma("unroll") for (int m = 0; m < 4; ++m) _Pragma("unroll") for (int n = 0; n < 2; ++n) _Pragma("unroll") for (int k = 0; k < 2; ++k) \
        acc[ai][bj][m][n] = __builtin_amdgcn_mfma_f32_16x16x32_bf16(Bt[n][k], At[m][k], acc[ai][bj][m][n], 0, 0, 0); __builtin_amdgcn_s_setprio(0); } while (0)
#define PG8_WAIT_V(n) asm volatile("s_waitcnt vmcnt(" #n ")" ::: "memory")
#define PG8_WAIT_L(n) asm volatile("s_waitcnt lgkmcnt(" #n ")" ::: "memory")
#define PG8_BAR __builtin_amdgcn_s_barrier()
#define PG8_SCHED __builtin_amdgcn_sched_barrier(0)
    Unit cur, nxt; int ui = 0;
    if (!S.next(0, cur)) return;
    f32x4 acc[2][2][4][2];
#pragma unroll
    for (int a = 0; a < 2; ++a)
#pragma unroll
        for (int b = 0; b < 2; ++b)
#pragma unroll
            for (int m = 0; m < 4; ++m)
#pragma unroll
                for (int n = 0; n < 2; ++n) acc[a][b][m][n] = (f32x4){0.f, 0.f, 0.f, 0.f};
    bf16x8 At[4][2], B0[2][2], B1[2][2];
    const char* cA = cur.a; const char* cB = cur.b;
    PG8_STAGE(PG8_SB(0, 0), cB, voffB); PG8_STAGE(PG8_SB(0, 1), cB + hstepB, voffB); PG8_STAGE(PG8_SA(0, 0), cA, voffA); PG8_STAGE(PG8_SA(0, 1), cA + hstepA, voffA);
    if (wr == 1) PG8_BAR;
    PG8_WAIT_V(2); PG8_BAR;
    PG8_STAGE(PG8_SB(1, 0), cB + kstep, voffB); PG8_STAGE(PG8_SA(1, 0), cA + kstep, voffA); PG8_STAGE(PG8_SB(1, 1), cB + hstepB + kstep, voffB);
    PG8_WAIT_V(6); PG8_BAR;
    for (;;) {
        const bool has_next = S.next(ui + 1, nxt);
        const char* nA = has_next ? nxt.a : cA; const char* nB = has_next ? nxt.b : cB;
#pragma unroll 1
        for (int t = 0; t < nt; t += 2) {
            const bool last = (t == nt - 2);
            const char* a1 = cA + (size_t)(t + 1) * kstep;
            const char* a2 = last ? nA : cA + (size_t)(t + 2) * kstep; const char* b2 = last ? nB : cB + (size_t)(t + 2) * kstep;
            const char* a3 = a2 + kstep; const char* b3 = b2 + kstep;
            PG8_LDB(B0, 0, 0); PG8_LDB(B1, 0, 1); PG8_SCHED; PG8_LDA(At, 0, 0); PG8_STAGE(PG8_SA(1, 1), a1 + hstepA, voffA);
            PG8_WAIT_V(8); PG8_WAIT_L(0); PG8_BAR; PG8_MMA(0, 0, At, B0); PG8_MMA(0, 1, At, B1); PG8_BAR; PG8_SCHED;
            PG8_LDA(At, 0, 1); PG8_STAGE(PG8_SB(0, 0), b2, voffB); PG8_STAGE(PG8_SB(0, 1), b2 + hstepB, voffB); PG8_STAGE(PG8_SA(0, 0), a2, voffA);
            PG8_WAIT_V(8); PG8_WAIT_L(0); PG8_BAR; PG8_MMA(1, 0, At, B0); PG8_MMA(1, 1, At, B1); PG8_BAR; PG8_SCHED;
            PG8_LDB(B0, 1, 0); PG8_LDB(B1, 1, 1); PG8_SCHED; PG8_LDA(At, 1, 0); PG8_STAGE(PG8_SA(0, 1), a2 + hstepA, voffA);
            PG8_WAIT_V(8); PG8_WAIT_L(0); PG8_BAR; PG8_MMA(0, 0, At, B0); PG8_MMA(0, 1, At, B1); PG8_BAR; PG8_SCHED;
            PG8_LDA(At, 1, 1); PG8_STAGE(PG8_SB(1, 0), b3, voffB); PG8_STAGE(PG8_SB(1, 1), b3 + hstepB, voffB); PG8_STAGE(PG8_SA(1, 0), a3, voffA);
            PG8_WAIT_V(8); PG8_WAIT_L(0); PG8_BAR; PG8_MMA(1, 0, At, B0); PG8_MMA(1, 1, At, B1); PG8_BAR; PG8_SCHED;
        }
        if constexpr (ALIGN_EPI) { if (wr == 0) PG8_BAR; }
        if constexpr (!Epi::AFTER_DRAIN) { E(acc, cur, wr, wc, fr, fq); }
        if (!has_next) break;
#pragma unroll
        for (int a = 0; a < 2; ++a)
#pragma unroll
            for (int b = 0; b < 2; ++b)
#pragma unroll
                for (int m = 0; m < 4; ++m)
#pragma unroll
                    for (int n = 0; n < 2; ++n) acc[a][b][m][n] = (f32x4){0.f, 0.f, 0.f, 0.f};
        cur = nxt; cA = nA; cB = nB; ++ui;
        if constexpr (ALIGN_EPI) { if (wr == 1) PG8_BAR; }
    }
    PG8_WAIT_V(0);
    if constexpr (!ALIGN_EPI) { if (wr == 0) PG8_BAR; }
    PG8_BAR;
    if constexpr (Epi::AFTER_DRAIN) { E.fused(acc, cur, wr, wc, fr, fq, lds, wid, lane); }
#undef PG8_SA
#undef PG8_SB
#undef PG8_STAGE
#undef PG8_LDA
#undef PG8_LDB
#undef PG8_MMA
#undef PG8_WAIT_V
#undef PG8_WAIT_L
#undef PG8_BAR
#undef PG8_SCHED
}
}

constexpr size_t MiB = 1u << 20;
constexpr size_t WS_CTL = 0, CTL_ZERO_BYTES = 1 * MiB;
constexpr size_t WS_SP = 1 * MiB;
constexpr size_t WS_CHA = 2 * MiB, WS_CHB = 4 * MiB;
constexpr size_t WS_PART = 6 * MiB;
constexpr size_t WS_MB = 8 * MiB;
constexpr size_t WS_KALL = 12 * MiB;
constexpr size_t WS_VTALL = 28 * MiB;
constexpr size_t WS_WGU = 48 * MiB;
constexpr size_t WS_WD = 400 * MiB;
constexpr size_t WS_WQ = 576 * MiB, WS_WK = 608 * MiB, WS_WV = 640 * MiB, WS_WO = 672 * MiB;
constexpr size_t WS_WIN = 704 * MiB;
constexpr size_t WS_WOUT = 736 * MiB;
constexpr size_t WS_WP = 752 * MiB;
constexpr size_t WS_WGATE = 756 * MiB;
constexpr size_t WS_HB = 760 * MiB;
constexpr size_t WS_ACT = 824 * MiB;
constexpr size_t WS_S = 1000 * MiB;
constexpr size_t WS_Q = WS_S, WS_P = WS_S + 64 * MiB, WS_O = WS_S + 96 * MiB;
constexpr size_t WS_POOLED = WS_S;
constexpr size_t WS_GG = WS_S, WS_XC32 = WS_S + 64 * MiB, WS_BT = WS_S + 192 * MiB, WS_XCB = WS_S + 320 * MiB;
constexpr size_t WS_XR = WS_ACT;
constexpr size_t WS_END = WS_S + 384 * MiB;
constexpr int CW_BAR = 4096;
constexpr int LDS_BYTES = 147456, MISC_OFF = LDS_BYTES - 512;

#define XB_TMO      128
#define XB_XCNT(j)  (256  + 64 * (j))
#define XB_XSUB(j)  (1280 + 64 * (j))
#define XB_XGEN(j)  (2304 + 64 * (j))
#define XB_TOP      3328
#define XB_TOPGEN   3392
#define XCD_BAR_WORDS 3456
#define XB_SPIN_CAP (1u << 18)
__device__ __forceinline__ unsigned xb_ld(unsigned* p)              { return __hip_atomic_load(p, __ATOMIC_RELAXED, __HIP_MEMORY_SCOPE_AGENT); }
__device__ __forceinline__ unsigned xb_add(unsigned* p, unsigned v) { return __hip_atomic_fetch_add(p, v, __ATOMIC_RELAXED, __HIP_MEMORY_SCOPE_AGENT); }
__device__ __forceinline__ unsigned xb_xcc_id() { return (unsigned)__builtin_amdgcn_s_getreg((3 << 11) | 20) & 0xFu; }
#define XB_SPIN(cond, bar) do { unsigned _sp = 0; while (cond) { __builtin_amdgcn_s_sleep(1); \
    if ((++_sp & 255u) == 0u) { if (xb_ld(&(bar)[XB_TMO])) break; if (_sp > XB_SPIN_CAP) { atomicAdd(&(bar)[XB_TMO], 1u); break; } } } } while (0)
struct XcdBarrier { unsigned* bar; unsigned x; volatile LAS unsigned* st; };
__device__ __forceinline__ XcdBarrier xcd_barrier_post(unsigned* bar, volatile LAS unsigned* st) {
    XcdBarrier b; b.bar = bar; b.x = xb_xcc_id(); b.st = st;
    if (threadIdx.x == 0) (void)xb_add(&bar[XB_XCNT(b.x)], 1u);
    return b;
}
__device__ __forceinline__ void xcd_barrier_complete(unsigned* bar, unsigned x, unsigned& nloc, unsigned& nx) {
    const unsigned G = gridDim.x * gridDim.y * gridDim.z;
    unsigned sum, cnt, mine, sp = 0u;
    for (;;) {
        sum = 0u; cnt = 0u; mine = 0u;
#pragma unroll
        for (unsigned j = 0; j < 16; ++j) { const unsigned c = xb_ld(&bar[XB_XCNT(j)]); sum += c; cnt += (c > 0u) ? 1u : 0u; mine = (j == x) ? c : mine; }
        if (sum == G) break;
        __builtin_amdgcn_s_sleep(1);
        if ((++sp & 255u) == 0u) { if (xb_ld(&bar[XB_TMO])) break; if (sp > XB_SPIN_CAP) { atomicAdd(&bar[XB_TMO], 1u); break; } }
    }
    nloc = mine > 0u ? mine : 1u; nx = cnt > 0u ? cnt : 1u;
}
__device__ __forceinline__ void xcd_barrier(const XcdBarrier& b) {
    asm volatile("s_waitcnt vmcnt(0)" ::: "memory");
    __syncthreads();
    if (threadIdx.x == 0) {
        unsigned* bar = b.bar;
        __builtin_amdgcn_s_waitcnt(0);
        unsigned nloc = b.st[0], nx = b.st[1];
        if (nloc == 0u) { xcd_barrier_complete(bar, b.x, nloc, nx); b.st[0] = nloc; b.st[1] = nx; }
        const unsigned old = xb_add(&bar[XB_XSUB(b.x)], 1u);
        const unsigned gen = old / nloc;
        if (old + 1u == (gen + 1u) * nloc) {
            __builtin_amdgcn_fence(__ATOMIC_RELEASE, "agent");
            asm volatile("s_waitcnt vmcnt(0)" ::: "memory");
            const unsigned og = xb_add(&bar[XB_TOP], 1u);
            const unsigned tg = og / nx;
            if (og + 1u == (tg + 1u) * nx) xb_add(&bar[XB_TOPGEN], 1u);
            else XB_SPIN(xb_ld(&bar[XB_TOPGEN]) == tg, bar);
            __builtin_amdgcn_fence(__ATOMIC_ACQUIRE, "agent");
            xb_add(&bar[XB_XGEN(b.x)], 1u);
            asm volatile("s_waitcnt vmcnt(0)" ::: "memory");
        } else {
            XB_SPIN(xb_ld(&bar[XB_XGEN(b.x)]) == gen, bar);
            __builtin_amdgcn_fence(__ATOMIC_ACQUIRE, "agent");
            asm volatile("s_waitcnt vmcnt(0)" ::: "memory");
        }
    }
    __syncthreads();
}

__device__ __forceinline__ void tr_item(const float* src, int ldw, bf16_t* dst, int ldd, const float* ks, const float* ns, float sc, bf16_t* dstz, LAS float* scr, int lane) {
    f32x4 v[16];
    const float* s0 = src + (size_t)(lane >> 4) * ldw + (lane & 15) * 4;
#pragma unroll
    for (int i = 0; i < 16; ++i) v[i] = *(const f32x4*)(s0 + (size_t)(4 * i) * ldw);
#pragma unroll
    for (int i = 0; i < 16; ++i) { LAS float* p = scr + ((lane >> 4) + 4 * i) * 65 + (lane & 15) * 4; p[0] = v[i][0]; p[1] = v[i][1]; p[2] = v[i][2]; p[3] = v[i][3]; }
    LDS_WAIT(); asm volatile("" ::: "memory");
    const int c = lane & 7;
    f32x4 k0v = (f32x4){sc, sc, sc, sc}, k1v = k0v;
    if (ks) { k0v = *(const f32x4*)(ks + 8 * c) * sc; k1v = *(const f32x4*)(ks + 8 * c + 4) * sc; }
#pragma unroll
    for (int j = 0; j < 8; ++j) { const int n = (lane >> 3) + 8 * j; const LAS float* s = scr + (8 * c) * 65 + n; const float nsv = ns ? ns[n] : 1.0f;
        u32x4 o; o.x = cvt_pk_bf16(s[0 * 65] * k0v[0] * nsv, s[1 * 65] * k0v[1] * nsv); o.y = cvt_pk_bf16(s[2 * 65] * k0v[2] * nsv, s[3 * 65] * k0v[3] * nsv);
        o.z = cvt_pk_bf16(s[4 * 65] * k1v[0] * nsv, s[5 * 65] * k1v[1] * nsv); o.w = cvt_pk_bf16(s[6 * 65] * k1v[2] * nsv, s[7 * 65] * k1v[3] * nsv);
        *(u32x4*)(dst + (size_t)n * ldd + 8 * c) = o;
        if (dstz) *(u32x4*)(dstz + (size_t)n * ldd + 8 * c) = (u32x4){0u, 0u, 0u, 0u}; }
    LDS_WAIT(); asm volatile("" ::: "memory");
}

struct Args { const float* in[25]; float* out; unsigned char* ws; int step, phase; };

__device__ __forceinline__ void prologue(const Args& args, LAS unsigned char* lds, int lane, int wave, int bx, int G) {
    unsigned char* ws = args.ws;
    LAS float* scr = (LAS float*)(lds + wave * 16640);
    const int gw = bx * 8 + wave, NGW = G * 8;
    constexpr int I_GU = 32 * 88, N_GU = 16 * I_GU, I_D = 88 * 32, N_D = 8 * I_D, I_SQ = 32 * 32, N_SQ = 16 * I_SQ, I_IN = 32 * 64, N_IN = 2 * I_IN, I_OUT = 32 * 32, N_OUT = 2 * I_OUT,
                  I_P = 8 * 8, N_P = 8 * I_P, I_G = 4, N_G = 64 * I_G, NITEMS = N_GU + N_D + N_SQ + N_IN + N_OUT + N_P + N_G;
    for (int it = gw; it < NITEMS; it += NGW) {
        int r = it; const float* src; int ldw; bf16_t* dst; int ldd; const float* ks = nullptr; const float* ns = nullptr; float sc = 1.0f; bf16_t* dstz = nullptr;
        if (r < N_GU) { const int mat = r / I_GU, item = r % I_GU, lw = mat >> 1, up = mat & 1, k0 = (item / 88) * 64, n0 = (item % 88) * 64;
            src = (up ? args.in[4] : args.in[3]) + (size_t)lw * D * FF + (size_t)k0 * FF + n0; ldw = FF;
            dst = (bf16_t*)(ws + WS_WGU) + (size_t)lw * (2 * FF) * D + (size_t)(256 * (n0 >> 7) + (n0 & 127) + up * 128) * D + k0; ldd = D; ks = args.in[2] + lw * D + k0; }
        else if ((r -= N_GU) < N_D) { const int lw = r / I_D, item = r % I_D, k0 = (item / 32) * 64, n0 = (item % 32) * 64;
            src = args.in[5] + (size_t)lw * FF * D + (size_t)k0 * D + n0; ldw = D; dst = (bf16_t*)(ws + WS_WD) + (size_t)lw * D * FF + (size_t)n0 * FF + k0; ldd = FF; }
        else if ((r -= N_D) < N_SQ) { const int mat = r / I_SQ, item = r % I_SQ, which = mat >> 2, L = mat & 3, k0 = (item / 32) * 64, n0 = (item % 32) * 64;
            src = (which == 0 ? args.in[20] : which == 1 ? args.in[21] : which == 2 ? args.in[22] : args.in[23]) + (size_t)L * D * D + (size_t)k0 * D + n0; ldw = D;
            dst = (bf16_t*)(ws + (which == 0 ? WS_WQ : which == 1 ? WS_WK : which == 2 ? WS_WV : WS_WO)) + (size_t)L * D * D + (size_t)n0 * D + k0; ldd = D;
            if (which == 0) { ks = args.in[18] + L * D + k0; sc = 0.04419417382415922f; } }
        else if ((r -= N_SQ) < N_IN) { const int j = r / I_IN, item = r % I_IN, k0 = (item / 64) * 64, n0 = (item % 64) * 64;
            src = args.in[9] + (size_t)j * D * 4096 + (size_t)k0 * 4096 + n0; ldw = 4096; dst = (bf16_t*)(ws + WS_WIN) + (size_t)j * 4096 * D + (size_t)n0 * D + k0; ldd = D; ks = args.in[6] + (2 * j + 1) * D + k0; }
        else if ((r -= N_IN) < N_OUT) { const int j = r / I_OUT, item = r % I_OUT, k0 = (item / 32) * 64, n0 = (item % 32) * 64;
            src = args.in[17] + (size_t)j * D * D + (size_t)k0 * D + n0; ldw = D; dst = (bf16_t*)(ws + WS_WOUT) + (size_t)j * D * D + (size_t)n0 * D + k0; ldd = D; }
        else if ((r -= N_OUT) < N_P) { const int mat = r / I_P, item = r % I_P, j = mat >> 2, g = mat & 3, k0 = (item / 8) * 64, n0 = (item % 8) * 64;
            src = args.in[7] + (size_t)mat * 512 * 512 + (size_t)k0 * 512 + n0; ldw = 512; dst = (bf16_t*)(ws + WS_WP) + (size_t)j * D * 512 + (size_t)(g * 512 + n0) * 512 + k0; ldd = 512;
            ks = args.in[6] + (2 * j) * D + g * 512 + k0; ns = args.in[8] + j * D + g * 512 + n0; }
        else { r -= N_P; const int mat = r / I_G, item = r % I_G, j = mat >> 5, isx = (mat >> 4) & 1, hh = mat & 15, k0 = (item >> 1) * 64, n0 = (item & 1) * 64;
            src = (isx ? args.in[14] : args.in[12]) + (size_t)(j * 16 + hh) * 128 * 128 + (size_t)k0 * 128 + n0; ldw = 128;
            bf16_t* rowp = (bf16_t*)(ws + WS_WGATE) + (size_t)j * 4096 * 256 + (size_t)(hh * 256 + isx * 128 + n0) * 256;
            dst = rowp + (hh & 1) * 128 + k0; dstz = rowp + ((hh & 1) ^ 1) * 128 + k0; ldd = 256; }
        tr_item(src, ldw, dst, ldd, ks, ns, sc, dstz, scr, lane);
    }
    { const float* x = args.in[0]; float* h = args.out; bf16_t* hb = (bf16_t*)(ws + WS_HB); float* part = (float*)(ws + WS_PART);
      for (int row = gw; row < M; row += NGW) { const f32x4* xr = (const f32x4*)(x + (size_t)row * D) + lane; f32x4 v[8]; float ss = 0.f;
#pragma unroll
          for (int j = 0; j < 8; ++j) { v[j] = xr[64 * j]; ss += (v[j][0] * v[j][0] + v[j][1] * v[j][1]) + (v[j][2] * v[j][2] + v[j][3] * v[j][3]); }
          ss = wave_sum(ss);
          f32x4* hr = (f32x4*)(h + (size_t)row * D) + lane; u32x2* br = (u32x2*)(hb + (size_t)row * D) + lane;
#pragma unroll
          for (int j = 0; j < 8; ++j) { hr[64 * j] = v[j]; u32x2 w; w.x = cvt_pk_bf16(v[j][0], v[j][1]); w.y = cvt_pk_bf16(v[j][2], v[j][3]); br[64 * j] = w; }
          if (lane < 32) part[(size_t)row * 32 + lane] = lane == 0 ? ss : 0.f; } }
    { const float* mem = args.in[1]; const float* g = args.in[19]; bf16_t* mb = (bf16_t*)(ws + WS_MB);
      for (int row = gw; row < MM; row += NGW) { const f32x4* xr = (const f32x4*)(mem + (size_t)row * D) + lane; f32x4 v[8]; float ss = 0.f;
#pragma unroll
          for (int j = 0; j < 8; ++j) { v[j] = xr[64 * j]; ss += (v[j][0] * v[j][0] + v[j][1] * v[j][1]) + (v[j][2] * v[j][2] + v[j][3] * v[j][3]); }
          const float rs = rsqrtf(wave_sum(ss) * (1.0f / 2048.0f) + EPS); u32x2* br = (u32x2*)(mb + (size_t)row * D) + lane;
#pragma unroll
          for (int j = 0; j < 8; ++j) { const f32x4 gv = *((const f32x4*)g + lane + 64 * j); const f32x4 o = v[j] * rs * gv; u32x2 w; w.x = cvt_pk_bf16(o[0], o[1]); w.y = cvt_pk_bf16(o[2], o[3]); br[64 * j] = w; } } }
    { const float* lam = args.in[16]; float* sp = (float*)(ws + WS_SP);
      for (int i = gw * 64 + lane; i < 2 * D; i += NGW * 64) { const float z = -lam[i]; sp[i] = 8.0f * (fmaxf(z, 0.f) + log1pf(expf(-fabsf(z)))); } }
}

constexpr int PD = 256 * D * 2;
typedef pg8::Sched<M,      2 * FF,  D,   D,    D,      PD,            0,       0,   PD,             0,                0> ShGU;
typedef pg8::Sched<M,      D,       FF,  FF,   FF,     256 * FF * 2,  0,       0,   256 * FF * 2,   0,                0> ShDown;
typedef pg8::Sched<M,      D,       512, D,    512,    PD,            512 * 2, 1,   256 * 512 * 2,  0,                0> ShPool;
typedef pg8::Sched<M,      2 * D,   D,   D,    D,      PD,            0,       0,   PD,             0,                0> ShLruIn;
typedef pg8::Sched<M,      2 * D,   256, D,    256,    PD,            256 * 2, 1,   256 * 256 * 2,  0,                0> ShGates;
typedef pg8::Sched<M,      D,       D,   D,    D,      PD,            0,       0,   PD,             0,                0> ShDD;
typedef pg8::Sched<M,      NH*MEML, HD,  D,    4 * D,  PD,            HD * 2,  0,   HD * 2,         256 * 4 * D * 2,  4> ShScore;
typedef pg8::Sched<M,      D,       256, 1024, MM,     256 * 1024 * 2, 256 * 2, 1,  256 * MM * 2,   256 * 2,          4> ShPV;
typedef pg8::Sched<MM,     4 * D,   D,   D,    D,      PD,            0,       0,   PD,             0,                0> ShK;
typedef pg8::Sched<4 * D,  MM,      D,   D,    D,      PD,            0,       0,   PD,             0,                0> ShV;

#define PHASE_VARS() int tid = threadIdx.x; asm volatile("" : "+v"(tid)); unsigned char* ws = args.ws; asm volatile("" : "+s"(ws)); float* h = args.out; asm volatile("" : "+s"(h)); \
    bf16_t* hb = (bf16_t*)(ws + WS_HB); float* part = (float*)(ws + WS_PART); (void)tid; (void)h; (void)hb; (void)part
__global__ void __launch_bounds__(512, 2) mk_fwd(Args args) {
    extern __shared__ __attribute__((aligned(16))) unsigned char lds_raw[];
    LAS unsigned char* lds = (LAS unsigned char*)lds_raw;
    const int G = gridDim.x, bx = blockIdx.x;
#if MK_SINGLE
    volatile LAS unsigned* MISC = (volatile LAS unsigned*)(lds + MISC_OFF);
    if (threadIdx.x < 32) MISC[threadIdx.x] = 0u;
    __syncthreads();
    XcdBarrier bar = xcd_barrier_post((unsigned*)(args.ws + WS_CTL) + CW_BAR, MISC + 8);
#define GRID_BAR() xcd_barrier(bar)
#define PH(k) true
    const int s_lo = 0, s_hi = 8; const bool do_pro = true, do_fin = true;
#else
#define GRID_BAR() do {} while (0)
#define PH(k) (args.phase == (k))
    const int s_lo = args.step, s_hi = (args.step >= 0 && args.step < 8) ? args.step + 1 : args.step; const bool do_pro = args.step == -1, do_fin = args.step == 8;
#endif

    if (do_pro) {
        if (PH(0)) { PHASE_VARS(); prologue(args, lds, tid & 63, __builtin_amdgcn_readfirstlane(tid >> 6), bx, G); GRID_BAR(); }
        if (PH(1)) {
            PHASE_VARS(); const int G2 = G / 2;
            if (bx < G2) { ShK S{(const char*)(ws + WS_MB), (const char*)(ws + WS_WK), G2, bx}; pg8::EpiPlain E{(bf16_t*)(ws + WS_KALL), 4 * D}; pg8::gemm_phase<pg8::EpiPlain, true>(lds, S, E); }
            else { ShV S{(const char*)(ws + WS_WV), (const char*)(ws + WS_MB), G - G2, bx - G2}; pg8::EpiPlain E{(bf16_t*)(ws + WS_VTALL), MM}; pg8::gemm_phase<pg8::EpiPlain, true>(lds, S, E); }
        }
    }
#pragma unroll 1
    for (int s = s_lo; s < s_hi; ++s) {
        const int L = s >> 1, lw = s;
        if (PH(0)) { PHASE_VARS(); ShGU S{(const char*)hb, (const char*)(ws + WS_WGU) + (size_t)lw * (2 * FF) * D * 2, G, bx};
            pg8::EpiSwiGLU E{(bf16_t*)(ws + WS_ACT), part};
            pg8::gemm_phase<pg8::EpiSwiGLU, true>(lds, S, E); GRID_BAR(); }
        if (PH(1)) { PHASE_VARS(); ShDown S{(const char*)(ws + WS_ACT), (const char*)(ws + WS_WD) + (size_t)lw * D * FF * 2, G, bx};
            pg8::EpiResid E{h, hb, part, 0.5f};
            pg8::gemm_phase<pg8::EpiResid, true>(lds, S, E); GRID_BAR(); }
        if ((s & 1) == 0) {
            const int j = L >> 1;
            if ((L & 1) == 0) {
                if (PH(2)) { PHASE_VARS(); bf16_t* pooled = (bf16_t*)(ws + WS_POOLED); LAS float* R = (LAS float*)lds;
                    for (int blk = bx; blk < M / 64; blk += G) { const int t0 = blk * 64, seq0 = (t0 / SEQ) * SEQ;
                        if (tid < 79) { const int row = t0 - 15 + tid; float rs = 0.f;
                            if (row >= seq0) { const f32x4* p = (const f32x4*)(part + (size_t)row * 32); float sacc = 0.f;
#pragma unroll
                                for (int q = 0; q < 8; ++q) { const f32x4 a = p[q]; sacc += (a[0] + a[1]) + (a[2] + a[3]); }
                                rs = rsqrtf(sacc * (1.0f / 2048.0f) + EPS); }
                            R[tid] = rs; }
                        __syncthreads();
                        const int w = 2 << (tid >> 7); const float* hc = h + 4 * tid; f32x4 S4 = (f32x4){0.f, 0.f, 0.f, 0.f};
                        for (int r = t0 - (w - 1); r < t0; ++r) if (r >= seq0) S4 = S4 + *(const f32x4*)(hc + (size_t)r * D) * R[r - t0 + 15];
#pragma unroll 4
                        for (int t = t0; t < t0 + 64; ++t) { const f32x4 uv = *(const f32x4*)(hc + (size_t)t * D) * R[t - t0 + 15]; S4 = S4 + uv; const int tt = t - seq0;
                            if (t > t0 && tt >= w) S4 = S4 - *(const f32x4*)(hc + (size_t)(t - w) * D) * R[t - w - t0 + 15];
                            const float ic = 1.0f / (float)(tt + 1 < w ? tt + 1 : w); const f32x4 o = S4 * ic - uv;
                            u32x2 pk; pk.x = cvt_pk_bf16(o[0], o[1]); pk.y = cvt_pk_bf16(o[2], o[3]); *(u32x2*)(pooled + (size_t)t * D + 4 * tid) = pk; }
                        __syncthreads(); }
                    GRID_BAR(); }
                if (PH(3)) { PHASE_VARS(); ShPool S{(const char*)(ws + WS_POOLED), (const char*)(ws + WS_WP) + (size_t)j * D * 512 * 2, G, bx};
                    pg8::EpiResid E{h, hb, part, 1.0f};
                    pg8::gemm_phase<pg8::EpiResid, true>(lds, S, E); GRID_BAR(); }
            } else {
                if (PH(2)) { PHASE_VARS(); ShLruIn S{(const char*)hb, (const char*)(ws + WS_WIN) + (size_t)j * 4096 * D * 2, G, bx};
                    pg8::EpiLruIn E{(bf16_t*)(ws + WS_GG), (float*)(ws + WS_XR), part};
                    pg8::gemm_phase<pg8::EpiLruIn, true>(lds, S, E); GRID_BAR(); }
                if (PH(3)) { PHASE_VARS(); const float* xr = (const float*)(ws + WS_XR); float* xc32 = (float*)(ws + WS_XC32); bf16_t* xcb = (bf16_t*)(ws + WS_XCB);
                    const float* cw = args.in[10] + (size_t)j * 4 * D + 4 * tid; const f32x4 w0 = *(const f32x4*)cw, w1 = *(const f32x4*)(cw + D), w2 = *(const f32x4*)(cw + 2 * D), w3 = *(const f32x4*)(cw + 3 * D);
                    const f32x4 cb = *(const f32x4*)(args.in[11] + (size_t)j * D + 4 * tid);
                    for (int blk = bx; blk < M / 64; blk += G) { const int t0 = blk * 64, seq0 = (t0 / SEQ) * SEQ; const float* xp = xr + 4 * tid; const f32x4 z = (f32x4){0.f, 0.f, 0.f, 0.f};
                        f32x4 x0 = t0 > seq0 ? *(const f32x4*)(xp + (size_t)(t0 - 3) * D) : z, x1 = t0 > seq0 ? *(const f32x4*)(xp + (size_t)(t0 - 2) * D) : z, x2 = t0 > seq0 ? *(const f32x4*)(xp + (size_t)(t0 - 1) * D) : z;
#pragma unroll 8
                        for (int t = t0; t < t0 + 64; ++t) { const f32x4 x3 = *(const f32x4*)(xp + (size_t)t * D); const f32x4 o = cb + x0 * w0 + x1 * w1 + x2 * w2 + x3 * w3;
                            *(f32x4*)(xc32 + (size_t)t * D + 4 * tid) = o; u32x2 pk; pk.x = cvt_pk_bf16(o[0], o[1]); pk.y = cvt_pk_bf16(o[2], o[3]); *(u32x2*)(xcb + (size_t)t * D + 4 * tid) = pk;
                            x0 = x1; x1 = x2; x2 = x3; } }
                    GRID_BAR(); }
                if (PH(4)) { PHASE_VARS(); ShGates S{(const char*)(ws + WS_XCB), (const char*)(ws + WS_WGATE) + (size_t)j * 4096 * 256 * 2, G, bx};
                    pg8::EpiGates E{(float*)(ws + WS_XR), (float*)(ws + WS_BT), (const float*)(ws + WS_XC32), args.in[13] + (size_t)j * D, args.in[15] + (size_t)j * D, (const float*)(ws + WS_SP) + (size_t)j * D};
                    pg8::gemm_phase<pg8::EpiGates, true>(lds, S, E); GRID_BAR(); }
                if (PH(5)) { PHASE_VARS(); const float* av = (const float*)(ws + WS_XR); const float* bv = (const float*)(ws + WS_BT); float* chA = (float*)(ws + WS_CHA); float* chB = (float*)(ws + WS_CHB);
                    for (int blk = bx; blk < M / 64; blk += G) { const int t0 = blk * 64; f32x4 Ap = (f32x4){1.f, 1.f, 1.f, 1.f}, Hs = (f32x4){0.f, 0.f, 0.f, 0.f};
#pragma unroll 8
                        for (int t = t0; t < t0 + 64; ++t) { const f32x4 a4 = *(const f32x4*)(av + (size_t)t * D + 4 * tid), b4 = *(const f32x4*)(bv + (size_t)t * D + 4 * tid); Hs = a4 * Hs + b4; Ap = Ap * a4; }
                        *(f32x4*)(chA + (size_t)blk * D + 4 * tid) = Ap; *(f32x4*)(chB + (size_t)blk * D + 4 * tid) = Hs; }
                    GRID_BAR(); }
                if (PH(6)) { PHASE_VARS(); const float* av = (const float*)(ws + WS_XR); const float* bv = (const float*)(ws + WS_BT); const float* chA = (const float*)(ws + WS_CHA); const float* chB = (const float*)(ws + WS_CHB);
                    const bf16_t* gg = (const bf16_t*)(ws + WS_GG); bf16_t* yb = (bf16_t*)(ws + WS_XCB);
                    for (int blk = bx; blk < M / 64; blk += G) { const int t0 = blk * 64, c0 = (blk / 64) * 64; f32x4 Hs = (f32x4){0.f, 0.f, 0.f, 0.f};
                        for (int c = c0; c < blk; ++c) { const f32x4 a4 = *(const f32x4*)(chA + (size_t)c * D + 4 * tid), b4 = *(const f32x4*)(chB + (size_t)c * D + 4 * tid); Hs = a4 * Hs + b4; }
#pragma unroll 8
                        for (int t = t0; t < t0 + 64; ++t) { const f32x4 a4 = *(const f32x4*)(av + (size_t)t * D + 4 * tid), b4 = *(const f32x4*)(bv + (size_t)t * D + 4 * tid); Hs = a4 * Hs + b4;
                            const u32x2 gk = *(const u32x2*)(gg + (size_t)t * D + 4 * tid);
                            const float g0 = __uint_as_float(gk.x << 16), g1 = __uint_as_float(gk.x & 0xffff0000u), g2 = __uint_as_float(gk.y << 16), g3 = __uint_as_float(gk.y & 0xffff0000u);
                            u32x2 pk; pk.x = cvt_pk_bf16(Hs[0] * g0, Hs[1] * g1); pk.y = cvt_pk_bf16(Hs[2] * g2, Hs[3] * g3); *(u32x2*)(yb + (size_t)t * D + 4 * tid) = pk; } }
                    GRID_BAR(); }
                if (PH(7)) { PHASE_VARS(); ShDD S{(const char*)(ws + WS_XCB), (const char*)(ws + WS_WOUT) + (size_t)j * D * D * 2, G, bx};
                    pg8::EpiResid E{h, hb, part, 1.0f};
                    pg8::gemm_phase<pg8::EpiResid, true>(lds, S, E); GRID_BAR(); }
            }
            if (PH(8)) { PHASE_VARS(); ShDD S{(const char*)hb, (const char*)(ws + WS_WQ) + (size_t)L * D * D * 2, G, bx};
                pg8::EpiRowScale E{(bf16_t*)(ws + WS_Q), D, part};
                pg8::gemm_phase<pg8::EpiRowScale, true>(lds, S, E); GRID_BAR(); }
            if (PH(9)) { PHASE_VARS(); ShScore S{(const char*)(ws + WS_Q), (const char*)(ws + WS_KALL) + (size_t)L * D * 2, G, bx};
                pg8::EpiSoftmax E{(bf16_t*)(ws + WS_P)};
                pg8::gemm_phase<pg8::EpiSoftmax, false>(lds, S, E); GRID_BAR(); }
            if (PH(10)) { PHASE_VARS(); ShPV S{(const char*)(ws + WS_P), (const char*)(ws + WS_VTALL) + (size_t)L * D * MM * 2, G, bx};
                pg8::EpiPlain E{(bf16_t*)(ws + WS_O), D};
                pg8::gemm_phase<pg8::EpiPlain, true>(lds, S, E); GRID_BAR(); }
            if (PH(11)) { PHASE_VARS(); ShDD S{(const char*)(ws + WS_O), (const char*)(ws + WS_WO) + (size_t)L * D * D * 2, G, bx};
                pg8::EpiResid E{h, hb, part, 1.0f};
                pg8::gemm_phase<pg8::EpiResid, true>(lds, S, E); GRID_BAR(); }
        }
    }
    if (do_fin) { PHASE_VARS(); const float* g = args.in[24]; const int lane = tid & 63, gw = bx * 8 + (tid >> 6), NGW = G * 8;
        for (int row = gw; row < M; row += NGW) { f32x4* xr = (f32x4*)(h + (size_t)row * D) + lane; f32x4 v[8]; float ss = 0.f;
#pragma unroll
            for (int jj = 0; jj < 8; ++jj) { v[jj] = xr[64 * jj]; ss += (v[jj][0] * v[jj][0] + v[jj][1] * v[jj][1]) + (v[jj][2] * v[jj][2] + v[jj][3] * v[jj][3]); }
            const float rs = rsqrtf(wave_sum(ss) * (1.0f / 2048.0f) + EPS);
#pragma unroll
            for (int jj = 0; jj < 8; ++jj) { const f32x4 gv = *((const f32x4*)g + lane + 64 * jj); xr[64 * jj] = v[jj] * rs * gv; } } }
}

extern "C" void kernel_launch(void* const* d_in, const int* in_sizes, int n_in, void* d_out, int out_size, void* d_ws, size_t ws_size, hipStream_t stream) {
    static int grid = 0;
    if (grid == 0) {
        if (n_in != 25 || in_sizes[0] != M * D || out_size != M * D || ws_size < WS_END) { fprintf(stderr, "kernel_launch: unexpected shapes (n_in %d, in0 %d, out %d, ws %zu, need %zu); nothing launched\n", n_in, n_in > 0 ? in_sizes[0] : -1, out_size, ws_size, (size_t)WS_END); grid = -1; return; }
        int dev = 0, cus = 0, per_cu = 0;
        if (hipGetDevice(&dev) != hipSuccess || hipDeviceGetAttribute(&cus, hipDeviceAttributeMultiprocessorCount, dev) != hipSuccess) { fprintf(stderr, "kernel_launch: device query failed\n"); grid = -1; return; }
        if (hipFuncSetAttribute((const void*)mk_fwd, hipFuncAttributeMaxDynamicSharedMemorySize, LDS_BYTES) != hipSuccess) { fprintf(stderr, "kernel_launch: hipFuncSetAttribute failed\n"); grid = -1; return; }
        if (hipOccupancyMaxActiveBlocksPerMultiprocessor(&per_cu, (const void*)mk_fwd, 512, LDS_BYTES) != hipSuccess || per_cu < 1) fprintf(stderr, "kernel_launch: occupancy query says %d\n", per_cu);
        (void)hipGetLastError();
        grid = cus;
        if (grid != 256) { fprintf(stderr, "kernel_launch: built for 256 CUs, found %d; nothing launched\n", cus); grid = -1; return; }
    }
    if (grid < 0) return;
    Args a{};
    for (int i = 0; i < 25; ++i) a.in[i] = (const float*)d_in[i];
    a.out = (float*)d_out; a.ws = (unsigned char*)d_ws;
#if MK_SINGLE
    if (hipMemsetAsync((char*)d_ws + WS_CTL, 0, CTL_ZERO_BYTES, stream) != hipSuccess) { fprintf(stderr, "kernel_launch: memset failed\n"); return; }
    a.step = 0; a.phase = 0;
    hipLaunchKernelGGL(mk_fwd, dim3(grid), dim3(512), LDS_BYTES, stream, a);
#else
    auto launch = [&](int s, int p) { a.step = s; a.phase = p; hipLaunchKernelGGL(mk_fwd, dim3(grid), dim3(512), LDS_BYTES, stream, a); };
    launch(-1, 0); launch(-1, 1);
    for (int s = 0; s < 8; ++s) { launch(s, 0); launch(s, 1);
        if ((s & 1) == 0) { const int L = s >> 1;
            if ((L & 1) == 0) { launch(s, 2); launch(s, 3); } else { for (int p = 2; p <= 7; ++p) launch(s, p); }
            for (int p = 8; p <= 11; ++p) launch(s, p); } }
    launch(8, 0);
#endif
    const hipError_t le = hipPeekAtLastError();
    if (le != hipSuccess) fprintf(stderr, "kernel_launch: launch failed: %s\n", hipGetErrorName(le));
}
```

```cpp
#include <hip/hip_runtime.h>
#include <cstdio>
#include <cstdint>

#ifndef MK_SINGLE
#define MK_SINGLE 1
#endif

#ifndef REP_PRO
#define REP_PRO 1
#endif
#ifndef REP_GU
#define REP_GU 1
#endif
#ifndef REP_DOWN
#define REP_DOWN 1
#endif
#ifndef REP_THIN
#define REP_THIN 1
#endif
#ifndef REP_RES2K
#define REP_RES2K 1
#endif
#define LAS __attribute__((address_space(3)))
#define GAS __attribute__((address_space(1)))
typedef unsigned short bf16_t;
typedef short bf16x8 __attribute__((ext_vector_type(8)));
typedef float f32x4 __attribute__((ext_vector_type(4)));
typedef float f32x2 __attribute__((ext_vector_type(2)));
typedef unsigned u32x4 __attribute__((ext_vector_type(4)));
typedef unsigned u32x2 __attribute__((ext_vector_type(2)));
typedef GAS unsigned gu32;
#define LDS_WAIT() asm volatile("s_waitcnt lgkmcnt(0)" ::: "memory")
#define VM_WAIT() asm volatile("s_waitcnt vmcnt(0)" ::: "memory")

__device__ __forceinline__ unsigned cvt_pk_bf16(float lo, float hi) { unsigned r; asm volatile("v_cvt_pk_bf16_f32 %0, %1, %2" : "=v"(r) : "v"(lo), "v"(hi)); return r; }
__device__ __forceinline__ float wave_sum(float v) {
#pragma unroll
    for (int o = 1; o < 64; o <<= 1) v += __shfl_xor(v, o);
    return v;
}
__device__ __forceinline__ float fast_sigmoid(float x) { return __builtin_amdgcn_rcpf(1.0f + __builtin_amdgcn_exp2f(-1.44269504089f * x)); }

constexpr int BATCH = 4, SEQ = 4096, D = 2048, DEPTH = 4, FF = 5632, MEML = 256, NH = 4, HD = 512, LH = 16;
constexpr int M = BATCH * SEQ;
constexpr int MM = BATCH * MEML;
constexpr float EPS = 1e-6f;

namespace pg8 {
constexpr int BM = 256, BK = 64, HALF = 128, HTB = HALF * BK * 2, STAGE_BYTES = 8 * HTB, NXCD = 8, WGM = 8;
__host__ __device__ __forceinline__ int lds_byte(int r, int c) { const int st = (r >> 4) * 2 + (c >> 5), rr = r & 15, cc = c & 31, ob = rr * 64 + cc * 2; return st * 1024 + (ob ^ (((ob >> 9) & 1) << 5)); }
__host__ __device__ __forceinline__ void stage_rc(int b, int& R, int& C) { const int st = b / 1024, sb = b % 1024, swz = sb ^ (((sb >> 9) & 1) << 5); R = (st >> 1) * 16 + swz / 64; C = (st & 1) * 32 + (swz % 64) / 2; }
__host__ __device__ __forceinline__ int perm32(int rho) { const int n = rho >> 4, i = rho & 15; return 8 * (i >> 2) + 4 * n + (i & 3); }

struct Unit { int pm, pn; const char* a; const char* b; };

template <int nM, int nN> __device__ __forceinline__ bool unit_order(int i, int G, int c, int& pm, int& pn) {
    constexpr int nwg = nM * nN;
    const int L = i * G + c; if (L >= nwg) return false;
    int wgid = L; { constexpr int q = nwg / NXCD, r = nwg % NXCD; const int xcd = wgid % NXCD, off = wgid / NXCD; wgid = (xcd < r ? xcd * (q + 1) : r * (q + 1) + (xcd - r) * q) + off; }
    constexpr int nig = WGM * nN; const int gid = wgid / nig, fm = gid * WGM, gsz = (nM - fm) < WGM ? (nM - fm) : WGM;
    pm = fm + ((wgid % nig) % gsz); pn = (wgid % nig) / gsz; return true;
}
template <int MR, int NC, int K_, int LDA, int LDB, int APM, int APN, int ASH, int BPN, int BPM, int BSH>
struct Sched {
    static constexpr int K = K_, lda = LDA, ldb = LDB;
    const char* A; const char* B; int G, c;
    __device__ __forceinline__ bool next(int i, Unit& u) const {
        if (!unit_order<MR / BM, NC / BM>(i, G, c, u.pm, u.pn)) return false;
        u.a = A + (size_t)u.pm * APM + (size_t)(u.pn >> ASH) * APN; u.b = B + (size_t)u.pn * BPN + (size_t)(u.pm >> BSH) * BPM; return true;
    }
};
struct SchedG {
    static constexpr int K = 512, lda = 16384, ldb = 2048;
    const char* KV; const char* WQN; int G, c;
    __device__ __forceinline__ bool next(int i, Unit& u) const {
        if (!unit_order<64, 8>(i, G, c, u.pm, u.pn)) return false;
        const int L = u.pm >> 4, b = (u.pm >> 2) & 3, h = u.pm & 3;
        u.a = KV + ((size_t)(b * 256) * 16384 + L * 2048 + h * 512) * 2; u.b = WQN + ((size_t)L * 2048 * 2048 + (size_t)u.pn * 256 * 2048 + h * 512) * 2; return true;
    }
};
struct SchedH {
    static constexpr int K = 512, lda = 2048, ldb = 16384;
    const char* WOT; const char* KV; int G, c;
    __device__ __forceinline__ bool next(int i, Unit& u) const {
        if (!unit_order<32, 16>(i, G, c, u.pm, u.pn)) return false;
        const int L = u.pm >> 3, b = u.pn >> 2, h = u.pn & 3;
        u.a = WOT + ((size_t)u.pm * 256 * 2048 + h * 512) * 2; u.b = KV + ((size_t)(b * 256) * 16384 + 8192 + L * 2048 + h * 512) * 2; return true;
    }
};

__device__ __forceinline__ float row_rstd(const float* part, int row, int fq) {
    const f32x4* p = (const f32x4*)(part + (size_t)row * 32 + fq * 8);
    const f32x4 a = p[0], b = p[1];
    float s = ((a.x + a.y) + (a.z + a.w)) + ((b.x + b.y) + (b.z + b.w));
    s += __shfl_xor(s, 16); s += __shfl_xor(s, 32);
    return rsqrtf(s * (1.0f / 2048.0f) + EPS);
}

struct EpiSwiGLU {
    static constexpr bool PERM = true, AFTER_DRAIN = false;
    bf16_t* O; const float* part;
    __device__ __forceinline__ void operator()(const f32x4 (&acc)[2][2][4][2], const Unit& u, int wr, int wc, int fr, int fq) const {
        const int row0 = u.pm * BM + wr * 64 + fr, col0 = u.pn * HALF + wc * 32 + 8 * fq;
#pragma unroll
        for (int ai = 0; ai < 2; ++ai)
#pragma unroll
            for (int m = 0; m < 4; ++m) { const int row = row0 + ai * HALF + m * 16; const float rs = row_rstd(part, row, fq);
                float o[8];
#pragma unroll
                for (int n = 0; n < 2; ++n)
#pragma unroll
                    for (int j = 0; j < 4; ++j) { const float g = acc[ai][0][m][n][j] * rs, up = acc[ai][1][m][n][j] * rs; o[n * 4 + j] = g * fast_sigmoid(g) * up; }
                u32x4 w; w.x = cvt_pk_bf16(o[0], o[1]); w.y = cvt_pk_bf16(o[2], o[3]); w.z = cvt_pk_bf16(o[4], o[5]); w.w = cvt_pk_bf16(o[6], o[7]);
                *(u32x4*)(O + (size_t)row * FF + col0) = w; }
    }
};
struct EpiResid {
    static constexpr bool PERM = true, AFTER_DRAIN = false;
    float* h; bf16_t* hb; float* part; float alpha;
    __device__ __forceinline__ void operator()(const f32x4 (&acc)[2][2][4][2], const Unit& u, int wr, int wc, int fr, int fq) const {
        const int row0 = u.pm * BM + wr * 64 + fr, col0 = u.pn * BM + wc * 32 + 8 * fq;
#pragma unroll
        for (int ai = 0; ai < 2; ++ai)
#pragma unroll
            for (int m = 0; m < 4; ++m) { const int row = row0 + ai * HALF + m * 16; float* hp = h + (size_t)row * D + col0; bf16_t* bp = hb + (size_t)row * D + col0; float ss = 0.f;
#pragma unroll
                for (int bj = 0; bj < 2; ++bj) { f32x4 x0 = *(const f32x4*)(hp + bj * HALF), x1 = *(const f32x4*)(hp + bj * HALF + 4);
                    x0 = x0 + acc[ai][bj][m][0] * alpha; x1 = x1 + acc[ai][bj][m][1] * alpha;
                    *(f32x4*)(hp + bj * HALF) = x0; *(f32x4*)(hp + bj * HALF + 4) = x1;
                    u32x4 w; w.x = cvt_pk_bf16(x0[0], x0[1]); w.y = cvt_pk_bf16(x0[2], x0[3]); w.z = cvt_pk_bf16(x1[0], x1[1]); w.w = cvt_pk_bf16(x1[2], x1[3]);
                    *(u32x4*)(bp + bj * HALF) = w;
                    ss += ((x0[0] * x0[0] + x0[1] * x0[1]) + (x0[2] * x0[2] + x0[3] * x0[3])) + ((x1[0] * x1[0] + x1[1] * x1[1]) + (x1[2] * x1[2] + x1[3] * x1[3])); }
                ss += __shfl_xor(ss, 16); ss += __shfl_xor(ss, 32);
                if (fq == 0) part[(size_t)row * 32 + u.pn * 4 + wc] = ss;
                if (m == 3) asm volatile("" ::: "memory"); }
    }
};
struct EpiRowScale {
    static constexpr bool PERM = true, AFTER_DRAIN = false;
    bf16_t* O; int ldo; const float* part;
    __device__ __forceinline__ void operator()(const f32x4 (&acc)[2][2][4][2], const Unit& u, int wr, int wc, int fr, int fq) const {
        const int row0 = u.pm * BM + wr * 64 + fr, col0 = u.pn * BM + wc * 32 + 8 * fq;
#pragma unroll
        for (int ai = 0; ai < 2; ++ai)
#pragma unroll
            for (int m = 0; m < 4; ++m) { const int row = row0 + ai * HALF + m * 16; const float rs = row_rstd(part, row, fq); bf16_t* rp = O + (size_t)row * ldo + col0;
#pragma unroll
                for (int bj = 0; bj < 2; ++bj) { const f32x4 v0 = acc[ai][bj][m][0] * rs, v1 = acc[ai][bj][m][1] * rs;
                    u32x4 w; w.x = cvt_pk_bf16(v0[0], v0[1]); w.y = cvt_pk_bf16(v0[2], v0[3]); w.z = cvt_pk_bf16(v1[0], v1[1]); w.w = cvt_pk_bf16(v1[2], v1[3]);
                    *(u32x4*)(rp + bj * HALF) = w; } }
    }
};
struct EpiPlain {
    static constexpr bool PERM = true, AFTER_DRAIN = false;
    bf16_t* O; int ldo;
    __device__ __forceinline__ void operator()(const f32x4 (&acc)[2][2][4][2], const Unit& u, int wr, int wc, int fr, int fq) const {
        const int row0 = u.pm * BM + wr * 64 + fr, col0 = u.pn * BM + wc * 32 + 8 * fq;
#pragma unroll
        for (int ai = 0; ai < 2; ++ai)
#pragma unroll
            for (int m = 0; m < 4; ++m) { bf16_t* rp = O + (size_t)(row0 + ai * HALF + m * 16) * ldo + col0;
#pragma unroll
                for (int bj = 0; bj < 2; ++bj) { const f32x4 v0 = acc[ai][bj][m][0], v1 = acc[ai][bj][m][1];
                    u32x4 w; w.x = cvt_pk_bf16(v0[0], v0[1]); w.y = cvt_pk_bf16(v0[2], v0[3]); w.z = cvt_pk_bf16(v1[0], v1[1]); w.w = cvt_pk_bf16(v1[2], v1[3]);
                    *(u32x4*)(rp + bj * HALF) = w; } }
    }
};
struct EpiLruIn {
    static constexpr bool PERM = true, AFTER_DRAIN = false;
    bf16_t* gg; float* xr; const float* part;
    __device__ __forceinline__ void operator()(const f32x4 (&acc)[2][2][4][2], const Unit& u, int wr, int wc, int fr, int fq) const {
        const int row0 = u.pm * BM + wr * 64 + fr; const bool isg = u.pn < 8; const int col0 = (isg ? u.pn : u.pn - 8) * BM + wc * 32 + 8 * fq;
#pragma unroll
        for (int ai = 0; ai < 2; ++ai)
#pragma unroll
            for (int m = 0; m < 4; ++m) { const int row = row0 + ai * HALF + m * 16; const float rs = row_rstd(part, row, fq);
#pragma unroll
                for (int bj = 0; bj < 2; ++bj) { const f32x4 v0 = acc[ai][bj][m][0] * rs, v1 = acc[ai][bj][m][1] * rs;
                    if (isg) { float o[8];
#pragma unroll
                        for (int j = 0; j < 8; ++j) { const float x = j < 4 ? v0[j] : v1[j - 4]; o[j] = x * fast_sigmoid(1.5957691216f * (x + 0.044715f * x * x * x)); }
                        u32x4 w; w.x = cvt_pk_bf16(o[0], o[1]); w.y = cvt_pk_bf16(o[2], o[3]); w.z = cvt_pk_bf16(o[4], o[5]); w.w = cvt_pk_bf16(o[6], o[7]);
                        *(u32x4*)(gg + (size_t)row * D + col0 + bj * HALF) = w; }
                    else { float* xp = xr + (size_t)row * D + col0 + bj * HALF; *(f32x4*)xp = v0; *(f32x4*)(xp + 4) = v1; } } }
    }
};
struct EpiGates {
    static constexpr bool PERM = true, AFTER_DRAIN = false;
    float* A; float* Bt; const bf16_t* xc; const float* ba; const float* bx; const float* sp8;
    __device__ __forceinline__ void operator()(const f32x4 (&acc)[2][2][4][2], const Unit& u, int wr, int wc, int fr, int fq) const {
        const int row0 = u.pm * BM + wr * 64 + fr, c0 = u.pn * HALF + wc * 32 + 8 * fq;
        f32x4 bav[2], bxv[2], spv[2];
#pragma unroll
        for (int n = 0; n < 2; ++n) { bav[n] = *(const f32x4*)(ba + c0 + 4 * n); bxv[n] = *(const f32x4*)(bx + c0 + 4 * n); spv[n] = *(const f32x4*)(sp8 + c0 + 4 * n); }
#pragma unroll
        for (int ai = 0; ai < 2; ++ai)
#pragma unroll
            for (int m = 0; m < 4; ++m) { const int row = row0 + ai * HALF + m * 16; const u32x4 xk = *(const u32x4*)(xc + (size_t)row * D + c0);
#pragma unroll
                for (int n = 0; n < 2; ++n) { const unsigned k0 = n == 0 ? xk.x : xk.z, k1 = n == 0 ? xk.y : xk.w;
                    const f32x4 xv = (f32x4){__uint_as_float(k0 << 16), __uint_as_float(k0 & 0xffff0000u), __uint_as_float(k1 << 16), __uint_as_float(k1 & 0xffff0000u)}; f32x4 av, bv;
#pragma unroll
                    for (int j = 0; j < 4; ++j) { const float r = fast_sigmoid(acc[ai][0][m][n][j] + bav[n][j]), ig = fast_sigmoid(acc[ai][1][m][n][j] + bxv[n][j]);
                        const float la = -r * spv[n][j], t = 2.0f * la;
                        const float a = __builtin_amdgcn_exp2f(1.44269504089f * la);
                        const float ser = -t * (1.0f + 0.5f * t * (1.0f + (1.0f / 3.0f) * t * (1.0f + 0.25f * t * (1.0f + 0.2f * t * (1.0f + (1.0f / 6.0f) * t)))));
                        const float om = t > -0.3f ? ser : 1.0f - __builtin_amdgcn_exp2f(1.44269504089f * t);
                        av[j] = a; bv[j] = sqrtf(om) * ig * xv[j]; }
                    *(f32x4*)(A + (size_t)row * D + c0 + 4 * n) = av; *(f32x4*)(Bt + (size_t)row * D + c0 + 4 * n) = bv; }
                if (m & 1) asm volatile("" ::: "memory"); }
    }
};
struct EpiSoftmax {
    static constexpr bool PERM = true, AFTER_DRAIN = true;
    bf16_t* P; const float* part;
    __device__ __forceinline__ void fused(f32x4 (&acc)[2][2][4][2], const Unit& u, int wr, int wc, int fr, int fq, LAS unsigned char* lds, int wid, int lane) const {
        LAS float* X = (LAS float*)lds; LAS float* Y = (LAS float*)(lds + 4096);
#pragma unroll
        for (int ai = 0; ai < 2; ++ai)
#pragma unroll
            for (int m = 0; m < 4; ++m) { float mx = -3.0e38f; const float rs = row_rstd(part, u.pm * BM + ai * HALF + wr * 64 + m * 16 + fr, fq);
#pragma unroll
                for (int bj = 0; bj < 2; ++bj)
#pragma unroll
                    for (int n = 0; n < 2; ++n) { acc[ai][bj][m][n] = acc[ai][bj][m][n] * rs; const f32x4 x = acc[ai][bj][m][n]; mx = fmaxf(mx, fmaxf(fmaxf(x[0], x[1]), fmaxf(x[2], x[3]))); }
                mx = fmaxf(mx, __shfl_xor(mx, 16)); mx = fmaxf(mx, __shfl_xor(mx, 32));
                if (fq == 0) X[(ai * HALF + wr * 64 + m * 16 + fr) * 4 + wc] = mx; }
        LDS_WAIT(); __builtin_amdgcn_s_barrier(); asm volatile("" ::: "memory");
#pragma unroll
        for (int ai = 0; ai < 2; ++ai)
#pragma unroll
            for (int m = 0; m < 4; ++m) { const int r = ai * HALF + wr * 64 + m * 16 + fr; const f32x4 v = *(const LAS f32x4*)(X + r * 4);
                const float mx = fmaxf(fmaxf(v[0], v[1]), fmaxf(v[2], v[3])) * 1.44269504089f; float s = 0.f;
#pragma unroll
                for (int bj = 0; bj < 2; ++bj)
#pragma unroll
                    for (int n = 0; n < 2; ++n)
#pragma unroll
                        for (int j = 0; j < 4; ++j) { const float p = __builtin_amdgcn_exp2f(acc[ai][bj][m][n][j] * 1.44269504089f - mx); acc[ai][bj][m][n][j] = p; s += p; }
                s += __shfl_xor(s, 16); s += __shfl_xor(s, 32);
                if (fq == 0) Y[r * 4 + wc] = s; }
        LDS_WAIT(); __builtin_amdgcn_s_barrier(); asm volatile("" ::: "memory");
#pragma unroll
        for (int ai = 0; ai < 2; ++ai)
#pragma unroll
            for (int m = 0; m < 4; ++m) { const int r = ai * HALF + wr * 64 + m * 16 + fr; const f32x4 v = *(const LAS f32x4*)(Y + r * 4);
                const float inv = 1.0f / ((v[0] + v[1]) + (v[2] + v[3])); bf16_t* rp = P + (size_t)(u.pm * BM + r) * 1024 + u.pn * BM + wc * 32 + 8 * fq;
#pragma unroll
                for (int bj = 0; bj < 2; ++bj) { const f32x4 v0 = acc[ai][bj][m][0] * inv, v1 = acc[ai][bj][m][1] * inv;
                    u32x4 w; w.x = cvt_pk_bf16(v0[0], v0[1]); w.y = cvt_pk_bf16(v0[2], v0[3]); w.z = cvt_pk_bf16(v1[0], v1[1]); w.w = cvt_pk_bf16(v1[2], v1[3]);
                    *(u32x4*)(rp + bj * HALF) = w; } }
    }
};

template <class Epi, bool ALIGN_EPI, class SchedT>
__device__ __forceinline__ void gemm_phase(LAS unsigned char* lds, const SchedT& S, const Epi& E) {
    int tid_ = threadIdx.x; asm volatile("" : "+v"(tid_));
    const int tid = tid_, wid = __builtin_amdgcn_readfirstlane(tid >> 6), lane = tid & 63, wr = wid >> 2, wc = wid & 3, fr = lane & 15, fq = lane >> 4;
    constexpr int K = SchedT::K, nt = K / BK;
    static_assert(K % 128 == 0 && K >= 256, "K multiple of 128, >= 256");
    unsigned voffA[2], voffB[2];
#pragma unroll
    for (int i = 0; i < 2; ++i) { int R, C; stage_rc(tid * 16 + i * 8192, R, C); const int Rb = Epi::PERM ? ((R & ~31) + perm32(R & 31)) : R;
        voffA[i] = (unsigned)(R * SchedT::lda + C) * 2u; voffB[i] = (unsigned)(Rb * SchedT::ldb + C) * 2u; }
    constexpr size_t kstep = (size_t)(BK * 2);
    constexpr size_t hstepA = (size_t)HALF * SchedT::lda * 2, hstepB = (size_t)HALF * SchedT::ldb * 2;
    const unsigned ldsw = (unsigned)wid * 1024u;
    const int aoff = lds_byte(wr * 64 + fr, fq * 8), boff = lds_byte(wc * 32 + fr, fq * 8);
#define PG8_SA(b, h) (((b) * 2 + (h)) * HTB)
#define PG8_SB(b, h) ((4 + (b) * 2 + (h)) * HTB)
#define PG8_STAGE(bufoff, gbase, voff) do { _Pragma("unroll") for (int _i = 0; _i < 2; ++_i) \
        __builtin_amdgcn_global_load_lds((const unsigned*)((const char*)(gbase) + (voff)[_i]), (LAS unsigned*)(lds + (bufoff) + ldsw + _i * 8192), 16, 0, 0); } while (0)
#define PG8_LDA(dst, b, h) do { _Pragma("unroll") for (int m = 0; m < 4; ++m) _Pragma("unroll") for (int k = 0; k < 2; ++k) dst[m][k] = *(const LAS bf16x8*)(lds + PG8_SA(b, h) + aoff + m * 2048 + k * 1024); } while (0)
#define PG8_LDB(dst, b, h) do { _Pragma("unroll") for (int n = 0; n < 2; ++n) _Pragma("unroll") for (int k = 0; k < 2; ++k) dst[n][k] = *(const LAS bf16x8*)(lds + PG8_SB(b, h) + boff + n * 2048 + k * 1024); } while (0)
#define PG8_MMA(ai, bj, At, Bt) do { __builtin_amdgcn_s_setprio(1); _Pragma("unroll") for (int m = 0; m < 4; ++m) _Pragma("unroll") for (int n = 0; n < 2; ++n) _Pragma("unroll") for (int k = 0; k < 2; ++k) \
        acc[ai][bj][m][n] = __builtin_amdgcn_mfma_f32_16x16x32_bf16(Bt[n][k], At[m][k], acc[ai][bj][m][n], 0, 0, 0); __builtin_amdgcn_s_setprio(0); } while (0)
#define PG8_WAIT_V(n) asm volatile("s_waitcnt vmcnt(" #n ")" ::: "memory")
#define PG8_WAIT_L(n) asm volatile("s_waitcnt lgkmcnt(" #n ")" ::: "memory")
#define PG8_BAR __builtin_amdgcn_s_barrier()
#define PG8_SCHED __builtin_amdgcn_sched_barrier(0)
    Unit cur, nxt; int ui = 0;
    if (!S.next(0, cur)) return;
    f32x4 acc[2][2][4][2];
#pragma unroll
    for (int a = 0; a < 2; ++a)
#pragma unroll
        for (int b = 0; b < 2; ++b)
#pragma unroll
            for (int m = 0; m < 4; ++m)
#pragma unroll
                for (int n = 0; n < 2; ++n) acc[a][b][m][n] = (f32x4){0.f, 0.f, 0.f, 0.f};
    bf16x8 At[4][2], B0[2][2], B1[2][2];
    const char* cA = cur.a; const char* cB = cur.b;
    PG8_STAGE(PG8_SB(0, 0), cB, voffB); PG8_STAGE(PG8_SB(0, 1), cB + hstepB, voffB); PG8_STAGE(PG8_SA(0, 0), cA, voffA); PG8_STAGE(PG8_SA(0, 1), cA + hstepA, voffA);
    if (wr == 1) PG8_BAR;
    PG8_WAIT_V(2); PG8_BAR;
    PG8_STAGE(PG8_SB(1, 0), cB + kstep, voffB); PG8_STAGE(PG8_SA(1, 0), cA + kstep, voffA); PG8_STAGE(PG8_SB(1, 1), cB + hstepB + kstep, voffB);
    PG8_WAIT_V(6); PG8_BAR;
    for (;;) {
        const bool has_next = S.next(ui + 1, nxt);
        const char* nA = has_next ? nxt.a : cA; const char* nB = has_next ? nxt.b : cB;
#pragma unroll 1
        for (int t = 0; t < nt; t += 2) {
            const bool last = (t == nt - 2);
            const char* a1 = cA + (size_t)(t + 1) * kstep;
            const char* a2 = last ? nA : cA + (size_t)(t + 2) * kstep; const char* b2 = last ? nB : cB + (size_t)(t + 2) * kstep;
            const char* a3 = a2 + kstep; const char* b3 = b2 + kstep;
            PG8_LDB(B0, 0, 0); PG8_LDB(B1, 0, 1); PG8_SCHED; PG8_LDA(At, 0, 0); PG8_STAGE(PG8_SA(1, 1), a1 + hstepA, voffA);
            PG8_WAIT_V(8); PG8_WAIT_L(0); PG8_BAR; PG8_MMA(0, 0, At, B0); PG8_MMA(0, 1, At, B1); PG8_BAR; PG8_SCHED;
            PG8_LDA(At, 0, 1); PG8_STAGE(PG8_SB(0, 0), b2, voffB); PG8_STAGE(PG8_SB(0, 1), b2 + hstepB, voffB); PG8_STAGE(PG8_SA(0, 0), a2, voffA);
            PG8_WAIT_V(8); PG8_WAIT_L(0); PG8_BAR; PG8_MMA(1, 0, At, B0); PG8_MMA(1, 1, At, B1); PG8_BAR; PG8_SCHED;
            PG8_LDB(B0, 1, 0); PG8_LDB(B1, 1, 1); PG8_SCHED; PG8_LDA(At, 1, 0); PG8_STAGE(PG8_SA(0, 1), a2 + hstepA, voffA);
            PG8_WAIT_V(8); PG8_WAIT_L(0); PG8_BAR; PG8_MMA(0, 0, At, B0); PG8_MMA(0, 1, At, B1); PG8_BAR; PG8_SCHED;
            PG8_LDA(At, 1, 1); PG8_STAGE(PG8_SB(1, 0), b3, voffB); PG8_STAGE(PG8_SB(1, 1), b3 + hstepB, voffB); PG8_STAGE(PG8_SA(1, 0), a3, voffA);
            PG8_WAIT_V(8); PG8_WAIT_L(0); PG8_BAR; PG8_MMA(1, 0, At, B0); PG8_MMA(1, 1, At, B1); PG8_BAR; PG8_SCHED;
        }
        if constexpr (ALIGN_EPI) { if (wr == 0) PG8_BAR; }
        if constexpr (!Epi::AFTER_DRAIN) { E(acc, cur, wr, wc, fr, fq); }
        if (!has_next) break;
#pragma unroll
        for (int a = 0; a < 2; ++a)
#pragma unroll
            for (int b = 0; b < 2; ++b)
#pragma unroll
                for (int m = 0; m < 4; ++m)
#pragma unroll
                    for (int n = 0; n < 2; ++n) acc[a][b][m][n] = (f32x4){0.f, 0.f, 0.f, 0.f};
        cur = nxt; cA = nA; cB = nB; ++ui;
        if constexpr (ALIGN_EPI) { if (wr == 1) PG8_BAR; }
    }
    PG8_WAIT_V(0);
    if constexpr (!ALIGN_EPI) { if (wr == 0) PG8_BAR; }
    PG8_BAR;
    if constexpr (Epi::AFTER_DRAIN) { E.fused(acc, cur, wr, wc, fr, fq, lds, wid, lane); }
#undef PG8_SA
#undef PG8_SB
#undef PG8_STAGE
#undef PG8_LDA
#undef PG8_LDB
#undef PG8_MMA
#undef PG8_WAIT_V
#undef PG8_WAIT_L
#undef PG8_BAR
#undef PG8_SCHED
}
}

constexpr size_t MiB = 1u << 20;
constexpr size_t WS_CTL = 0, CTL_ZERO_BYTES = 1 * MiB;
constexpr size_t WS_SP = 1 * MiB;
constexpr size_t WS_CHA = 2 * MiB, WS_CHB = 4 * MiB;
constexpr size_t WS_PART = 6 * MiB;
constexpr size_t WS_MB = 8 * MiB;
constexpr size_t WS_KV = 12 * MiB;
constexpr size_t WS_WGU = 48 * MiB;
constexpr size_t WS_WD = 400 * MiB;
constexpr size_t WS_WQN = 576 * MiB;
constexpr size_t WS_WK = 608 * MiB, WS_WV = 640 * MiB, WS_WO = 672 * MiB;
constexpr size_t WS_WIN = 704 * MiB;
constexpr size_t WS_WOUT = 736 * MiB;
constexpr size_t WS_WP = 752 * MiB;
constexpr size_t WS_WGATE = 756 * MiB;
constexpr size_t WS_HB = 760 * MiB;
constexpr size_t WS_ACT = 824 * MiB;
constexpr size_t WS_S = 1000 * MiB;
constexpr size_t WS_P = WS_S;
constexpr size_t WS_POOLED = WS_S;
constexpr size_t WS_GG = WS_S, WS_BT = WS_S + 64 * MiB, WS_XCB = WS_S + 192 * MiB;
constexpr size_t WS_XR = WS_ACT;
constexpr size_t WS_GALL = WS_S + 256 * MiB;
constexpr size_t WS_HALL = WS_S + 320 * MiB;
constexpr size_t WS_END = WS_S + 384 * MiB;
constexpr int CW_BAR = 4096;
constexpr int LDS_BYTES = 147456, MISC_OFF = LDS_BYTES - 512;

#define XB_TMO      128
#define XB_XCNT(j)  (256  + 64 * (j))
#define XB_XSUB(j)  (1280 + 64 * (j))
#define XB_XGEN(j)  (2304 + 64 * (j))
#define XB_TOP      3328
#define XB_TOPGEN   3392
#define XCD_BAR_WORDS 3456
#define XB_SPIN_CAP (1u << 18)
__device__ __forceinline__ unsigned xb_ld(unsigned* p)              { return __hip_atomic_load(p, __ATOMIC_RELAXED, __HIP_MEMORY_SCOPE_AGENT); }
__device__ __forceinline__ unsigned xb_add(unsigned* p, unsigned v) { return __hip_atomic_fetch_add(p, v, __ATOMIC_RELAXED, __HIP_MEMORY_SCOPE_AGENT); }
__device__ __forceinline__ unsigned xb_xcc_id() { return (unsigned)__builtin_amdgcn_s_getreg((3 << 11) | 20) & 0xFu; }
#define XB_SPIN(cond, bar) do { unsigned _sp = 0; while (cond) { __builtin_amdgcn_s_sleep(1); \
    if ((++_sp & 255u) == 0u) { if (xb_ld(&(bar)[XB_TMO])) break; if (_sp > XB_SPIN_CAP) { atomicAdd(&(bar)[XB_TMO], 1u); break; } } } } while (0)
struct XcdBarrier { unsigned* bar; unsigned x; volatile LAS unsigned* st; };
__device__ __forceinline__ XcdBarrier xcd_barrier_post(unsigned* bar, volatile LAS unsigned* st) {
    XcdBarrier b; b.bar = bar; b.x = xb_xcc_id(); b.st = st;
    if (threadIdx.x == 0) (void)xb_add(&bar[XB_XCNT(b.x)], 1u);
    return b;
}
__device__ __forceinline__ void xcd_barrier_complete(unsigned* bar, unsigned x, unsigned& nloc, unsigned& nx) {
    const unsigned G = gridDim.x * gridDim.y * gridDim.z;
    unsigned sum, cnt, mine, sp = 0u;
    for (;;) {
        sum = 0u; cnt = 0u; mine = 0u;
#pragma unroll
        for (unsigned j = 0; j < 16; ++j) { const unsigned c = xb_ld(&bar[XB_XCNT(j)]); sum += c; cnt += (c > 0u) ? 1u : 0u; mine = (j == x) ? c : mine; }
        if (sum == G) break;
        __builtin_amdgcn_s_sleep(1);
        if ((++sp & 255u) == 0u) { if (xb_ld(&bar[XB_TMO])) break; if (sp > XB_SPIN_CAP) { atomicAdd(&bar[XB_TMO], 1u); break; } }
    }
    nloc = mine > 0u ? mine : 1u; nx = cnt > 0u ? cnt : 1u;
}
__device__ __forceinline__ void xcd_barrier(const XcdBarrier& b) {
    asm volatile("s_waitcnt vmcnt(0)" ::: "memory");
    __syncthreads();
    if (threadIdx.x == 0) {
        unsigned* bar = b.bar;
        __builtin_amdgcn_s_waitcnt(0);
        unsigned nloc = b.st[0], nx = b.st[1];
        if (nloc == 0u) { xcd_barrier_complete(bar, b.x, nloc, nx); b.st[0] = nloc; b.st[1] = nx; }
        const unsigned old = xb_add(&bar[XB_XSUB(b.x)], 1u);
        const unsigned gen = old / nloc;
        if (old + 1u == (gen + 1u) * nloc) {
            __builtin_amdgcn_fence(__ATOMIC_RELEASE, "agent");
            asm volatile("s_waitcnt vmcnt(0)" ::: "memory");
            const unsigned og = xb_add(&bar[XB_TOP], 1u);
            const unsigned tg = og / nx;
            if (og + 1u == (tg + 1u) * nx) xb_add(&bar[XB_TOPGEN], 1u);
            else XB_SPIN(xb_ld(&bar[XB_TOPGEN]) == tg, bar);
            __builtin_amdgcn_fence(__ATOMIC_ACQUIRE, "agent");
            xb_add(&bar[XB_XGEN(b.x)], 1u);
            asm volatile("s_waitcnt vmcnt(0)" ::: "memory");
        } else {
            XB_SPIN(xb_ld(&bar[XB_XGEN(b.x)]) == gen, bar);
            __builtin_amdgcn_fence(__ATOMIC_ACQUIRE, "agent");
            asm volatile("s_waitcnt vmcnt(0)" ::: "memory");
        }
    }
    __syncthreads();
}

__device__ __forceinline__ void tr_item(const float* src, int ldw, bf16_t* dst, int ldd, const float* ks, const float* ns, float sc, bf16_t* dstz, LAS float* scr, int lane) {
    f32x4 v[16];
    const float* s0 = src + (size_t)(lane >> 4) * ldw + (lane & 15) * 4;
#pragma unroll
    for (int i = 0; i < 16; ++i) v[i] = *(const f32x4*)(s0 + (size_t)(4 * i) * ldw);
#pragma unroll
    for (int i = 0; i < 16; ++i) { LAS float* p = scr + ((lane >> 4) + 4 * i) * 65 + (lane & 15) * 4; p[0] = v[i][0]; p[1] = v[i][1]; p[2] = v[i][2]; p[3] = v[i][3]; }
    LDS_WAIT(); asm volatile("" ::: "memory");
    const int c = lane & 7;
    f32x4 k0v = (f32x4){sc, sc, sc, sc}, k1v = k0v;
    if (ks) { k0v = *(const f32x4*)(ks + 8 * c) * sc; k1v = *(const f32x4*)(ks + 8 * c + 4) * sc; }
#pragma unroll
    for (int j = 0; j < 8; ++j) { const int n = (lane >> 3) + 8 * j; const LAS float* s = scr + (8 * c) * 65 + n; const float nsv = ns ? ns[n] : 1.0f;
        u32x4 o; o.x = cvt_pk_bf16(s[0 * 65] * k0v[0] * nsv, s[1 * 65] * k0v[1] * nsv); o.y = cvt_pk_bf16(s[2 * 65] * k0v[2] * nsv, s[3 * 65] * k0v[3] * nsv);
        o.z = cvt_pk_bf16(s[4 * 65] * k1v[0] * nsv, s[5 * 65] * k1v[1] * nsv); o.w = cvt_pk_bf16(s[6 * 65] * k1v[2] * nsv, s[7 * 65] * k1v[3] * nsv);
        *(u32x4*)(dst + (size_t)n * ldd + 8 * c) = o;
        if (dstz) *(u32x4*)(dstz + (size_t)n * ldd + 8 * c) = (u32x4){0u, 0u, 0u, 0u}; }
    LDS_WAIT(); asm volatile("" ::: "memory");
}

template <class T> __device__ __forceinline__ T* uniform_ptr(T* p) {
    const unsigned long long v = (unsigned long long)p; const unsigned lo = __builtin_amdgcn_readfirstlane((unsigned)v), hi = __builtin_amdgcn_readfirstlane((unsigned)(v >> 32));
    return (T*)(((unsigned long long)hi << 32) | lo);
}
struct Args { const float* in[25]; float* out; unsigned char* ws; int step, phase; };

__device__ __forceinline__ void prologue(const Args& args, LAS unsigned char* lds, int lane, int wave, int bx, int G) {
    unsigned char* ws = args.ws;
    LAS float* scr = (LAS float*)(lds + wave * 16640);
    const int gw = bx * 8 + wave, NGW = G * 8;
    constexpr int I_GU = 32 * 88, N_GU = 16 * I_GU, I_D = 88 * 32, N_D = 8 * I_D, I_SQ = 32 * 32, N_SQ = 12 * I_SQ, I_IN = 32 * 64, N_IN = 2 * I_IN, I_OUT = 32 * 32, N_OUT = 2 * I_OUT,
                  I_P = 8 * 8, N_P = 8 * I_P, I_G = 4, N_G = 64 * I_G, NITEMS = N_GU + N_D + N_SQ + N_IN + N_OUT + N_P + N_G;
    for (int it = gw; it < NITEMS; it += NGW) {
        int r = it;
        if (r < N_GU) { const int mat = r / I_GU, item = r % I_GU, lw = mat >> 1, up = mat & 1, k0 = (item / 88) * 64, n0 = (item % 88) * 64;
            tr_item((up ? args.in[4] : args.in[3]) + (size_t)lw * D * FF + (size_t)k0 * FF + n0, FF,
                    (bf16_t*)(ws + WS_WGU) + (size_t)lw * (2 * FF) * D + (size_t)(256 * (n0 >> 7) + (n0 & 127) + up * 128) * D + k0, D, args.in[2] + lw * D + k0, nullptr, 1.0f, nullptr, scr, lane); continue; }
        r -= N_GU;
        if (r < N_D) { const int lw = r / I_D, item = r % I_D, k0 = (item / 32) * 64, n0 = (item % 32) * 64;
            tr_item(args.in[5] + (size_t)lw * FF * D + (size_t)k0 * D + n0, D, (bf16_t*)(ws + WS_WD) + (size_t)lw * D * FF + (size_t)n0 * FF + k0, FF, nullptr, nullptr, 1.0f, nullptr, scr, lane); continue; }
        r -= N_D;
        if (r < N_SQ) { const int mat = r / I_SQ, item = r % I_SQ, which = mat >> 2, L = mat & 3, k0 = (item / 32) * 64, n0 = (item % 32) * 64;
            tr_item((which == 0 ? args.in[21] : which == 1 ? args.in[22] : args.in[23]) + (size_t)L * D * D + (size_t)k0 * D + n0, D,
                    (bf16_t*)(ws + WS_WK + (size_t)which * 32 * MiB) + (size_t)L * D * D + (size_t)n0 * D + k0, D, nullptr, nullptr, 1.0f, nullptr, scr, lane); continue; }
        r -= N_SQ;
        if (r < N_IN) { const int j = r / I_IN, item = r % I_IN, k0 = (item / 64) * 64, n0 = (item % 64) * 64;
            tr_item(args.in[9] + (size_t)j * D * 4096 + (size_t)k0 * 4096 + n0, 4096, (bf16_t*)(ws + WS_WIN) + (size_t)j * 4096 * D + (size_t)n0 * D + k0, D, args.in[6] + (2 * j + 1) * D + k0, nullptr, 1.0f, nullptr, scr, lane); continue; }
        r -= N_IN;
        if (r < N_OUT) { const int j = r / I_OUT, item = r % I_OUT, k0 = (item / 32) * 64, n0 = (item % 32) * 64;
            tr_item(args.in[17] + (size_t)j * D * D + (size_t)k0 * D + n0, D, (bf16_t*)(ws + WS_WOUT) + (size_t)j * D * D + (size_t)n0 * D + k0, D, nullptr, nullptr, 1.0f, nullptr, scr, lane); continue; }
        r -= N_OUT;
        if (r < N_P) { const int mat = r / I_P, item = r % I_P, j = mat >> 2, g = mat & 3, k0 = (item / 8) * 64, n0 = (item % 8) * 64;
            tr_item(args.in[7] + (size_t)mat * 512 * 512 + (size_t)k0 * 512 + n0, 512, (bf16_t*)(ws + WS_WP) + (size_t)j * D * 512 + (size_t)(g * 512 + n0) * 512 + k0, 512,
                    args.in[6] + (2 * j) * D + g * 512 + k0, args.in[8] + j * D + g * 512 + n0, 1.0f, nullptr, scr, lane); continue; }
        r -= N_P;
        { const int mat = r / I_G, item = r % I_G, j = mat >> 5, isx = (mat >> 4) & 1, hh = mat & 15, k0 = (item >> 1) * 64, n0 = (item & 1) * 64;
            bf16_t* rowp = (bf16_t*)(ws + WS_WGATE) + (size_t)j * 4096 * 256 + (size_t)(hh * 256 + isx * 128 + n0) * 256;
            tr_item((isx ? args.in[14] : args.in[12]) + (size_t)(j * 16 + hh) * 128 * 128 + (size_t)k0 * 128 + n0, 128, rowp + (hh & 1) * 128 + k0, 256, nullptr, nullptr, 1.0f, rowp + ((hh & 1) ^ 1) * 128 + k0, scr, lane); }
    }
    { bf16_t* wqn = (bf16_t*)(ws + WS_WQN);
      for (int row = gw; row < 4 * D; row += NGW) { const float sck = args.in[18][row] * 0.04419417382415922f; const f32x4* xr = (const f32x4*)(args.in[20] + (size_t)row * D) + lane; u32x2* br = (u32x2*)(wqn + (size_t)row * D) + lane;
#pragma unroll
          for (int j = 0; j < 8; ++j) { const f32x4 v = xr[64 * j] * sck; u32x2 w; w.x = cvt_pk_bf16(v[0], v[1]); w.y = cvt_pk_bf16(v[2], v[3]); br[64 * j] = w; } } }
    { const float* x = args.in[0]; float* h = args.out; bf16_t* hb = (bf16_t*)(ws + WS_HB); float* part = (float*)(ws + WS_PART);
      for (int row = gw; row < M; row += NGW) { const f32x4* xr = (const f32x4*)(x + (size_t)row * D) + lane; f32x4 v[8]; float ss = 0.f;
#pragma unroll
          for (int j = 0; j < 8; ++j) { v[j] = xr[64 * j]; ss += (v[j][0] * v[j][0] + v[j][1] * v[j][1]) + (v[j][2] * v[j][2] + v[j][3] * v[j][3]); }
          ss = wave_sum(ss);
          f32x4* hr = (f32x4*)(h + (size_t)row * D) + lane; u32x2* br = (u32x2*)(hb + (size_t)row * D) + lane;
#pragma unroll
          for (int j = 0; j < 8; ++j) { hr[64 * j] = v[j]; u32x2 w; w.x = cvt_pk_bf16(v[j][0], v[j][1]); w.y = cvt_pk_bf16(v[j][2], v[j][3]); br[64 * j] = w; }
          if (lane < 32) part[(size_t)row * 32 + lane] = lane == 0 ? ss : 0.f; } }
    { const float* mem = args.in[1]; const float* g = args.in[19]; bf16_t* mb = (bf16_t*)(ws + WS_MB);
      for (int row = gw; row < MM; row += NGW) { const f32x4* xr = (const f32x4*)(mem + (size_t)row * D) + lane; f32x4 v[8]; float ss = 0.f;
#pragma unroll
          for (int j = 0; j < 8; ++j) { v[j] = xr[64 * j]; ss += (v[j][0] * v[j][0] + v[j][1] * v[j][1]) + (v[j][2] * v[j][2] + v[j][3] * v[j][3]); }
          const float rs = rsqrtf(wave_sum(ss) * (1.0f / 2048.0f) + EPS); u32x2* br = (u32x2*)(mb + (size_t)row * D) + lane;
#pragma unroll
          for (int j = 0; j < 8; ++j) { const f32x4 gv = *((const f32x4*)g + lane + 64 * j); const f32x4 o = v[j] * rs * gv; u32x2 w; w.x = cvt_pk_bf16(o[0], o[1]); w.y = cvt_pk_bf16(o[2], o[3]); br[64 * j] = w; } } }
    { const float* lam = args.in[16]; float* sp = (float*)(ws + WS_SP);
      for (int i = gw * 64 + lane; i < 2 * D; i += NGW * 64) { const float z = -lam[i]; sp[i] = 8.0f * (fmaxf(z, 0.f) + log1pf(expf(-fabsf(z)))); } }
}

constexpr int PD = 256 * D * 2;
typedef pg8::Sched<M,      2 * FF,  D,   D,    D,      PD,            0,       0,   PD,             0,                0> ShGU;
typedef pg8::Sched<M,      D,       FF,  FF,   FF,     256 * FF * 2,  0,       0,   256 * FF * 2,   0,                0> ShDown;
typedef pg8::Sched<M,      D,       512, D,    512,    PD,            512 * 2, 1,   256 * 512 * 2,  0,                0> ShPool;
typedef pg8::Sched<M,      2 * D,   D,   D,    D,      PD,            0,       0,   PD,             0,                0> ShLruIn;
typedef pg8::Sched<M,      2 * D,   256, D,    256,    PD,            256 * 2, 1,   256 * 256 * 2,  0,                0> ShGates;
typedef pg8::Sched<M,      D,       D,   D,    D,      PD,            0,       0,   PD,             0,                0> ShDD;
typedef pg8::Sched<M,      NH*MEML, D,   D,    D,      PD,            0,       0,   256 * D * 2,    1024 * D * 2,     4> ShScore;
typedef pg8::Sched<M,      D,       1024, 1024, 4096,  256 * 1024 * 2, 0,      0,   256 * 4096 * 2, 1024 * 2,         4> ShAO;
typedef pg8::Sched<MM,     8 * D,   D,   D,    D,      PD,            0,       0,   PD,             0,                0> ShKV;

__device__ __forceinline__ unsigned long long launder_u64(unsigned long long v) {
    unsigned lo = (unsigned)v, hi = (unsigned)(v >> 32); asm volatile("" : "+v"(lo), "+v"(hi));
    return ((unsigned long long)(unsigned)__builtin_amdgcn_readfirstlane(hi) << 32) | (unsigned)__builtin_amdgcn_readfirstlane(lo);
}
#define PHASE_VARS() int tid = threadIdx.x; asm volatile("" : "+v"(tid)); unsigned char* ws = (unsigned char*)launder_u64((unsigned long long)args.ws); float* h = (float*)launder_u64((unsigned long long)args.out); \
    bf16_t* hb = (bf16_t*)(ws + WS_HB); float* part = (float*)(ws + WS_PART); (void)tid; (void)h; (void)hb; (void)part
__global__ void __launch_bounds__(512, 2) mk_fwd(Args args) {
    extern __shared__ __attribute__((aligned(16))) unsigned char lds_raw[];
    LAS unsigned char* lds = (LAS unsigned char*)lds_raw;
    const int G = gridDim.x, bx = blockIdx.x;
#if MK_SINGLE
    volatile LAS unsigned* MISC = (volatile LAS unsigned*)(lds + MISC_OFF);
    if (threadIdx.x < 32) MISC[threadIdx.x] = 0u;
    __syncthreads();
    XcdBarrier bar = xcd_barrier_post((unsigned*)(args.ws + WS_CTL) + CW_BAR, MISC + 8);
#define GRID_BAR() xcd_barrier(bar)
#define PH(k) true
    const int s_lo = 0, s_hi = 8; const bool do_pro = true, do_fin = true;
#else
#define GRID_BAR() do {} while (0)
#define PH(k) (args.phase == (k))
    const int s_lo = args.step, s_hi = (args.step >= 0 && args.step < 8) ? args.step + 1 : args.step; const bool do_pro = args.step == -1, do_fin = args.step == 8;
#endif

    if (do_pro) {
        if (PH(0)) { for (int rep = 0; rep < REP_PRO; ++rep) { PHASE_VARS(); prologue(args, lds, tid & 63, __builtin_amdgcn_readfirstlane(tid >> 6), bx, G); GRID_BAR(); } }
        if (PH(1)) {
            PHASE_VARS(); ShKV S{(const char*)(ws + WS_MB), (const char*)(ws + WS_WK), G, bx}; pg8::EpiPlain E{(bf16_t*)(ws + WS_KV), 8 * D}; pg8::gemm_phase<pg8::EpiPlain, true>(lds, S, E); GRID_BAR(); }
        if (PH(2)) {
            { PHASE_VARS(); pg8::SchedG S{(const char*)(ws + WS_KV), (const char*)(ws + WS_WQN), G, bx}; pg8::EpiPlain E{(bf16_t*)(ws + WS_GALL), D}; pg8::gemm_phase<pg8::EpiPlain, true>(lds, S, E); }
            { PHASE_VARS(); pg8::SchedH S{(const char*)(ws + WS_WO), (const char*)(ws + WS_KV), G, bx}; pg8::EpiPlain E{(bf16_t*)(ws + WS_HALL), 4096}; pg8::gemm_phase<pg8::EpiPlain, true>(lds, S, E); }
        }
    }
#pragma unroll 1
    for (int s = s_lo; s < s_hi; ++s) {
        const int L = s >> 1, lw = s;
        if (PH(0)) for (int rep = 0; rep < REP_GU; ++rep) { PHASE_VARS(); ShGU S{(const char*)hb, (const char*)(ws + WS_WGU) + (size_t)lw * (2 * FF) * D * 2, G, bx};
            pg8::EpiSwiGLU E{(bf16_t*)(ws + WS_ACT), part};
            pg8::gemm_phase<pg8::EpiSwiGLU, true>(lds, S, E); GRID_BAR(); }
        if (PH(1)) for (int rep = 0; rep < REP_DOWN; ++rep) { PHASE_VARS(); ShDown S{(const char*)(ws + WS_ACT), (const char*)(ws + WS_WD) + (size_t)lw * D * FF * 2, G, bx};
            pg8::EpiResid E{h, hb, part, rep == 0 ? 0.5f : 0.0f};
            pg8::gemm_phase<pg8::EpiResid, true>(lds, S, E); GRID_BAR(); }
        if ((s & 1) == 0) {
            const int j = L >> 1;
            if ((L & 1) == 0) {
                if (PH(2)) for (int rep = 0; rep < REP_THIN; ++rep) { PHASE_VARS(); bf16_t* pooled = (bf16_t*)(ws + WS_POOLED); LAS float* R = (LAS float*)lds;
                    for (int blk = bx; blk < M / 64; blk += G) { const int t0 = blk * 64, seq0 = (t0 / SEQ) * SEQ;
                        if (tid < 79) { const int row = t0 - 15 + tid; float rs = 0.f;
                            if (row >= seq0) { const f32x4* p = (const f32x4*)(part + (size_t)row * 32); float sacc = 0.f;
#pragma unroll
                                for (int q = 0; q < 8; ++q) { const f32x4 a = p[q]; sacc += (a[0] + a[1]) + (a[2] + a[3]); }
                                rs = rsqrtf(sacc * (1.0f / 2048.0f) + EPS); }
                            R[tid] = rs; }
                        __syncthreads();
                        const int w = 2 << (tid >> 7); const float* hc = h + 4 * tid; f32x4 S4 = (f32x4){0.f, 0.f, 0.f, 0.f};
                        for (int r = t0 - (w - 1); r < t0; ++r) if (r >= seq0) S4 = S4 + *(const f32x4*)(hc + (size_t)r * D) * R[r - t0 + 15];
#pragma unroll 4
                        for (int t = t0; t < t0 + 64; ++t) { const f32x4 uv = *(const f32x4*)(hc + (size_t)t * D) * R[t - t0 + 15]; S4 = S4 + uv; const int tt = t - seq0;
                            if (t > t0 && tt >= w) S4 = S4 - *(const f32x4*)(hc + (size_t)(t - w) * D) * R[t - w - t0 + 15];
                            const float ic = 1.0f / (float)(tt + 1 < w ? tt + 1 : w); const f32x4 o = S4 * ic - uv;
                            u32x2 pk; pk.x = cvt_pk_bf16(o[0], o[1]); pk.y = cvt_pk_bf16(o[2], o[3]); *(u32x2*)(pooled + (size_t)t * D + 4 * tid) = pk; }
                        __syncthreads(); }
                    GRID_BAR(); }
                if (PH(3)) { PHASE_VARS(); ShPool S{(const char*)(ws + WS_POOLED), (const char*)(ws + WS_WP) + (size_t)j * D * 512 * 2, G, bx};
                    pg8::EpiResid E{h, hb, part, 1.0f};
                    pg8::gemm_phase<pg8::EpiResid, true>(lds, S, E); GRID_BAR(); }
            } else {
                if (PH(2)) { PHASE_VARS(); ShLruIn S{(const char*)hb, (const char*)(ws + WS_WIN) + (size_t)j * 4096 * D * 2, G, bx};
                    pg8::EpiLruIn E{(bf16_t*)(ws + WS_GG), (float*)(ws + WS_XR), part};
                    pg8::gemm_phase<pg8::EpiLruIn, true>(lds, S, E); GRID_BAR(); }
                if (PH(3)) for (int rep = 0; rep < REP_THIN; ++rep) { PHASE_VARS(); const float* xr = (const float*)(ws + WS_XR); bf16_t* xcb = (bf16_t*)(ws + WS_XCB);
                    const float* cw = args.in[10] + (size_t)j * 4 * D + 4 * tid; const f32x4 w0 = *(const f32x4*)cw, w1 = *(const f32x4*)(cw + D), w2 = *(const f32x4*)(cw + 2 * D), w3 = *(const f32x4*)(cw + 3 * D);
                    const f32x4 cb = *(const f32x4*)(args.in[11] + (size_t)j * D + 4 * tid);
                    for (int blk = bx; blk < M / 64; blk += G) { const int t0 = blk * 64, seq0 = (t0 / SEQ) * SEQ; const float* xp = xr + 4 * tid; const f32x4 z = (f32x4){0.f, 0.f, 0.f, 0.f};
                        f32x4 x0 = t0 > seq0 ? *(const f32x4*)(xp + (size_t)(t0 - 3) * D) : z, x1 = t0 > seq0 ? *(const f32x4*)(xp + (size_t)(t0 - 2) * D) : z, x2 = t0 > seq0 ? *(const f32x4*)(xp + (size_t)(t0 - 1) * D) : z;
#pragma unroll 8
                        for (int t = t0; t < t0 + 64; ++t) { const f32x4 x3 = *(const f32x4*)(xp + (size_t)t * D); const f32x4 o = cb + x0 * w0 + x1 * w1 + x2 * w2 + x3 * w3;
                            u32x2 pk; pk.x = cvt_pk_bf16(o[0], o[1]); pk.y = cvt_pk_bf16(o[2], o[3]); *(u32x2*)(xcb + (size_t)t * D + 4 * tid) = pk;
                            x0 = x1; x1 = x2; x2 = x3; } }
                    GRID_BAR(); }
                if (PH(4)) { PHASE_VARS(); ShGates S{(const char*)(ws + WS_XCB), (const char*)(ws + WS_WGATE) + (size_t)j * 4096 * 256 * 2, G, bx};
                    pg8::EpiGates E{(float*)(ws + WS_XR), (float*)(ws + WS_BT), (const bf16_t*)(ws + WS_XCB), args.in[13] + (size_t)j * D, args.in[15] + (size_t)j * D, (const float*)(ws + WS_SP) + (size_t)j * D};
                    pg8::gemm_phase<pg8::EpiGates, true>(lds, S, E); GRID_BAR(); }
                if (PH(5)) for (int rep = 0; rep < REP_THIN; ++rep) { PHASE_VARS(); const float* av = (const float*)(ws + WS_XR); const float* bv = (const float*)(ws + WS_BT); float* chA = (float*)(ws + WS_CHA); float* chB = (float*)(ws + WS_CHB);
                    for (int blk = bx; blk < M / 64; blk += G) { const int t0 = blk * 64; f32x4 Ap = (f32x4){1.f, 1.f, 1.f, 1.f}, Hs = (f32x4){0.f, 0.f, 0.f, 0.f};
#pragma unroll 8
                        for (int t = t0; t < t0 + 64; ++t) { const f32x4 a4 = *(const f32x4*)(av + (size_t)t * D + 4 * tid), b4 = *(const f32x4*)(bv + (size_t)t * D + 4 * tid); Hs = a4 * Hs + b4; Ap = Ap * a4; }
                        *(f32x4*)(chA + (size_t)blk * D + 4 * tid) = Ap; *(f32x4*)(chB + (size_t)blk * D + 4 * tid) = Hs; }
                    GRID_BAR(); }
                if (PH(6)) for (int rep = 0; rep < REP_THIN; ++rep) { PHASE_VARS(); const float* av = (const float*)(ws + WS_XR); const float* bv = (const float*)(ws + WS_BT); const float* chA = (const float*)(ws + WS_CHA); const float* chB = (const float*)(ws + WS_CHB);
                    const bf16_t* gg = (const bf16_t*)(ws + WS_GG); bf16_t* yb = (bf16_t*)(ws + WS_XCB);
                    for (int blk = bx; blk < M / 64; blk += G) { const int t0 = blk * 64, c0 = (blk / 64) * 64; f32x4 Hs = (f32x4){0.f, 0.f, 0.f, 0.f};
                        for (int c = c0; c < blk; ++c) { const f32x4 a4 = *(const f32x4*)(chA + (size_t)c * D + 4 * tid), b4 = *(const f32x4*)(chB + (size_t)c * D + 4 * tid); Hs = a4 * Hs + b4; }
#pragma unroll 8
                        for (int t = t0; t < t0 + 64; ++t) { const f32x4 a4 = *(const f32x4*)(av + (size_t)t * D + 4 * tid), b4 = *(const f32x4*)(bv + (size_t)t * D + 4 * tid); Hs = a4 * Hs + b4;
                            const u32x2 gk = *(const u32x2*)(gg + (size_t)t * D + 4 * tid);
                            const float g0 = __uint_as_float(gk.x << 16), g1 = __uint_as_float(gk.x & 0xffff0000u), g2 = __uint_as_float(gk.y << 16), g3 = __uint_as_float(gk.y & 0xffff0000u);
                            u32x2 pk; pk.x = cvt_pk_bf16(Hs[0] * g0, Hs[1] * g1); pk.y = cvt_pk_bf16(Hs[2] * g2, Hs[3] * g3); *(u32x2*)(yb + (size_t)t * D + 4 * tid) = pk; } }
                    GRID_BAR(); }
                if (PH(7)) { PHASE_VARS(); ShDD S{(const char*)(ws + WS_XCB), (const char*)(ws + WS_WOUT) + (size_t)j * D * D * 2, G, bx};
                    pg8::EpiResid E{h, hb, part, 1.0f};
                    pg8::gemm_phase<pg8::EpiResid, true>(lds, S, E); GRID_BAR(); }
            }
            if (PH(8)) { PHASE_VARS(); ShScore S{(const char*)hb, (const char*)(ws + WS_GALL) + (size_t)L * 4096 * D * 2, G, bx};
                pg8::EpiSoftmax E{(bf16_t*)(ws + WS_P), part};
                pg8::gemm_phase<pg8::EpiSoftmax, false>(lds, S, E); GRID_BAR(); }
            if (PH(9)) for (int rep = 0; rep < REP_RES2K; ++rep) { PHASE_VARS(); ShAO S{(const char*)(ws + WS_P), (const char*)(ws + WS_HALL) + (size_t)L * D * 4096 * 2, G, bx};
                pg8::EpiResid E{h, hb, part, rep == 0 ? 1.0f : 0.0f};
                pg8::gemm_phase<pg8::EpiResid, true>(lds, S, E); GRID_BAR(); }
        }
    }
    if (do_fin) { PHASE_VARS(); const float* g = args.in[24]; const int lane = tid & 63, gw = bx * 8 + (tid >> 6), NGW = G * 8;
        for (int row = gw; row < M; row += NGW) { f32x4* xr = (f32x4*)(h + (size_t)row * D) + lane; f32x4 v[8]; float ss = 0.f;
#pragma unroll
            for (int jj = 0; jj < 8; ++jj) { v[jj] = xr[64 * jj]; ss += (v[jj][0] * v[jj][0] + v[jj][1] * v[jj][1]) + (v[jj][2] * v[jj][2] + v[jj][3] * v[jj][3]); }
            const float rs = rsqrtf(wave_sum(ss) * (1.0f / 2048.0f) + EPS);
#pragma unroll
            for (int jj = 0; jj < 8; ++jj) { const f32x4 gv = *((const f32x4*)g + lane + 64 * jj); xr[64 * jj] = v[jj] * rs * gv; } } }
}

extern "C" void kernel_launch(void* const* d_in, const int* in_sizes, int n_in, void* d_out, int out_size, void* d_ws, size_t ws_size, hipStream_t stream) {
    static int grid = 0;
    if (grid == 0) {
        if (n_in != 25 || in_sizes[0] != M * D || out_size != M * D || ws_size < WS_END) { fprintf(stderr, "kernel_launch: unexpected shapes (n_in %d, in0 %d, out %d, ws %zu, need %zu); nothing launched\n", n_in, n_in > 0 ? in_sizes[0] : -1, out_size, ws_size, (size_t)WS_END); grid = -1; return; }
        int dev = 0, cus = 0, per_cu = 0;
        if (hipGetDevice(&dev) != hipSuccess || hipDeviceGetAttribute(&cus, hipDeviceAttributeMultiprocessorCount, dev) != hipSuccess) { fprintf(stderr, "kernel_launch: device query failed\n"); grid = -1; return; }
        if (hipFuncSetAttribute((const void*)mk_fwd, hipFuncAttributeMaxDynamicSharedMemorySize, LDS_BYTES) != hipSuccess) { fprintf(stderr, "kernel_launch: hipFuncSetAttribute failed\n"); grid = -1; return; }
        if (hipOccupancyMaxActiveBlocksPerMultiprocessor(&per_cu, (const void*)mk_fwd, 512, LDS_BYTES) != hipSuccess || per_cu < 1) fprintf(stderr, "kernel_launch: occupancy query says %d\n", per_cu);
        (void)hipGetLastError();
        grid = cus;
        if (grid != 256) { fprintf(stderr, "kernel_launch: built for 256 CUs, found %d; nothing launched\n", cus); grid = -1; return; }
    }
    if (grid < 0) return;
    Args a{};
    for (int i = 0; i < 25; ++i) a.in[i] = (const float*)d_in[i];
    a.out = (float*)d_out; a.ws = (unsigned char*)d_ws;
#if MK_SINGLE
    if (hipMemsetAsync((char*)d_ws + WS_CTL, 0, CTL_ZERO_BYTES, stream) != hipSuccess) { fprintf(stderr, "kernel_launch: memset failed\n"); return; }
    a.step = 0; a.phase = 0;
    hipLaunchKernelGGL(mk_fwd, dim3(grid), dim3(512), LDS_BYTES, stream, a);
#else
    auto launch = [&](int s, int p) { a.step = s; a.phase = p; hipLaunchKernelGGL(mk_fwd, dim3(grid), dim3(512), LDS_BYTES, stream, a); };
    launch(-1, 0); launch(-1, 1); launch(-1, 2);
    for (int s = 0; s < 8; ++s) { launch(s, 0); launch(s, 1);
        if ((s & 1) == 0) { const int L = s >> 1;
            if ((L & 1) == 0) { launch(s, 2); launch(s, 3); } else { for (int p = 2; p <= 7; ++p) launch(s, p); }
            for (int p = 8; p <= 9; ++p) launch(s, p); } }
    launch(8, 0);
#endif
    const hipError_t le = hipPeekAtLastError();
    if (le != hipSuccess) fprintf(stderr, "kernel_launch: launch failed: %s\n", hipGetErrorName(le));
}
```

```cpp
#include <hip/hip_runtime.h>
#include <cstdio>
#include <cstdint>

#ifndef MK_SINGLE
#define MK_SINGLE 1
#endif

#ifndef PROF_TAG
#define PROF_TAG 0
#endif
#define PROF_NOW() __builtin_amdgcn_s_memrealtime()
#ifndef DOWN_WGM
#define DOWN_WGM 4
#endif
#ifndef DOWN_KREV
#define DOWN_KREV true
#endif
#ifndef REP_PRO
#define REP_PRO 1
#endif
#ifndef REP_GU
#define REP_GU 1
#endif
#ifndef REP_DOWN
#define REP_DOWN 1
#endif
#ifndef REP_THIN
#define REP_THIN 1
#endif
#ifndef STAGGER_TICKS
#define STAGGER_TICKS 0
#endif
#ifndef STAGGER_GROUPS
#define STAGGER_GROUPS 2
#endif
#ifndef STAGGER_GU_TICKS
#define STAGGER_GU_TICKS 0
#endif
#ifndef STAGGER_GU_GROUPS
#define STAGGER_GU_GROUPS 4
#endif
#ifndef REP_RES2K
#define REP_RES2K 1
#endif
#define LAS __attribute__((address_space(3)))
#define GAS __attribute__((address_space(1)))
typedef unsigned short bf16_t;
typedef short bf16x8 __attribute__((ext_vector_type(8)));
typedef float f32x4 __attribute__((ext_vector_type(4)));
typedef float f32x2 __attribute__((ext_vector_type(2)));
typedef unsigned u32x4 __attribute__((ext_vector_type(4)));
typedef unsigned u32x2 __attribute__((ext_vector_type(2)));
typedef GAS unsigned gu32;
#define LDS_WAIT() asm volatile("s_waitcnt lgkmcnt(0)" ::: "memory")
#define VM_WAIT() asm volatile("s_waitcnt vmcnt(0)" ::: "memory")

__device__ __forceinline__ unsigned cvt_pk_bf16(float lo, float hi) { unsigned r; asm volatile("v_cvt_pk_bf16_f32 %0, %1, %2" : "=v"(r) : "v"(lo), "v"(hi)); return r; }
typedef _Float16 f16x2 __attribute__((ext_vector_type(2)));
typedef _Float16 f16x8 __attribute__((ext_vector_type(8)));
__device__ __forceinline__ unsigned cvt_pk_f16(float lo, float hi) { const f16x2 v = {(_Float16)lo, (_Float16)hi}; return __builtin_bit_cast(unsigned, v); }
#ifndef H_TRIM
#define H_TRIM 2
#endif
__device__ __forceinline__ unsigned cvt_pk_h(float lo, float hi) { const unsigned w = cvt_pk_f16(lo, hi);
    if constexpr (H_TRIM > 0) { constexpr unsigned almost_half = ((1u << (H_TRIM - 1)) - 1u) * 0x00010001u, mask = ~(((1u << H_TRIM) - 1u) * 0x00010001u);
        return (w + almost_half + ((w >> H_TRIM) & 0x00010001u)) & mask; } else return w; }
template <bool F16> __device__ __forceinline__ unsigned cvt_pk16(float lo, float hi) { const unsigned b = cvt_pk_bf16(lo, hi); if constexpr (F16) return cvt_pk_f16(__uint_as_float(b << 16), __uint_as_float(b & 0xffff0000u)); else return b; }
__device__ __forceinline__ f32x4 f16x4_to_f32(u32x2 k) { const unsigned ka = k.x, kb = k.y; const f16x2 a = __builtin_bit_cast(f16x2, ka); const f16x2 b = __builtin_bit_cast(f16x2, kb);
    return (f32x4){(float)a.x, (float)a.y, (float)b.x, (float)b.y}; }
__device__ __forceinline__ f32x4 bf16x4_to_f32(u32x2 k) { return (f32x4){__uint_as_float(k.x << 16), __uint_as_float(k.x & 0xffff0000u), __uint_as_float(k.y << 16), __uint_as_float(k.y & 0xffff0000u)}; }
__device__ __forceinline__ float wave_sum(float v) {
#pragma unroll
    for (int o = 1; o < 64; o <<= 1) v += __shfl_xor(v, o);
    return v;
}
__device__ __forceinline__ float fast_sigmoid(float x) { return __builtin_amdgcn_rcpf(1.0f + __builtin_amdgcn_exp2f(-1.44269504089f * x)); }

constexpr int BATCH = 4, SEQ = 4096, D = 2048, DEPTH = 4, FF = 5632, MEML = 256, NH = 4, HD = 512, LH = 16;
constexpr int M = BATCH * SEQ;
constexpr int MM = BATCH * MEML;
constexpr float EPS = 1e-6f;

namespace pg8 {
constexpr int BM = 256, BK = 64, HALF = 128, HTB = HALF * BK * 2, STAGE_BYTES = 8 * HTB, NXCD = 8;
__host__ __device__ __forceinline__ int lds_byte(int r, int c) { const int st = (r >> 4) * 2 + (c >> 5), rr = r & 15, cc = c & 31, ob = rr * 64 + cc * 2; return st * 1024 + (ob ^ (((ob >> 9) & 1) << 5)); }
__host__ __device__ __forceinline__ void stage_rc(int b, int& R, int& C) { const int st = b / 1024, sb = b % 1024, swz = sb ^ (((sb >> 9) & 1) << 5); R = (st >> 1) * 16 + swz / 64; C = (st & 1) * 32 + (swz % 64) / 2; }
__host__ __device__ __forceinline__ int perm32(int rho) { const int n = rho >> 4, i = rho & 15; return 8 * (i >> 2) + 4 * n + (i & 3); }

struct Unit { int pm, pn; const char* a; const char* b; };

template <int nM, int nN, int WGM = 8> __device__ __forceinline__ bool unit_order(int i, int G, int c, int& pm, int& pn) {
    constexpr int nwg = nM * nN;
    const int L = i * G + c; if (L >= nwg) return false;
    int wgid = L; { constexpr int q = nwg / NXCD, r = nwg % NXCD; const int xcd = wgid % NXCD, off = wgid / NXCD; wgid = (xcd < r ? xcd * (q + 1) : r * (q + 1) + (xcd - r) * q) + off; }
    constexpr int nig = WGM * nN; const int gid = wgid / nig, fm = gid * WGM, gsz = (nM - fm) < WGM ? (nM - fm) : WGM;
    pm = fm + ((wgid % nig) % gsz); pn = (wgid % nig) / gsz; return true;
}
template <int MR, int NC, int K_, int LDA, int LDB, int APM, int APN, int ASH, int BPN, int BPM, int BSH, bool KREV_ = false, bool F16_ = false, int WGM_ = 8>
struct Sched {
    static constexpr int K = K_, lda = LDA, ldb = LDB; static constexpr bool KREV = KREV_, F16 = F16_;
    const char* A; const char* B; int G, c;
    __device__ __forceinline__ bool next(int i, Unit& u) const {
        if (!unit_order<MR / BM, NC / BM, WGM_>(i, G, c, u.pm, u.pn)) return false;
        u.a = A + (size_t)u.pm * APM + (size_t)(u.pn >> ASH) * APN + (KREV ? (K - BK) * 2 : 0); u.b = B + (size_t)u.pn * BPN + (size_t)(u.pm >> BSH) * BPM + (KREV ? (K - BK) * 2 : 0); return true;
    }
};
struct SchedG {
    static constexpr int K = 512, lda = 16384, ldb = 2048; static constexpr bool KREV = false, F16 = false;
    const char* KV; const char* WQN; int G, c;
    __device__ __forceinline__ bool next(int i, Unit& u) const {
        if (!unit_order<64, 8>(i, G, c, u.pm, u.pn)) return false;
        const int L = u.pm >> 4, b = (u.pm >> 2) & 3, h = u.pm & 3;
        u.a = KV + ((size_t)(b * 256) * 16384 + L * 2048 + h * 512) * 2; u.b = WQN + ((size_t)L * 2048 * 2048 + (size_t)u.pn * 256 * 2048 + h * 512) * 2; return true;
    }
};
struct SchedH {
    static constexpr int K = 512, lda = 2048, ldb = 16384; static constexpr bool KREV = false, F16 = false;
    const char* WOT; const char* KV; int G, c;
    __device__ __forceinline__ bool next(int i, Unit& u) const {
        if (!unit_order<32, 16>(i, G, c, u.pm, u.pn)) return false;
        const int L = u.pm >> 3, b = u.pn >> 2, h = u.pn & 3;
        u.a = WOT + ((size_t)u.pm * 256 * 2048 + h * 512) * 2; u.b = KV + ((size_t)(b * 256) * 16384 + 8192 + L * 2048 + h * 512) * 2; return true;
    }
};

__device__ __forceinline__ float row_rstd(const float* part, int row, int fq) {
    const f32x4* p = (const f32x4*)(part + (size_t)row * 32 + fq * 8);
    const f32x4 a = p[0], b = p[1];
    float s = ((a.x + a.y) + (a.z + a.w)) + ((b.x + b.y) + (b.z + b.w));
    s += __shfl_xor(s, 16); s += __shfl_xor(s, 32);
    return rsqrtf(s * (1.0f / 2048.0f) + EPS);
}

__device__ __forceinline__ void rstd_table(LAS float* tbl, const float* part, int pm, int tid) {
    if (tid < 256) { const f32x4* p = (const f32x4*)(part + (size_t)(pm * BM + tid) * 32); float sm = 0.f;
#pragma unroll
        for (int q = 0; q < 8; ++q) { const f32x4 a = p[q]; sm += (a[0] + a[1]) + (a[2] + a[3]); }
        tbl[tid] = rsqrtf(sm * (1.0f / 2048.0f) + EPS); }
    if (tid == 0) ((LAS int*)tbl)[256] = pm;
}
#define EPI_NO_PREPARE __device__ __forceinline__ void prepare(const Unit&, int) const {}
struct EpiSwiGLU {
    static constexpr bool PERM = true, AFTER_DRAIN = false, IS_RESID = false, IS_GU = true;
    bf16_t* O; const float* part; LAS float* tbl;
    __device__ __forceinline__ void prepare(const Unit& u, int tid) const { rstd_table(tbl, part, u.pm, tid); }
    __device__ __forceinline__ void operator()(f32x4 (&acc)[2][2][4][2], const Unit& u, int wr, int wc, int fr, int fq) const {
        const int row0 = u.pm * BM + wr * 64 + fr, col0 = u.pn * HALF + wc * 32 + 8 * fq;
        const bool tb = __builtin_amdgcn_readfirstlane(((const LAS int*)tbl)[256]) == u.pm;
#pragma unroll
        for (int ai = 0; ai < 2; ++ai)
#pragma unroll
            for (int m = 0; m < 4; ++m) { const int row = row0 + ai * HALF + m * 16; const float rs = tb ? tbl[ai * HALF + wr * 64 + m * 16 + fr] : row_rstd(part, row, fq);
                const f32x2 rsl = (f32x2){-1.44269504089f * rs, -1.44269504089f * rs}, rs2 = (f32x2){rs * rs, rs * rs}; f32x2 o[4];
#pragma unroll
                for (int n = 0; n < 2; ++n)
#pragma unroll
                    for (int jp = 0; jp < 2; ++jp) { const f32x2 ag = (f32x2){acc[ai][0][m][n][2 * jp], acc[ai][0][m][n][2 * jp + 1]}, au = (f32x2){acc[ai][1][m][n][2 * jp], acc[ai][1][m][n][2 * jp + 1]};
                        const f32x2 t = ag * rsl; f32x2 d = (f32x2){__builtin_amdgcn_exp2f(t.x), __builtin_amdgcn_exp2f(t.y)}; d = d + 1.0f;
                        const f32x2 r = (f32x2){__builtin_amdgcn_rcpf(d.x), __builtin_amdgcn_rcpf(d.y)}; o[n * 2 + jp] = (ag * au) * (r * rs2); }
                u32x4 w; w.x = cvt_pk_bf16(o[0].x, o[0].y); w.y = cvt_pk_bf16(o[1].x, o[1].y); w.z = cvt_pk_bf16(o[2].x, o[2].y); w.w = cvt_pk_bf16(o[3].x, o[3].y);
                *(u32x4*)(O + (size_t)row * FF + col0) = w; }
    }
};
struct EpiResid {
    EPI_NO_PREPARE
    static constexpr bool PERM = true, AFTER_DRAIN = false, IS_RESID = true, IS_GU = false;
    bf16_t* hb; float* part; float alpha;
    __device__ __forceinline__ void load_half(u32x4 (&xk)[4][2], int ai, int row0, int col0) const {
#pragma unroll
        for (int m = 0; m < 4; ++m) { const bf16_t* bp = hb + (size_t)(row0 + ai * HALF + m * 16) * D + col0; xk[m][0] = *(const u32x4*)bp; xk[m][1] = *(const u32x4*)(bp + HALF); }
    }
    __device__ __forceinline__ void fold_half(f32x4 (&acc)[2][2][4][2], const u32x4 (&xk)[4][2], int ai) const {
#pragma unroll
        for (int m = 0; m < 4; ++m)
#pragma unroll
            for (int bj = 0; bj < 2; ++bj) { const u32x4 k = xk[m][bj];
                const f32x4 x0 = f16x4_to_f32((u32x2){k.x, k.y}), x1 = f16x4_to_f32((u32x2){k.z, k.w});
                acc[ai][bj][m][0] = x0 + acc[ai][bj][m][0] * alpha; acc[ai][bj][m][1] = x1 + acc[ai][bj][m][1] * alpha; }
    }
    __device__ __forceinline__ void store_half(const f32x4 (&acc)[2][2][4][2], int ai, int row0, int col0, int slot, int fq) const {
#pragma unroll
        for (int m = 0; m < 4; ++m) { const int row = row0 + ai * HALF + m * 16; bf16_t* bp = hb + (size_t)row * D + col0; float ss = 0.f;
#pragma unroll
            for (int bj = 0; bj < 2; ++bj) { const f32x4 x0 = acc[ai][bj][m][0], x1 = acc[ai][bj][m][1];
                u32x4 w; w.x = cvt_pk_h(x0[0], x0[1]); w.y = cvt_pk_h(x0[2], x0[3]); w.z = cvt_pk_h(x1[0], x1[1]); w.w = cvt_pk_h(x1[2], x1[3]);
                *(u32x4*)(bp + bj * HALF) = w;
                ss += ((x0[0] * x0[0] + x0[1] * x0[1]) + (x0[2] * x0[2] + x0[3] * x0[3])) + ((x1[0] * x1[0] + x1[1] * x1[1]) + (x1[2] * x1[2] + x1[3] * x1[3])); }
            ss += __shfl_xor(ss, 16); ss += __shfl_xor(ss, 32);
            if (fq == 0) part[(size_t)row * 32 + slot] = ss; }
    }
    __device__ __forceinline__ void operator()(f32x4 (&acc)[2][2][4][2], const Unit& u, int wr, int wc, int fr, int fq) const {
        const int row0 = u.pm * BM + wr * 64 + fr, col0 = u.pn * BM + wc * 32 + 8 * fq, slot = u.pn * 4 + wc;
        u32x4 xk[4][2], xk1[4][2];
        load_half(xk, 0, row0, col0);
#pragma unroll
        for (int m = 0; m < 3; ++m) { const bf16_t* bp = hb + (size_t)(row0 + HALF + m * 16) * D + col0; xk1[m][0] = *(const u32x4*)bp; xk1[m][1] = *(const u32x4*)(bp + HALF); }
        asm volatile("" ::: "memory");
        fold_half(acc, xk, 0); asm volatile("" ::: "memory");
        { const bf16_t* bp = hb + (size_t)(row0 + HALF + 3 * 16) * D + col0; xk1[3][0] = *(const u32x4*)bp; xk1[3][1] = *(const u32x4*)(bp + HALF); }
        asm volatile("" ::: "memory");
        store_half(acc, 0, row0, col0, slot, fq); asm volatile("" ::: "memory");
        fold_half(acc, xk1, 1);
        store_half(acc, 1, row0, col0, slot, fq);
    }
};
struct EpiRowScale {
    EPI_NO_PREPARE
    static constexpr bool PERM = true, AFTER_DRAIN = false, IS_RESID = false, IS_GU = false;
    bf16_t* O; int ldo; const float* part;
    __device__ __forceinline__ void operator()(f32x4 (&acc)[2][2][4][2], const Unit& u, int wr, int wc, int fr, int fq) const {
        const int row0 = u.pm * BM + wr * 64 + fr, col0 = u.pn * BM + wc * 32 + 8 * fq;
#pragma unroll
        for (int ai = 0; ai < 2; ++ai)
#pragma unroll
            for (int m = 0; m < 4; ++m) { const int row = row0 + ai * HALF + m * 16; const float rs = row_rstd(part, row, fq); bf16_t* rp = O + (size_t)row * ldo + col0;
#pragma unroll
                for (int bj = 0; bj < 2; ++bj) { const f32x4 v0 = acc[ai][bj][m][0] * rs, v1 = acc[ai][bj][m][1] * rs;
                    u32x4 w; w.x = cvt_pk_bf16(v0[0], v0[1]); w.y = cvt_pk_bf16(v0[2], v0[3]); w.z = cvt_pk_bf16(v1[0], v1[1]); w.w = cvt_pk_bf16(v1[2], v1[3]);
                    *(u32x4*)(rp + bj * HALF) = w; } }
    }
};
template <bool F16OUT> struct EpiPlain {
    EPI_NO_PREPARE
    static constexpr bool PERM = true, AFTER_DRAIN = false, IS_RESID = false, IS_GU = false;
    bf16_t* O; int ldo;
    __device__ __forceinline__ void operator()(f32x4 (&acc)[2][2][4][2], const Unit& u, int wr, int wc, int fr, int fq) const {
        const int row0 = u.pm * BM + wr * 64 + fr, col0 = u.pn * BM + wc * 32 + 8 * fq;
#pragma unroll
        for (int ai = 0; ai < 2; ++ai)
#pragma unroll
            for (int m = 0; m < 4; ++m) { bf16_t* rp = O + (size_t)(row0 + ai * HALF + m * 16) * ldo + col0;
#pragma unroll
                for (int bj = 0; bj < 2; ++bj) { const f32x4 v0 = acc[ai][bj][m][0], v1 = acc[ai][bj][m][1];
                    u32x4 w; w.x = cvt_pk16<F16OUT>(v0[0], v0[1]); w.y = cvt_pk16<F16OUT>(v0[2], v0[3]); w.z = cvt_pk16<F16OUT>(v1[0], v1[1]); w.w = cvt_pk16<F16OUT>(v1[2], v1[3]);
                    *(u32x4*)(rp + bj * HALF) = w; } }
    }
};
struct EpiLruIn {
    static constexpr bool PERM = true, AFTER_DRAIN = false, IS_RESID = false, IS_GU = false;
    bf16_t* gg; bf16_t* xr; const float* part; LAS float* tbl;
    __device__ __forceinline__ void prepare(const Unit& u, int tid) const { rstd_table(tbl, part, u.pm, tid); }
    __device__ __forceinline__ void operator()(f32x4 (&acc)[2][2][4][2], const Unit& u, int wr, int wc, int fr, int fq) const {
        const int row0 = u.pm * BM + wr * 64 + fr; const bool isg = u.pn < 8; const int col0 = (isg ? u.pn : u.pn - 8) * BM + wc * 32 + 8 * fq; bf16_t* O = isg ? gg : xr;
        const bool tb = __builtin_amdgcn_readfirstlane(((const LAS int*)tbl)[256]) == u.pm;
#pragma unroll
        for (int ai = 0; ai < 2; ++ai)
#pragma unroll
            for (int m = 0; m < 4; ++m) { const int row = row0 + ai * HALF + m * 16; const float rs = tb ? tbl[ai * HALF + wr * 64 + m * 16 + fr] : row_rstd(part, row, fq);
#pragma unroll
                for (int bj = 0; bj < 2; ++bj) { const f32x4 v0 = acc[ai][bj][m][0] * rs, v1 = acc[ai][bj][m][1] * rs; float o[8];
#pragma unroll
                    for (int j = 0; j < 8; ++j) { const float x = j < 4 ? v0[j] : v1[j - 4]; o[j] = isg ? x * fast_sigmoid(1.5957691216f * (x + 0.044715f * x * x * x)) : x; }
                    u32x4 w; w.x = cvt_pk_bf16(o[0], o[1]); w.y = cvt_pk_bf16(o[2], o[3]); w.z = cvt_pk_bf16(o[4], o[5]); w.w = cvt_pk_bf16(o[6], o[7]);
                    *(u32x4*)(O + (size_t)row * D + col0 + bj * HALF) = w; } }
    }
};
struct EpiGates {
    EPI_NO_PREPARE
    static constexpr bool PERM = true, AFTER_DRAIN = false, IS_RESID = false, IS_GU = false;
    bf16_t* LA; bf16_t* Bt; const bf16_t* xc; const float* ba; const float* bx; const float* sp8;
    __device__ __forceinline__ void operator()(f32x4 (&acc)[2][2][4][2], const Unit& u, int wr, int wc, int fr, int fq) const {
        const int row0 = u.pm * BM + wr * 64 + fr, c0 = u.pn * HALF + wc * 32 + 8 * fq;
        f32x4 bav[2], bxv[2], spv[2];
#pragma unroll
        for (int n = 0; n < 2; ++n) { bav[n] = *(const f32x4*)(ba + c0 + 4 * n); bxv[n] = *(const f32x4*)(bx + c0 + 4 * n); spv[n] = *(const f32x4*)(sp8 + c0 + 4 * n) * 1.44269504089f; }
        u32x4 xkv[8];
#pragma unroll
        for (int g = 0; g < 8; ++g) xkv[g] = *(const u32x4*)(xc + (size_t)(row0 + (g >> 2) * HALF + (g & 3) * 16) * D + c0);
        asm volatile("" ::: "memory");
#pragma unroll
        for (int ai = 0; ai < 2; ++ai)
#pragma unroll
            for (int m = 0; m < 4; ++m) { const int row = row0 + ai * HALF + m * 16; const u32x4 xk = xkv[ai * 4 + m]; float lo[8], bo[8];
#pragma unroll
                for (int n = 0; n < 2; ++n) { const unsigned k0 = n == 0 ? xk.x : xk.z, k1 = n == 0 ? xk.y : xk.w;
                    const f32x4 xv = (f32x4){__uint_as_float(k0 << 16), __uint_as_float(k0 & 0xffff0000u), __uint_as_float(k1 << 16), __uint_as_float(k1 & 0xffff0000u)};
#pragma unroll
                    for (int j = 0; j < 4; ++j) { const float r = fast_sigmoid(acc[ai][0][m][n][j] + bav[n][j]), ig = fast_sigmoid(acc[ai][1][m][n][j] + bxv[n][j]);
                        const float l2 = -r * spv[n][j];
                        const float l2r = __uint_as_float(cvt_pk_bf16(l2, l2) << 16);
                        const float t = 1.38629436112f * l2r;
                        const float ser = -t * (1.0f + 0.5f * t * (1.0f + (1.0f / 3.0f) * t * (1.0f + 0.25f * t * (1.0f + 0.2f * t * (1.0f + (1.0f / 6.0f) * t)))));
                        const float om = t > -0.3f ? ser : 1.0f - __builtin_amdgcn_exp2f(2.0f * l2r);
                        lo[n * 4 + j] = l2; bo[n * 4 + j] = sqrtf(om) * ig * xv[j]; } }
                u32x4 wl, wb; wl.x = cvt_pk_bf16(lo[0], lo[1]); wl.y = cvt_pk_bf16(lo[2], lo[3]); wl.z = cvt_pk_bf16(lo[4], lo[5]); wl.w = cvt_pk_bf16(lo[6], lo[7]);
                wb.x = cvt_pk_bf16(bo[0], bo[1]); wb.y = cvt_pk_bf16(bo[2], bo[3]); wb.z = cvt_pk_bf16(bo[4], bo[5]); wb.w = cvt_pk_bf16(bo[6], bo[7]);
                *(u32x4*)(LA + (size_t)row * D + c0) = wl; *(u32x4*)(Bt + (size_t)row * D + c0) = wb; }
    }
};
struct EpiSoftmax {
    EPI_NO_PREPARE
    static constexpr bool PERM = true, AFTER_DRAIN = true, IS_RESID = false, IS_GU = false;
    bf16_t* P; const float* part;
    __device__ __forceinline__ void fused(f32x4 (&acc)[2][2][4][2], const Unit& u, int wr, int wc, int fr, int fq, LAS unsigned char* lds, int wid, int lane) const {
        LAS float* X = (LAS float*)lds; LAS float* Y = (LAS float*)(lds + 4096);
#pragma unroll
        for (int ai = 0; ai < 2; ++ai)
#pragma unroll
            for (int m = 0; m < 4; ++m) { float mx = -3.0e38f; const float rs = row_rstd(part, u.pm * BM + ai * HALF + wr * 64 + m * 16 + fr, fq);
#pragma unroll
                for (int bj = 0; bj < 2; ++bj)
#pragma unroll
                    for (int n = 0; n < 2; ++n) { acc[ai][bj][m][n] = acc[ai][bj][m][n] * rs; const f32x4 x = acc[ai][bj][m][n]; mx = fmaxf(mx, fmaxf(fmaxf(x[0], x[1]), fmaxf(x[2], x[3]))); }
                mx = fmaxf(mx, __shfl_xor(mx, 16)); mx = fmaxf(mx, __shfl_xor(mx, 32));
                if (fq == 0) X[(ai * HALF + wr * 64 + m * 16 + fr) * 4 + wc] = mx; }
        LDS_WAIT(); __builtin_amdgcn_s_barrier(); asm volatile("" ::: "memory");
#pragma unroll
        for (int ai = 0; ai < 2; ++ai)
#pragma unroll
            for (int m = 0; m < 4; ++m) { const int r = ai * HALF + wr * 64 + m * 16 + fr; const f32x4 v = *(const LAS f32x4*)(X + r * 4);
                const float mx = fmaxf(fmaxf(v[0], v[1]), fmaxf(v[2], v[3])) * 1.44269504089f; float s = 0.f;
#pragma unroll
                for (int bj = 0; bj < 2; ++bj)
#pragma unroll
                    for (int n = 0; n < 2; ++n)
#pragma unroll
                        for (int j = 0; j < 4; ++j) { const float p = __builtin_amdgcn_exp2f(acc[ai][bj][m][n][j] * 1.44269504089f - mx); acc[ai][bj][m][n][j] = p; s += p; }
                s += __shfl_xor(s, 16); s += __shfl_xor(s, 32);
                if (fq == 0) Y[r * 4 + wc] = s; }
        LDS_WAIT(); __builtin_amdgcn_s_barrier(); asm volatile("" ::: "memory");
#pragma unroll
        for (int ai = 0; ai < 2; ++ai)
#pragma unroll
            for (int m = 0; m < 4; ++m) { const int r = ai * HALF + wr * 64 + m * 16 + fr; const f32x4 v = *(const LAS f32x4*)(Y + r * 4);
                const float inv = 1.0f / ((v[0] + v[1]) + (v[2] + v[3])); bf16_t* rp = P + (size_t)(u.pm * BM + r) * 1024 + u.pn * BM + wc * 32 + 8 * fq;
#pragma unroll
                for (int bj = 0; bj < 2; ++bj) { const f32x4 v0 = acc[ai][bj][m][0] * inv, v1 = acc[ai][bj][m][1] * inv;
                    u32x4 w; w.x = cvt_pk_bf16(v0[0], v0[1]); w.y = cvt_pk_bf16(v0[2], v0[3]); w.z = cvt_pk_bf16(v1[0], v1[1]); w.w = cvt_pk_bf16(v1[2], v1[3]);
                    *(u32x4*)(rp + bj * HALF) = w; } }
    }
};

template <bool F16> __device__ __forceinline__ f32x4 mma16(bf16x8 b, bf16x8 a, f32x4 c) {
    if constexpr (F16) return __builtin_amdgcn_mfma_f32_16x16x32_f16(__builtin_bit_cast(f16x8, b), __builtin_bit_cast(f16x8, a), c, 0, 0, 0);
    else return __builtin_amdgcn_mfma_f32_16x16x32_bf16(b, a, c, 0, 0, 0);
}
template <class Epi, bool ALIGN_EPI, int PID, class SchedT>
__device__ __forceinline__ void gemm_phase(LAS unsigned char* lds, const SchedT& S, const Epi& E, unsigned long long& pacc) {
    unsigned long long pt0 = 0, pt1 = 0; (void)pt0; (void)pt1;
    if constexpr (PROF_TAG == PID * 10 + 0) pt0 = PROF_NOW();
    { constexpr int ticks = Epi::IS_RESID ? STAGGER_TICKS : Epi::IS_GU ? STAGGER_GU_TICKS : 0;
      if constexpr (ticks > 0) { const unsigned grp = (blockIdx.x >> 3) & (Epi::IS_RESID ? (STAGGER_GROUPS - 1) : (STAGGER_GU_GROUPS - 1));
        if (grp) { const unsigned long long t0 = __builtin_amdgcn_s_memrealtime(), want = (unsigned long long)ticks * grp; while (__builtin_amdgcn_s_memrealtime() - t0 < want) __builtin_amdgcn_s_sleep(8); } } }
    int tid_ = threadIdx.x; asm volatile("" : "+v"(tid_));
    const int tid = tid_, wid = __builtin_amdgcn_readfirstlane(tid >> 6), lane = tid & 63, wr = wid >> 2, wc = wid & 3, fr = lane & 15, fq = lane >> 4;
    constexpr int K = SchedT::K, nt = K / BK;
    static_assert(K % 128 == 0 && K >= 256, "K multiple of 128, >= 256");
    unsigned voffA[2], voffB[2];
#pragma unroll
    for (int i = 0; i < 2; ++i) { int R, C; stage_rc(tid * 16 + i * 8192, R, C); const int Rb = Epi::PERM ? ((R & ~31) + perm32(R & 31)) : R;
        voffA[i] = (unsigned)(R * SchedT::lda + C) * 2u; voffB[i] = (unsigned)(Rb * SchedT::ldb + C) * 2u; }
    constexpr long kstep = SchedT::KREV ? -(long)(BK * 2) : (long)(BK * 2);
    constexpr size_t hstepA = (size_t)HALF * SchedT::lda * 2, hstepB = (size_t)HALF * SchedT::ldb * 2;
    const unsigned ldsw = (unsigned)wid * 1024u;
    const int aoff = lds_byte(wr * 64 + fr, fq * 8), boff = lds_byte(wc * 32 + fr, fq * 8);
#define PG8_SA(b, h) (((b) * 2 + (h)) * HTB)
#define PG8_SB(b, h) ((4 + (b) * 2 + (h)) * HTB)
#define PG8_STAGE(bufoff, gbase, voff) do { _Pragma("unroll") for (int _i = 0; _i < 2; ++_i) \
        __builtin_amdgcn_global_load_lds((const unsigned*)((const char*)(gbase) + (voff)[_i]), (LAS unsigned*)(lds + (bufoff) + ldsw + _i * 8192), 16, 0, 0); } while (0)
#define PG8_LDA(dst, b, h) do { _Pragma("unroll") for (int m = 0; m < 4; ++m) _Pragma("unroll") for (int k = 0; k < 2; ++k) dst[m][k] = *(const LAS bf16x8*)(lds + PG8_SA(b, h) + aoff + m * 2048 + k * 1024); } while (0)
#define PG8_LDB(dst, b, h) do { _Pragma("unroll") for (int n = 0; n < 2; ++n) _Pragma("unroll") for (int k = 0; k < 2; ++k) dst[n][k] = *(const LAS bf16x8*)(lds + PG8_SB(b, h) + boff + n * 2048 + k * 1024); } while (0)
#define PG8_MMA(ai, bj, At, Bt) do { __builtin_amdgcn_s_setprio(1); _Pragma("unroll") for (int m = 0; m < 4; ++m) _Pragma("unroll") for (int n = 0; n < 2; ++n) _Pragma("unroll") for (int k = 0; k < 2; ++k) \
        acc[ai][bj][m][n] = mma16<SchedT::F16>(Bt[n][k], At[m][k], acc[ai][bj][m][n]); __builtin_amdgcn_s_setprio(0); } while (0)
#define PG8_MMA_(ai, bj, At, Bt) do { _Pragma("unroll") for (int m = 0; m < 4; ++m) _Pragma("unroll") for (int n = 0; n < 2; ++n) _Pragma("unroll") for (int k = 0; k < 2; ++k) \
        acc[ai][bj][m][n] = mma16<SchedT::F16>(Bt[n][k], At[m][k], acc[ai][bj][m][n]); } while (0)
#define PG8_MMA2(ai, At, Ba, Bb) do { __builtin_amdgcn_s_setprio(1); PG8_MMA_(ai, 0, At, Ba); PG8_MMA_(ai, 1, At, Bb); __builtin_amdgcn_s_setprio(0); } while (0)
#define PG8_WAIT_V(n) asm volatile("s_waitcnt vmcnt(" #n ")" ::: "memory")
#define PG8_WAIT_L(n) asm volatile("s_waitcnt lgkmcnt(" #n ")" ::: "memory")
#define PG8_BAR __builtin_amdgcn_s_barrier()
#define PG8_SCHED __builtin_amdgcn_sched_barrier(0)
    Unit cur, nxt; int ui = 0;
    if (!S.next(0, cur)) return;
    E.prepare(cur, tid);
    f32x4 acc[2][2][4][2];
#pragma unroll
    for (int a = 0; a < 2; ++a)
#pragma unroll
        for (int b = 0; b < 2; ++b)
#pragma unroll
            for (int m = 0; m < 4; ++m)
#pragma unroll
                for (int n = 0; n < 2; ++n) acc[a][b][m][n] = (f32x4){0.f, 0.f, 0.f, 0.f};
    bf16x8 At[4][2], B0[2][2], B1[2][2];
    const char* cA = cur.a; const char* cB = cur.b;
    PG8_STAGE(PG8_SB(0, 0), cB, voffB); PG8_STAGE(PG8_SB(0, 1), cB + hstepB, voffB); PG8_STAGE(PG8_SA(0, 0), cA, voffA); PG8_STAGE(PG8_SA(0, 1), cA + hstepA, voffA);
    if (wr == 1) PG8_BAR;
    PG8_WAIT_V(2); PG8_BAR;
    PG8_STAGE(PG8_SB(1, 0), cB + kstep, voffB); PG8_STAGE(PG8_SA(1, 0), cA + kstep, voffA); PG8_STAGE(PG8_SB(1, 1), cB + hstepB + kstep, voffB);
    PG8_WAIT_V(6); PG8_BAR;
    for (;;) {
        const bool has_next = S.next(ui + 1, nxt);
        const char* nA = has_next ? nxt.a : cA; const char* nB = has_next ? nxt.b : cB;
        if constexpr (PROF_TAG == PID * 10 + 1) pt0 = PROF_NOW();
#pragma unroll 1
        for (int t = 0; t < nt; t += 2) {
            const bool last = (t == nt - 2);
            if constexpr (PROF_TAG == PID * 10 + 4) { if (t == 0) pt0 = PROF_NOW(); }
            if constexpr (PROF_TAG == PID * 10 + 5) { if (t == 2) pt0 = PROF_NOW(); }
            const char* a1 = cA + (long)(t + 1) * kstep;
            const char* a2 = last ? nA : cA + (long)(t + 2) * kstep; const char* b2 = last ? nB : cB + (long)(t + 2) * kstep;
            const char* a3 = a2 + kstep; const char* b3 = b2 + kstep;
            PG8_LDB(B0, 0, 0); PG8_LDB(B1, 0, 1); PG8_SCHED; PG8_LDA(At, 0, 0); PG8_STAGE(PG8_SA(1, 1), a1 + hstepA, voffA);
            PG8_WAIT_V(8); PG8_WAIT_L(0); PG8_BAR; PG8_MMA2(0, At, B0, B1); PG8_BAR; PG8_SCHED;
            PG8_LDA(At, 0, 1); PG8_STAGE(PG8_SB(0, 0), b2, voffB); PG8_STAGE(PG8_SB(0, 1), b2 + hstepB, voffB); PG8_STAGE(PG8_SA(0, 0), a2, voffA);
            PG8_WAIT_V(8); PG8_WAIT_L(0); PG8_BAR; PG8_MMA2(1, At, B0, B1); PG8_BAR; PG8_SCHED;
            PG8_LDB(B0, 1, 0); PG8_LDB(B1, 1, 1); PG8_SCHED; PG8_LDA(At, 1, 0); PG8_STAGE(PG8_SA(0, 1), a2 + hstepA, voffA);
            PG8_WAIT_V(8); PG8_WAIT_L(0); PG8_BAR; PG8_MMA2(0, At, B0, B1); PG8_BAR; PG8_SCHED;
            PG8_LDA(At, 1, 1); PG8_STAGE(PG8_SB(1, 0), b3, voffB); PG8_STAGE(PG8_SB(1, 1), b3 + hstepB, voffB); PG8_STAGE(PG8_SA(1, 0), a3, voffA);
            PG8_WAIT_V(8); PG8_WAIT_L(0); PG8_BAR; PG8_MMA2(1, At, B0, B1); PG8_BAR; PG8_SCHED;
            if constexpr (PROF_TAG == PID * 10 + 4) { if (t == 0) pacc += PROF_NOW() - pt0; }
            if constexpr (PROF_TAG == PID * 10 + 5) { if (t == 2) pacc += PROF_NOW() - pt0; }
        }
        if constexpr (PROF_TAG == PID * 10 + 1) pacc += PROF_NOW() - pt0;
        if constexpr (PROF_TAG == PID * 10 + 2) pt0 = PROF_NOW();
        if constexpr (ALIGN_EPI) { if (wr == 0) PG8_BAR; }
        if constexpr (PROF_TAG == PID * 10 + 3) pt0 = PROF_NOW();
        if constexpr (!Epi::AFTER_DRAIN) { E(acc, cur, wr, wc, fr, fq); }
        if constexpr (PROF_TAG == PID * 10 + 2 || PROF_TAG == PID * 10 + 3) pacc += PROF_NOW() - pt0;
        if (!has_next) break;
#pragma unroll
        for (int a = 0; a < 2; ++a)
#pragma unroll
            for (int b = 0; b < 2; ++b)
#pragma unroll
                for (int m = 0; m < 4; ++m)
#pragma unroll
                    for (int n = 0; n < 2; ++n) acc[a][b][m][n] = (f32x4){0.f, 0.f, 0.f, 0.f};
        cur = nxt; cA = nA; cB = nB; ++ui;
        if constexpr (ALIGN_EPI) { if (wr == 1) PG8_BAR; }
    }
    PG8_WAIT_V(0);
    if constexpr (!ALIGN_EPI) { if (wr == 0) PG8_BAR; }
    PG8_BAR;
    if constexpr (Epi::AFTER_DRAIN) { E.fused(acc, cur, wr, wc, fr, fq, lds, wid, lane); }
    if constexpr (PROF_TAG == PID * 10 + 0) pacc += PROF_NOW() - pt0;
#undef PG8_SA
#undef PG8_SB
#undef PG8_STAGE
#undef PG8_LDA
#undef PG8_LDB
#undef PG8_MMA
#undef PG8_WAIT_V
#undef PG8_WAIT_L
#undef PG8_BAR
#undef PG8_SCHED
}
}

constexpr size_t MiB = 1u << 20;
constexpr size_t WS_CTL = 0, CTL_ZERO_BYTES = 1 * MiB;
constexpr size_t WS_SP = 1 * MiB;
constexpr size_t WS_CHA = 2 * MiB, WS_CHB = 4 * MiB;
constexpr size_t WS_PART = 6 * MiB;
constexpr size_t WS_MB = 8 * MiB;
constexpr size_t WS_KV = 12 * MiB;
constexpr size_t WS_WGU = 48 * MiB;
constexpr size_t WS_WD = 400 * MiB;
constexpr size_t WS_WQN = 576 * MiB;
constexpr size_t WS_WK = 608 * MiB, WS_WV = 640 * MiB, WS_WO = 672 * MiB;
constexpr size_t WS_WIN = 704 * MiB;
constexpr size_t WS_WOUT = 736 * MiB;
constexpr size_t WS_WP = 752 * MiB;
constexpr size_t WS_WGATE = 756 * MiB;
constexpr size_t WS_HB = 760 * MiB;
constexpr size_t WS_ACT = 824 * MiB;
constexpr size_t WS_S = 1000 * MiB;
constexpr size_t WS_P = WS_S;
constexpr size_t WS_POOLED = WS_S;
constexpr size_t WS_GG = WS_S, WS_BT = WS_S + 64 * MiB, WS_XCB = WS_S + 192 * MiB;
constexpr size_t WS_XR = WS_ACT;
constexpr size_t WS_LA = WS_ACT + 64 * MiB;
constexpr size_t WS_GALL = WS_S + 256 * MiB;
constexpr size_t WS_HALL = WS_S + 320 * MiB;
constexpr size_t WS_END = WS_S + 384 * MiB;
constexpr int CW_BAR = 4096;
constexpr int LDS_BYTES = 147456, MISC_OFF = LDS_BYTES - 512, EPI_TBL_OFF = 131072;

#define XB_TMO      128
#define XB_XCNT(j)  (256  + 64 * (j))
#define XB_XSUB(j)  (1280 + 64 * (j))
#define XB_XGEN(j)  (2304 + 64 * (j))
#define XB_TOP      3328
#define XB_TOPGEN   3392
#define XCD_BAR_WORDS 3456
#define XB_SPIN_CAP (1u << 18)
__device__ __forceinline__ unsigned xb_ld(unsigned* p)              { return __hip_atomic_load(p, __ATOMIC_RELAXED, __HIP_MEMORY_SCOPE_AGENT); }
__device__ __forceinline__ unsigned xb_add(unsigned* p, unsigned v) { return __hip_atomic_fetch_add(p, v, __ATOMIC_RELAXED, __HIP_MEMORY_SCOPE_AGENT); }
__device__ __forceinline__ unsigned xb_xcc_id() { return (unsigned)__builtin_amdgcn_s_getreg((3 << 11) | 20) & 0xFu; }
#define XB_SPIN(cond, bar) do { unsigned _sp = 0; while (cond) { __builtin_amdgcn_s_sleep(1); \
    if ((++_sp & 255u) == 0u) { if (xb_ld(&(bar)[XB_TMO])) break; if (_sp > XB_SPIN_CAP) { atomicAdd(&(bar)[XB_TMO], 1u); break; } } } } while (0)
struct XcdBarrier { unsigned* bar; unsigned x; volatile LAS unsigned* st; };
__device__ __forceinline__ XcdBarrier xcd_barrier_post(unsigned* bar, volatile LAS unsigned* st) {
    XcdBarrier b; b.bar = bar; b.x = xb_xcc_id(); b.st = st;
    if (threadIdx.x == 0) (void)xb_add(&bar[XB_XCNT(b.x)], 1u);
    return b;
}
__device__ __forceinline__ void xcd_barrier_complete(unsigned* bar, unsigned x, unsigned& nloc, unsigned& nx) {
    const unsigned G = gridDim.x * gridDim.y * gridDim.z;
    unsigned sum, cnt, mine, sp = 0u;
    for (;;) {
        sum = 0u; cnt = 0u; mine = 0u;
#pragma unroll
        for (unsigned j = 0; j < 16; ++j) { const unsigned c = xb_ld(&bar[XB_XCNT(j)]); sum += c; cnt += (c > 0u) ? 1u : 0u; mine = (j == x) ? c : mine; }
        if (sum == G) break;
        __builtin_amdgcn_s_sleep(1);
        if ((++sp & 255u) == 0u) { if (xb_ld(&bar[XB_TMO])) break; if (sp > XB_SPIN_CAP) { atomicAdd(&bar[XB_TMO], 1u); break; } }
    }
    nloc = mine > 0u ? mine : 1u; nx = cnt > 0u ? cnt : 1u;
}
__device__ __forceinline__ void xcd_barrier(const XcdBarrier& b) {
    asm volatile("s_waitcnt vmcnt(0)" ::: "memory");
    __syncthreads();
    if (threadIdx.x == 0) {
        unsigned* bar = b.bar;
        __builtin_amdgcn_s_waitcnt(0);
        unsigned nloc = b.st[0], nx = b.st[1];
        if (nloc == 0u) { xcd_barrier_complete(bar, b.x, nloc, nx); b.st[0] = nloc; b.st[1] = nx; }
        const unsigned old = xb_add(&bar[XB_XSUB(b.x)], 1u);
        const unsigned gen = old / nloc;
        if (old + 1u == (gen + 1u) * nloc) {
            __builtin_amdgcn_fence(__ATOMIC_RELEASE, "agent");
            asm volatile("s_waitcnt vmcnt(0)" ::: "memory");
            const unsigned og = xb_add(&bar[XB_TOP], 1u);
            const unsigned tg = og / nx;
            if (og + 1u == (tg + 1u) * nx) xb_add(&bar[XB_TOPGEN], 1u);
            else XB_SPIN(xb_ld(&bar[XB_TOPGEN]) == tg, bar);
            __builtin_amdgcn_fence(__ATOMIC_ACQUIRE, "agent");
            xb_add(&bar[XB_XGEN(b.x)], 1u);
            asm volatile("s_waitcnt vmcnt(0)" ::: "memory");
        } else {
            XB_SPIN(xb_ld(&bar[XB_XGEN(b.x)]) == gen, bar);
            __builtin_amdgcn_fence(__ATOMIC_ACQUIRE, "agent");
            asm volatile("s_waitcnt vmcnt(0)" ::: "memory");
        }
    }
    __syncthreads();
}

template <bool F16OUT = false>
__device__ __forceinline__ void tr_item(const float* src, int ldw, bf16_t* dst, int ldd, const float* ks, const float* ns, float sc, bf16_t* dstz, LAS float* scr, int lane) {
    f32x4 v[16];
    const float* s0 = src + (size_t)(lane >> 4) * ldw + (lane & 15) * 4;
#pragma unroll
    for (int i = 0; i < 16; ++i) v[i] = *(const f32x4*)(s0 + (size_t)(4 * i) * ldw);
#pragma unroll
    for (int i = 0; i < 16; ++i) { LAS float* p = scr + ((lane >> 4) + 4 * i) * 65 + (lane & 15) * 4; p[0] = v[i][0]; p[1] = v[i][1]; p[2] = v[i][2]; p[3] = v[i][3]; }
    LDS_WAIT(); asm volatile("" ::: "memory");
    const int c = lane & 7;
    f32x4 k0v = (f32x4){sc, sc, sc, sc}, k1v = k0v;
    if (ks) { k0v = *(const f32x4*)(ks + 8 * c) * sc; k1v = *(const f32x4*)(ks + 8 * c + 4) * sc; }
#pragma unroll
    for (int j = 0; j < 8; ++j) { const int n = (lane >> 3) + 8 * j; const LAS float* s = scr + (8 * c) * 65 + n; const float nsv = ns ? ns[n] : 1.0f;
        u32x4 o; o.x = cvt_pk16<F16OUT>(s[0 * 65] * k0v[0] * nsv, s[1 * 65] * k0v[1] * nsv); o.y = cvt_pk16<F16OUT>(s[2 * 65] * k0v[2] * nsv, s[3 * 65] * k0v[3] * nsv);
        o.z = cvt_pk16<F16OUT>(s[4 * 65] * k1v[0] * nsv, s[5 * 65] * k1v[1] * nsv); o.w = cvt_pk16<F16OUT>(s[6 * 65] * k1v[2] * nsv, s[7 * 65] * k1v[3] * nsv);
        *(u32x4*)(dst + (size_t)n * ldd + 8 * c) = o;
        if (dstz) *(u32x4*)(dstz + (size_t)n * ldd + 8 * c) = (u32x4){0u, 0u, 0u, 0u}; }
    LDS_WAIT(); asm volatile("" ::: "memory");
}

struct TrItem { const float* src; bf16_t* dst; const float* ks; const float* ns; bf16_t* dstz; int ldw, ldd, f16; };
__device__ __forceinline__ void tr_load(const TrItem& t, f32x4 (&v)[16], int lane) {
    const float* s0 = t.src + (size_t)(lane >> 4) * t.ldw + (lane & 15) * 4;
#pragma unroll
    for (int i = 0; i < 16; ++i) v[i] = *(const f32x4*)(s0 + (size_t)(4 * i) * t.ldw);
}
template <bool F16OUT>
__device__ __forceinline__ void tr_finish_t(const TrItem& t, const f32x4 (&v)[16], LAS float* scr, int lane) {
#pragma unroll
    for (int i = 0; i < 16; ++i) { LAS float* p = scr + ((lane >> 4) + 4 * i) * 65 + (lane & 15) * 4; p[0] = v[i][0]; p[1] = v[i][1]; p[2] = v[i][2]; p[3] = v[i][3]; }
    LDS_WAIT(); asm volatile("" ::: "memory");
    const int c = lane & 7;
    f32x4 k0v = (f32x4){1.f, 1.f, 1.f, 1.f}, k1v = k0v;
    if (t.ks) { k0v = *(const f32x4*)(t.ks + 8 * c); k1v = *(const f32x4*)(t.ks + 8 * c + 4); }
#pragma unroll
    for (int j = 0; j < 8; ++j) { const int n = (lane >> 3) + 8 * j; const LAS float* s = scr + (8 * c) * 65 + n; const float nsv = t.ns ? t.ns[n] : 1.0f;
        u32x4 o; o.x = cvt_pk16<F16OUT>(s[0 * 65] * k0v[0] * nsv, s[1 * 65] * k0v[1] * nsv); o.y = cvt_pk16<F16OUT>(s[2 * 65] * k0v[2] * nsv, s[3 * 65] * k0v[3] * nsv);
        o.z = cvt_pk16<F16OUT>(s[4 * 65] * k1v[0] * nsv, s[5 * 65] * k1v[1] * nsv); o.w = cvt_pk16<F16OUT>(s[6 * 65] * k1v[2] * nsv, s[7 * 65] * k1v[3] * nsv);
        *(u32x4*)(t.dst + (size_t)n * t.ldd + 8 * c) = o;
        if (t.dstz) *(u32x4*)(t.dstz + (size_t)n * t.ldd + 8 * c) = (u32x4){0u, 0u, 0u, 0u}; }
    LDS_WAIT(); asm volatile("" ::: "memory");
}
__device__ __forceinline__ void tr_finish(const TrItem& t, const f32x4 (&v)[16], LAS float* scr, int lane) { if (t.f16) tr_finish_t<true>(t, v, scr, lane); else tr_finish_t<false>(t, v, scr, lane); }
template <class T> __device__ __forceinline__ T* uniform_ptr(T* p) {
    const unsigned long long v = (unsigned long long)p; const unsigned lo = __builtin_amdgcn_readfirstlane((unsigned)v), hi = __builtin_amdgcn_readfirstlane((unsigned)(v >> 32));
    return (T*)(((unsigned long long)hi << 32) | lo);
}
struct Args { const float* in[25]; float* out; unsigned char* ws; int step, phase; };

__device__ __forceinline__ void prologue(const Args& args, LAS unsigned char* lds, int lane, int wave, int bx, int G) {
    unsigned char* ws = args.ws;
    LAS float* scr = (LAS float*)(lds + wave * 16640);
    const int gw = bx * 8 + wave, NGW = G * 8;
    constexpr int I_GU = 32 * 88, N_GU = 16 * I_GU, I_D = 88 * 32, N_D = 8 * I_D, I_SQ = 32 * 32, N_SQ = 12 * I_SQ, I_IN = 32 * 64, N_IN = 2 * I_IN, I_OUT = 32 * 32, N_OUT = 2 * I_OUT,
                  I_P = 8 * 8, N_P = 8 * I_P, I_G = 4, N_G = 64 * I_G, NITEMS = N_GU + N_D + N_SQ + N_IN + N_OUT + N_P + N_G;
#define TR_KB(item, NB) (2 * (((item) >> 3) / ((NB) / 4)) + (((item) & 7) >> 2))
#define TR_NB(item, NB) (4 * (((item) >> 3) % ((NB) / 4)) + ((item) & 3))
    auto decode = [&](int it) -> TrItem { TrItem t; t.ks = nullptr; t.ns = nullptr; t.dstz = nullptr; t.f16 = 0; int r = it;
        if (r < N_GU) { const int mat = r / I_GU, item = r % I_GU, lw = mat >> 1, up = mat & 1, k0 = TR_KB(item, 88) * 64, n0 = TR_NB(item, 88) * 64;
            t.src = (up ? args.in[4] : args.in[3]) + (size_t)lw * D * FF + (size_t)k0 * FF + n0; t.ldw = FF;
            t.dst = (bf16_t*)(ws + WS_WGU) + (size_t)lw * (2 * FF) * D + (size_t)(256 * (n0 >> 7) + (n0 & 127) + up * 128) * D + k0; t.ldd = D; t.ks = args.in[2] + lw * D + k0; t.f16 = 1; return t; }
        r -= N_GU;
        if (r < N_D) { const int lw = r / I_D, item = r % I_D, k0 = TR_KB(item, 32) * 64, n0 = TR_NB(item, 32) * 64;
            t.src = args.in[5] + (size_t)lw * FF * D + (size_t)k0 * D + n0; t.ldw = D; t.dst = (bf16_t*)(ws + WS_WD) + (size_t)lw * D * FF + (size_t)n0 * FF + k0; t.ldd = FF; return t; }
        r -= N_D;
        if (r < N_SQ) { const int mat = r / I_SQ, item = r % I_SQ, which = mat >> 2, L = mat & 3, k0 = TR_KB(item, 32) * 64, n0 = TR_NB(item, 32) * 64;
            t.src = (which == 0 ? args.in[21] : which == 1 ? args.in[22] : args.in[23]) + (size_t)L * D * D + (size_t)k0 * D + n0; t.ldw = D;
            t.dst = (bf16_t*)(ws + WS_WK + (size_t)which * 32 * MiB) + (size_t)L * D * D + (size_t)n0 * D + k0; t.ldd = D; return t; }
        r -= N_SQ;
        if (r < N_IN) { const int j = r / I_IN, item = r % I_IN, k0 = TR_KB(item, 64) * 64, n0 = TR_NB(item, 64) * 64;
            t.src = args.in[9] + (size_t)j * D * 4096 + (size_t)k0 * 4096 + n0; t.ldw = 4096; t.dst = (bf16_t*)(ws + WS_WIN) + (size_t)j * 4096 * D + (size_t)n0 * D + k0; t.ldd = D; t.ks = args.in[6] + (2 * j + 1) * D + k0; t.f16 = 1; return t; }
        r -= N_IN;
        if (r < N_OUT) { const int j = r / I_OUT, item = r % I_OUT, k0 = TR_KB(item, 32) * 64, n0 = TR_NB(item, 32) * 64;
            t.src = args.in[17] + (size_t)j * D * D + (size_t)k0 * D + n0; t.ldw = D; t.dst = (bf16_t*)(ws + WS_WOUT) + (size_t)j * D * D + (size_t)n0 * D + k0; t.ldd = D; return t; }
        r -= N_OUT;
        if (r < N_P) { const int mat = r / I_P, item = r % I_P, j = mat >> 2, g = mat & 3, k0 = TR_KB(item, 8) * 64, n0 = TR_NB(item, 8) * 64;
            t.src = args.in[7] + (size_t)mat * 512 * 512 + (size_t)k0 * 512 + n0; t.ldw = 512; t.dst = (bf16_t*)(ws + WS_WP) + (size_t)j * D * 512 + (size_t)(g * 512 + n0) * 512 + k0; t.ldd = 512;
            t.ks = args.in[6] + (2 * j) * D + g * 512 + k0; t.ns = args.in[8] + j * D + g * 512 + n0; return t; }
        r -= N_P;
        { const int mat = r / I_G, item = r % I_G, j = mat >> 5, isx = (mat >> 4) & 1, hh = mat & 15, k0 = (item >> 1) * 64, n0 = (item & 1) * 64;
            bf16_t* rowp = (bf16_t*)(ws + WS_WGATE) + (size_t)j * 4096 * 256 + (size_t)(hh * 256 + isx * 128 + n0) * 256;
            t.src = (isx ? args.in[14] : args.in[12]) + (size_t)(j * 16 + hh) * 128 * 128 + (size_t)k0 * 128 + n0; t.ldw = 128; t.dst = rowp + (hh & 1) * 128 + k0; t.ldd = 256; t.dstz = rowp + ((hh & 1) ^ 1) * 128 + k0; return t; } };
    if (gw < NITEMS) { int it = gw; TrItem a = decode(it), b = a; f32x4 va[16], vb[16]; tr_load(a, va, lane);
        for (;;) { const int itb = it + NGW; const bool hasb = itb < NITEMS;
            if (hasb) { b = decode(itb); tr_load(b, vb, lane); }
            asm volatile("" ::: "memory");
            tr_finish(a, va, scr, lane);
            if (!hasb) break;
            const int ita = itb + NGW; const bool hasa = ita < NITEMS;
            if (hasa) { a = decode(ita); tr_load(a, va, lane); }
            asm volatile("" ::: "memory");
            tr_finish(b, vb, scr, lane);
            if (!hasa) break;
            it = ita; } }
    { bf16_t* wqn = (bf16_t*)(ws + WS_WQN);
      for (int row = gw; row < 4 * D; row += NGW) { const float sck = args.in[18][row] * 0.04419417382415922f; const f32x4* xr = (const f32x4*)(args.in[20] + (size_t)row * D) + lane; u32x2* br = (u32x2*)(wqn + (size_t)row * D) + lane;
#pragma unroll
          for (int j = 0; j < 8; ++j) { const f32x4 v = xr[64 * j] * sck; u32x2 w; w.x = cvt_pk_bf16(v[0], v[1]); w.y = cvt_pk_bf16(v[2], v[3]); br[64 * j] = w; } } }
    { const float* x = args.in[0]; bf16_t* hb = (bf16_t*)(ws + WS_HB); float* part = (float*)(ws + WS_PART);
      for (int row = gw; row < M; row += NGW) { const f32x4* xr = (const f32x4*)(x + (size_t)row * D) + lane; f32x4 v[8]; float ss = 0.f;
#pragma unroll
          for (int j = 0; j < 8; ++j) { v[j] = xr[64 * j]; ss += (v[j][0] * v[j][0] + v[j][1] * v[j][1]) + (v[j][2] * v[j][2] + v[j][3] * v[j][3]); }
          ss = wave_sum(ss);
          u32x2* br = (u32x2*)(hb + (size_t)row * D) + lane;
#pragma unroll
          for (int j = 0; j < 8; ++j) { u32x2 w; w.x = cvt_pk_h(v[j][0], v[j][1]); w.y = cvt_pk_h(v[j][2], v[j][3]); br[64 * j] = w; }
          if (lane < 32) part[(size_t)row * 32 + lane] = lane == 0 ? ss : 0.f; } }
    { const float* mem = args.in[1]; const float* g = args.in[19]; bf16_t* mb = (bf16_t*)(ws + WS_MB);
      for (int row = gw; row < MM; row += NGW) { const f32x4* xr = (const f32x4*)(mem + (size_t)row * D) + lane; f32x4 v[8]; float ss = 0.f;
#pragma unroll
          for (int j = 0; j < 8; ++j) { v[j] = xr[64 * j]; ss += (v[j][0] * v[j][0] + v[j][1] * v[j][1]) + (v[j][2] * v[j][2] + v[j][3] * v[j][3]); }
          const float rs = rsqrtf(wave_sum(ss) * (1.0f / 2048.0f) + EPS); u32x2* br = (u32x2*)(mb + (size_t)row * D) + lane;
#pragma unroll
          for (int j = 0; j < 8; ++j) { const f32x4 gv = *((const f32x4*)g + lane + 64 * j); const f32x4 o = v[j] * rs * gv; u32x2 w; w.x = cvt_pk_bf16(o[0], o[1]); w.y = cvt_pk_bf16(o[2], o[3]); br[64 * j] = w; } } }
    { const float* lam = args.in[16]; float* sp = (float*)(ws + WS_SP);
      for (int i = gw * 64 + lane; i < 2 * D; i += NGW * 64) { const float z = -lam[i]; sp[i] = 8.0f * (fmaxf(z, 0.f) + log1pf(expf(-fabsf(z)))); } }
}

constexpr int PD = 256 * D * 2;
typedef pg8::Sched<M,      2 * FF,  D,   D,    D,      PD,            0,       0,   PD,             0,                0, false, true> ShGU;
typedef pg8::Sched<M,      D,       FF,  FF,   FF,     256 * FF * 2,  0,       0,   256 * FF * 2,   0,                0, DOWN_KREV, false, DOWN_WGM> ShDown;
typedef pg8::Sched<M,      D,       512, D,    512,    PD,            512 * 2, 1,   256 * 512 * 2,  0,                0> ShPool;
typedef pg8::Sched<M,      2 * D,   D,   D,    D,      PD,            0,       0,   PD,             0,                0, false, true> ShLruIn;
typedef pg8::Sched<M,      2 * D,   256, D,    256,    PD,            256 * 2, 1,   256 * 256 * 2,  0,                0> ShGates;
typedef pg8::Sched<M,      D,       D,   D,    D,      PD,            0,       0,   PD,             0,                0> ShDD;
typedef pg8::Sched<M,      NH*MEML, D,   D,    D,      PD,            0,       0,   256 * D * 2,    1024 * D * 2,     4, false, true> ShScore;
typedef pg8::Sched<M,      D,       1024, 1024, 4096,  256 * 1024 * 2, 0,      0,   256 * 4096 * 2, 1024 * 2,         4> ShAO;
typedef pg8::Sched<MM,     8 * D,   D,   D,    D,      PD,            0,       0,   PD,             0,                0> ShKV;

#define LD_BF4P(p) f16x4_to_f32(*(const u32x2*)(p))
__device__ __forceinline__ unsigned long long launder_u64(unsigned long long v) {
    unsigned lo = (unsigned)v, hi = (unsigned)(v >> 32); asm volatile("" : "+v"(lo), "+v"(hi));
    return ((unsigned long long)(unsigned)__builtin_amdgcn_readfirstlane(hi) << 32) | (unsigned)__builtin_amdgcn_readfirstlane(lo);
}
#define PHASE_VARS() int tid = threadIdx.x; asm volatile("" : "+v"(tid)); unsigned char* ws = (unsigned char*)(GAS unsigned char*)launder_u64((unsigned long long)args.ws); float* h = (float*)(GAS float*)launder_u64((unsigned long long)args.out); \
    bf16_t* hb = (bf16_t*)(ws + WS_HB); float* part = (float*)(ws + WS_PART); (void)tid; (void)h; (void)hb; (void)part
__global__ void __launch_bounds__(512, 2) mk_fwd(Args args) {
    extern __shared__ __attribute__((aligned(16))) unsigned char lds_raw[];
    LAS unsigned char* lds = (LAS unsigned char*)lds_raw;
    const int G = gridDim.x, bx = blockIdx.x;
    unsigned long long prof_acc = 0;
#if MK_SINGLE
    volatile LAS unsigned* MISC = (volatile LAS unsigned*)(lds + MISC_OFF);
    if (threadIdx.x < 32) MISC[threadIdx.x] = 0u;
    __syncthreads();
    XcdBarrier bar = xcd_barrier_post((unsigned*)(args.ws + WS_CTL) + CW_BAR, MISC + 8);
#define GRID_BAR() xcd_barrier(bar)
#define PH(k) true
    const int s_lo = 0, s_hi = 8; const bool do_pro = true, do_fin = true;
#else
#define GRID_BAR() do {} while (0)
#define PH(k) (args.phase == (k))
    const int s_lo = args.step, s_hi = (args.step >= 0 && args.step < 8) ? args.step + 1 : args.step; const bool do_pro = args.step == -1, do_fin = args.step == 8;
#endif

    if (do_pro) {
        if (PH(0)) { for (int rep = 0; rep < REP_PRO; ++rep) { PHASE_VARS(); unsigned long long pt_ = 0; if constexpr (PROF_TAG == 110) pt_ = PROF_NOW(); prologue(args, lds, tid & 63, __builtin_amdgcn_readfirstlane(tid >> 6), bx, G); GRID_BAR(); if constexpr (PROF_TAG == 110) prof_acc += PROF_NOW() - pt_; } }
        if (PH(1)) {
            PHASE_VARS(); ShKV S{(const char*)(ws + WS_MB), (const char*)(ws + WS_WK), G, bx}; pg8::EpiPlain<false> E{(bf16_t*)(ws + WS_KV), 8 * D}; pg8::gemm_phase<pg8::EpiPlain<false>, true, 9>(lds, S, E, prof_acc); GRID_BAR(); }
        if (PH(2)) {
            { PHASE_VARS(); pg8::SchedG S{(const char*)(ws + WS_KV), (const char*)(ws + WS_WQN), G, bx}; pg8::EpiPlain<true> E{(bf16_t*)(ws + WS_GALL), D}; pg8::gemm_phase<pg8::EpiPlain<true>, true, 10>(lds, S, E, prof_acc); }
            { PHASE_VARS(); pg8::SchedH S{(const char*)(ws + WS_WO), (const char*)(ws + WS_KV), G, bx}; pg8::EpiPlain<false> E{(bf16_t*)(ws + WS_HALL), 4096}; pg8::gemm_phase<pg8::EpiPlain<false>, true, 10>(lds, S, E, prof_acc); }
        }
    }
#pragma unroll 1
    for (int s = s_lo; s < s_hi; ++s) {
        const int L = s >> 1, lw = s;
        if (PH(0)) for (int rep = 0; rep < REP_GU; ++rep) { PHASE_VARS(); ShGU S{(const char*)hb, (const char*)(ws + WS_WGU) + (size_t)lw * (2 * FF) * D * 2, G, bx};
            pg8::EpiSwiGLU E{(bf16_t*)(ws + WS_ACT), part, (LAS float*)(lds + EPI_TBL_OFF)};
            pg8::gemm_phase<pg8::EpiSwiGLU, true, 1>(lds, S, E, prof_acc); GRID_BAR(); }
        if (PH(1)) for (int rep = 0; rep < REP_DOWN; ++rep) { PHASE_VARS(); ShDown S{(const char*)(ws + WS_ACT), (const char*)(ws + WS_WD) + (size_t)lw * D * FF * 2, G, bx};
            pg8::EpiResid E{hb, part, 0.5f};
            pg8::gemm_phase<pg8::EpiResid, true, 2>(lds, S, E, prof_acc); GRID_BAR(); }
        if ((s & 1) == 0) {
            const int j = L >> 1;
            if ((L & 1) == 0) {
                if (PH(2)) for (int rep = 0; rep < REP_THIN; ++rep) { PHASE_VARS(); unsigned long long pt_ = 0; if constexpr (PROF_TAG == 120) pt_ = PROF_NOW(); bf16_t* pooled = (bf16_t*)(ws + WS_POOLED); LAS float* R = (LAS float*)lds;
                    for (int blk = bx; blk < M / 64; blk += G) { const int t0 = blk * 64, seq0 = (t0 / SEQ) * SEQ;
                        if (tid < 79) { const int row = t0 - 15 + tid; float rs = 0.f;
                            if (row >= seq0) { const f32x4* p = (const f32x4*)(part + (size_t)row * 32); float sacc = 0.f;
#pragma unroll
                                for (int q = 0; q < 8; ++q) { const f32x4 a = p[q]; sacc += (a[0] + a[1]) + (a[2] + a[3]); }
                                rs = rsqrtf(sacc * (1.0f / 2048.0f) + EPS); }
                            R[tid] = rs; }
                        __syncthreads();
                        const int w = 2 << (tid >> 7); const bf16_t* hc = hb + 4 * tid; f32x4 S4 = (f32x4){0.f, 0.f, 0.f, 0.f};
                        { u32x2 hk[15];
#pragma unroll
                          for (int i = 0; i < 15; ++i) { const int r = t0 - 15 + i; hk[i] = (i >= 16 - w && r >= seq0) ? *(const u32x2*)(hc + (size_t)r * D) : (u32x2){0u, 0u}; }
#pragma unroll
                          for (int i = 0; i < 15; ++i) S4 = S4 + f16x4_to_f32(hk[i]) * R[i]; }
                        u32x2 nb[2][8], ob[2][8];
#define POOL_LOAD(b) do { _Pragma("unroll") for (int i = 0; i < 8; ++i) { const int t_ = t0 + 8 * (b) + i, to_ = t_ - w; nb[(b) & 1][i] = *(const u32x2*)(hc + (size_t)t_ * D); \
                              ob[(b) & 1][i] = to_ >= seq0 ? *(const u32x2*)(hc + (size_t)to_ * D) : (u32x2){0u, 0u}; } } while (0)
                        POOL_LOAD(0);
#pragma unroll
                        for (int b = 0; b < 8; ++b) { if (b + 1 < 8) POOL_LOAD(b + 1);
                            asm volatile("" ::: "memory");
#pragma unroll
                            for (int i = 0; i < 8; ++i) { const int idx = 8 * b + i, t = t0 + idx, tt = t - seq0; const f32x4 uv = f16x4_to_f32(nb[b & 1][i]) * R[idx + 15]; S4 = S4 + uv;
                                if (idx > 0 && tt >= w) S4 = S4 - f16x4_to_f32(ob[b & 1][i]) * R[idx - w + 15];
                                const float ic = 1.0f / (float)(tt + 1 < w ? tt + 1 : w); const f32x4 o = S4 * ic - uv;
                                u32x2 pk; pk.x = cvt_pk_bf16(o[0], o[1]); pk.y = cvt_pk_bf16(o[2], o[3]); *(u32x2*)(pooled + (size_t)t * D + 4 * tid) = pk; }
                            asm volatile("" ::: "memory"); }
#undef POOL_LOAD
                        __syncthreads(); }
                    GRID_BAR(); if constexpr (PROF_TAG == 120) prof_acc += PROF_NOW() - pt_; }
                if (PH(3)) { PHASE_VARS(); ShPool S{(const char*)(ws + WS_POOLED), (const char*)(ws + WS_WP) + (size_t)j * D * 512 * 2, G, bx};
                    pg8::EpiResid E{hb, part, 1.0f};
                    pg8::gemm_phase<pg8::EpiResid, true, 3>(lds, S, E, prof_acc); GRID_BAR(); }
            } else {
                if (PH(2)) { PHASE_VARS(); ShLruIn S{(const char*)hb, (const char*)(ws + WS_WIN) + (size_t)j * 4096 * D * 2, G, bx};
                    pg8::EpiLruIn E{(bf16_t*)(ws + WS_GG), (bf16_t*)(ws + WS_XR), part, (LAS float*)(lds + EPI_TBL_OFF)};
                    pg8::gemm_phase<pg8::EpiLruIn, true, 4>(lds, S, E, prof_acc); GRID_BAR(); }
                if (PH(3)) for (int rep = 0; rep < REP_THIN; ++rep) { PHASE_VARS(); unsigned long long pt_ = 0; if constexpr (PROF_TAG == 130) pt_ = PROF_NOW(); const bf16_t* xr = (const bf16_t*)(ws + WS_XR); bf16_t* xcb = (bf16_t*)(ws + WS_XCB);
                    const float* cw = args.in[10] + (size_t)j * 4 * D + 4 * tid; const f32x4 w0 = *(const f32x4*)cw, w1 = *(const f32x4*)(cw + D), w2 = *(const f32x4*)(cw + 2 * D), w3 = *(const f32x4*)(cw + 3 * D);
                    const f32x4 cb = *(const f32x4*)(args.in[11] + (size_t)j * D + 4 * tid);
                    for (int blk = bx; blk < M / 64; blk += G) { const int t0 = blk * 64, seq0 = (t0 / SEQ) * SEQ; const bf16_t* xp = xr + 4 * tid; const f32x4 z = (f32x4){0.f, 0.f, 0.f, 0.f};
                        f32x4 x0 = z, x1 = z, x2 = z; if (t0 > seq0) { x0 = bf16x4_to_f32(*(const u32x2*)(xp + (size_t)(t0 - 3) * D)); x1 = bf16x4_to_f32(*(const u32x2*)(xp + (size_t)(t0 - 2) * D)); x2 = bf16x4_to_f32(*(const u32x2*)(xp + (size_t)(t0 - 1) * D)); }
                        u32x2 xb[2][16];
#define CONV_LOAD(b) do { _Pragma("unroll") for (int i = 0; i < 16; ++i) xb[(b) & 1][i] = *(const u32x2*)(xp + (size_t)(t0 + 16 * (b) + i) * D); } while (0)
                        CONV_LOAD(0);
#pragma unroll
                        for (int b = 0; b < 4; ++b) { if (b + 1 < 4) CONV_LOAD(b + 1);
                            asm volatile("" ::: "memory");
#pragma unroll
                            for (int i = 0; i < 16; ++i) { const int t = t0 + 16 * b + i; const f32x4 x3 = bf16x4_to_f32(xb[b & 1][i]); const f32x4 o = cb + x0 * w0 + x1 * w1 + x2 * w2 + x3 * w3;
                                u32x2 pk; pk.x = cvt_pk_bf16(o[0], o[1]); pk.y = cvt_pk_bf16(o[2], o[3]); *(u32x2*)(xcb + (size_t)t * D + 4 * tid) = pk;
                                x0 = x1; x1 = x2; x2 = x3; }
                            asm volatile("" ::: "memory"); }
#undef CONV_LOAD
                    }
                    GRID_BAR(); if constexpr (PROF_TAG == 130) prof_acc += PROF_NOW() - pt_; }
                if (PH(4)) { PHASE_VARS(); ShGates S{(const char*)(ws + WS_XCB), (const char*)(ws + WS_WGATE) + (size_t)j * 4096 * 256 * 2, G, bx};
                    pg8::EpiGates E{(bf16_t*)(ws + WS_LA), (bf16_t*)(ws + WS_BT), (const bf16_t*)(ws + WS_XCB), args.in[13] + (size_t)j * D, args.in[15] + (size_t)j * D, (const float*)(ws + WS_SP) + (size_t)j * D};
                    pg8::gemm_phase<pg8::EpiGates, true, 5>(lds, S, E, prof_acc); GRID_BAR(); }
#define EXP2_4(v) ((f32x4){__builtin_amdgcn_exp2f((v)[0]), __builtin_amdgcn_exp2f((v)[1]), __builtin_amdgcn_exp2f((v)[2]), __builtin_amdgcn_exp2f((v)[3])})
                if (PH(5)) for (int rep = 0; rep < REP_THIN; ++rep) { PHASE_VARS(); unsigned long long pt_ = 0; if constexpr (PROF_TAG == 140) pt_ = PROF_NOW(); const bf16_t* lav = (const bf16_t*)(ws + WS_LA) + 4 * tid; const bf16_t* bv = (const bf16_t*)(ws + WS_BT) + 4 * tid; float* chA = (float*)(ws + WS_CHA); float* chB = (float*)(ws + WS_CHB);
                    for (int blk = bx; blk < M / 64; blk += G) { const int t0 = blk * 64; f32x4 Ls = (f32x4){0.f, 0.f, 0.f, 0.f}, Hs = (f32x4){0.f, 0.f, 0.f, 0.f};
                        u32x2 lb[2][8], bb[2][8];
#define SC1_LOAD(b) do { _Pragma("unroll") for (int i = 0; i < 8; ++i) { const size_t o_ = (size_t)(t0 + 8 * (b) + i) * D; lb[(b) & 1][i] = *(const u32x2*)(lav + o_); bb[(b) & 1][i] = *(const u32x2*)(bv + o_); } } while (0)
                        SC1_LOAD(0);
#pragma unroll
                        for (int b = 0; b < 8; ++b) { if (b + 1 < 8) SC1_LOAD(b + 1);
                            asm volatile("" ::: "memory");
#pragma unroll
                            for (int i = 0; i < 8; ++i) { const f32x4 l4 = bf16x4_to_f32(lb[b & 1][i]), b4 = bf16x4_to_f32(bb[b & 1][i]); const f32x4 a4 = EXP2_4(l4); Hs = a4 * Hs + b4; Ls = Ls + l4; } }
#undef SC1_LOAD
                        *(f32x4*)(chA + (size_t)blk * D + 4 * tid) = EXP2_4(Ls); *(f32x4*)(chB + (size_t)blk * D + 4 * tid) = Hs; }
                    GRID_BAR(); if constexpr (PROF_TAG == 140) prof_acc += PROF_NOW() - pt_; }
                if (PH(6)) for (int rep = 0; rep < REP_THIN; ++rep) { PHASE_VARS(); unsigned long long pt_ = 0; if constexpr (PROF_TAG == 150) pt_ = PROF_NOW(); const bf16_t* lav = (const bf16_t*)(ws + WS_LA) + 4 * tid; const bf16_t* bv = (const bf16_t*)(ws + WS_BT) + 4 * tid;
                    const float* chA = (const float*)(ws + WS_CHA) + 4 * tid; const float* chB = (const float*)(ws + WS_CHB) + 4 * tid; const bf16_t* gg = (const bf16_t*)(ws + WS_GG) + 4 * tid; bf16_t* yb = (bf16_t*)(ws + WS_XCB) + 4 * tid;
                    for (int blk = bx; blk < M / 64; blk += G) { const int t0 = blk * 64, c0 = (blk / 64) * 64; f32x4 Hs = (f32x4){0.f, 0.f, 0.f, 0.f};
                        u32x2 lb[2][8], bb[2][8], gb[2][8];
#define SC2_LOAD(b) do { _Pragma("unroll") for (int i = 0; i < 8; ++i) { const size_t o_ = (size_t)(t0 + 8 * (b) + i) * D; lb[(b) & 1][i] = *(const u32x2*)(lav + o_); bb[(b) & 1][i] = *(const u32x2*)(bv + o_); gb[(b) & 1][i] = *(const u32x2*)(gg + o_); } } while (0)
                        SC2_LOAD(0);
                        int c = c0;
                        for (; c + 8 <= blk; c += 8) { f32x4 ca[8], cb8[8];
#pragma unroll
                            for (int i = 0; i < 8; ++i) { ca[i] = *(const f32x4*)(chA + (size_t)(c + i) * D); cb8[i] = *(const f32x4*)(chB + (size_t)(c + i) * D); }
#pragma unroll
                            for (int i = 0; i < 8; ++i) Hs = ca[i] * Hs + cb8[i]; }
                        for (; c < blk; ++c) { const f32x4 a4 = *(const f32x4*)(chA + (size_t)c * D), b4 = *(const f32x4*)(chB + (size_t)c * D); Hs = a4 * Hs + b4; }
#pragma unroll
                        for (int b = 0; b < 8; ++b) { if (b + 1 < 8) SC2_LOAD(b + 1);
                            asm volatile("" ::: "memory");
#pragma unroll
                            for (int i = 0; i < 8; ++i) { const int t = t0 + 8 * b + i; const f32x4 l4 = bf16x4_to_f32(lb[b & 1][i]), b4 = bf16x4_to_f32(bb[b & 1][i]), g4 = bf16x4_to_f32(gb[b & 1][i]); const f32x4 a4 = EXP2_4(l4); Hs = a4 * Hs + b4;
                                u32x2 pk; pk.x = cvt_pk_bf16(Hs[0] * g4[0], Hs[1] * g4[1]); pk.y = cvt_pk_bf16(Hs[2] * g4[2], Hs[3] * g4[3]); *(u32x2*)(yb + (size_t)t * D) = pk; }
                            asm volatile("" ::: "memory"); }
#undef SC2_LOAD
                    }
                    GRID_BAR(); if constexpr (PROF_TAG == 150) prof_acc += PROF_NOW() - pt_; }
#undef EXP2_4
                if (PH(7)) { PHASE_VARS(); ShDD S{(const char*)(ws + WS_XCB), (const char*)(ws + WS_WOUT) + (size_t)j * D * D * 2, G, bx};
                    pg8::EpiResid E{hb, part, 1.0f};
                    pg8::gemm_phase<pg8::EpiResid, true, 6>(lds, S, E, prof_acc); GRID_BAR(); }
            }
            if (PH(8)) { PHASE_VARS(); ShScore S{(const char*)hb, (const char*)(ws + WS_GALL) + (size_t)L * 4096 * D * 2, G, bx};
                pg8::EpiSoftmax E{(bf16_t*)(ws + WS_P), part};
                pg8::gemm_phase<pg8::EpiSoftmax, false, 7>(lds, S, E, prof_acc); GRID_BAR(); }
            if (PH(9)) for (int rep = 0; rep < REP_RES2K; ++rep) { PHASE_VARS(); ShAO S{(const char*)(ws + WS_P), (const char*)(ws + WS_HALL) + (size_t)L * D * 4096 * 2, G, bx};
                pg8::EpiResid E{hb, part, 1.0f};
                pg8::gemm_phase<pg8::EpiResid, true, 8>(lds, S, E, prof_acc); GRID_BAR(); }
        }
    }
    if (do_fin) { unsigned long long pt_ = 0; if constexpr (PROF_TAG == 160) pt_ = PROF_NOW(); PHASE_VARS(); const float* g = args.in[24]; const int lane = tid & 63, gw = bx * 8 + (tid >> 6), NGW = G * 8;
        for (int row = gw; row < M; row += NGW) { const u32x2* br = (const u32x2*)(hb + (size_t)row * D) + lane; f32x4* orow = (f32x4*)(h + (size_t)row * D) + lane; f32x4 v[8]; float ss = 0.f;
#pragma unroll
            for (int jj = 0; jj < 8; ++jj) { v[jj] = f16x4_to_f32(br[64 * jj]);
                ss += (v[jj][0] * v[jj][0] + v[jj][1] * v[jj][1]) + (v[jj][2] * v[jj][2] + v[jj][3] * v[jj][3]); }
            const float rs = rsqrtf(wave_sum(ss) * (1.0f / 2048.0f) + EPS);
#pragma unroll
            for (int jj = 0; jj < 8; ++jj) { const f32x4 gv = *((const f32x4*)g + lane + 64 * jj); orow[64 * jj] = v[jj] * rs * gv; } }
        if constexpr (PROF_TAG == 160) { VM_WAIT(); prof_acc += PROF_NOW() - pt_; } }
    if constexpr (PROF_TAG != 0) { const unsigned long long t0 = PROF_NOW(); while (PROF_NOW() - t0 < prof_acc) __builtin_amdgcn_s_sleep(4); }
}

extern "C" void kernel_launch(void* const* d_in, const int* in_sizes, int n_in, void* d_out, int out_size, void* d_ws, size_t ws_size, hipStream_t stream) {
    static int grid = 0;
    if (grid == 0) {
        if (n_in != 25 || in_sizes[0] != M * D || out_size != M * D || ws_size < WS_END) { fprintf(stderr, "kernel_launch: unexpected shapes (n_in %d, in0 %d, out %d, ws %zu, need %zu); nothing launched\n", n_in, n_in > 0 ? in_sizes[0] : -1, out_size, ws_size, (size_t)WS_END); grid = -1; return; }
        int dev = 0, cus = 0, per_cu = 0;
        if (hipGetDevice(&dev) != hipSuccess || hipDeviceGetAttribute(&cus, hipDeviceAttributeMultiprocessorCount, dev) != hipSuccess) { fprintf(stderr, "kernel_launch: device query failed\n"); grid = -1; return; }
        if (hipFuncSetAttribute((const void*)mk_fwd, hipFuncAttributeMaxDynamicSharedMemorySize, LDS_BYTES) != hipSuccess) { fprintf(stderr, "kernel_launch: hipFuncSetAttribute failed\n"); grid = -1; return; }
        if (hipOccupancyMaxActiveBlocksPerMultiprocessor(&per_cu, (const void*)mk_fwd, 512, LDS_BYTES) != hipSuccess || per_cu < 1) fprintf(stderr, "kernel_launch: occupancy query says %d\n", per_cu);
        (void)hipGetLastError();
        grid = cus;
        if (grid != 256) { fprintf(stderr, "kernel_launch: built for 256 CUs, found %d; nothing launched\n", cus); grid = -1; return; }
    }
    if (grid < 0) return;
    Args a{};
    for (int i = 0; i < 25; ++i) a.in[i] = (const float*)d_in[i];
    a.out = (float*)d_out; a.ws = (unsigned char*)d_ws;
#if MK_SINGLE
    if (hipMemsetAsync((char*)d_ws + WS_CTL, 0, CTL_ZERO_BYTES, stream) != hipSuccess) { fprintf(stderr, "kernel_launch: memset failed\n"); return; }
    a.step = 0; a.phase = 0;
    hipLaunchKernelGGL(mk_fwd, dim3(grid), dim3(512), LDS_BYTES, stream, a);
#else
    auto launch = [&](int s, int p) { a.step = s; a.phase = p; hipLaunchKernelGGL(mk_fwd, dim3(grid), dim3(512), LDS_BYTES, stream, a); };
    launch(-1, 0); launch(-1, 1); launch(-1, 2);
    for (int s = 0; s < 8; ++s) { launch(s, 0); launch(s, 1);
        if ((s & 1) == 0) { const int L = s >> 1;
            if ((L & 1) == 0) { launch(s, 2); launch(s, 3); } else { for (int p = 2; p <= 7; ++p) launch(s, p); }
            for (int p = 8; p <= 9; ++p) launch(s, p); } }
    launch(8, 0);
#endif
    const hipError_t le = hipPeekAtLastError();
    if (le != hipSuccess) fprintf(stderr, "kernel_launch: launch failed: %s\n", hipGetErrorName(le));
}
```

```cpp
#include <hip/hip_runtime.h>
#include <cstdio>
#include <cstdint>

#ifndef MK_SINGLE
#define MK_SINGLE 1
#endif

#ifndef PROF_TAG
#define PROF_TAG 0
#endif
#define PROF_NOW() __builtin_amdgcn_s_memrealtime()
#ifndef DOWN_WGM
#define DOWN_WGM 4
#endif
#ifndef DOWN_KREV
#define DOWN_KREV true
#endif
#ifndef REP_PRO
#define REP_PRO 1
#endif
#ifndef REP_GU
#define REP_GU 1
#endif
#ifndef REP_DOWN
#define REP_DOWN 1
#endif
#ifndef REP_THIN
#define REP_THIN 1
#endif
#ifndef STAGGER_TICKS
#define STAGGER_TICKS 0
#endif
#ifndef STAGGER_GROUPS
#define STAGGER_GROUPS 2
#endif
#ifndef STAGGER_GU_TICKS
#define STAGGER_GU_TICKS 0
#endif
#ifndef STAGGER_GU_GROUPS
#define STAGGER_GU_GROUPS 4
#endif
#ifndef REP_RES2K
#define REP_RES2K 1
#endif
#define LAS __attribute__((address_space(3)))
#define GAS __attribute__((address_space(1)))
typedef unsigned short bf16_t;
typedef short bf16x8 __attribute__((ext_vector_type(8)));
typedef float f32x4 __attribute__((ext_vector_type(4)));
typedef float f32x2 __attribute__((ext_vector_type(2)));
typedef unsigned u32x4 __attribute__((ext_vector_type(4)));
typedef unsigned u32x2 __attribute__((ext_vector_type(2)));
typedef GAS unsigned gu32;
#define LDS_WAIT() asm volatile("s_waitcnt lgkmcnt(0)" ::: "memory")
#define VM_WAIT() asm volatile("s_waitcnt vmcnt(0)" ::: "memory")

__device__ __forceinline__ unsigned cvt_pk_bf16(float lo, float hi) { unsigned r; asm volatile("v_cvt_pk_bf16_f32 %0, %1, %2" : "=v"(r) : "v"(lo), "v"(hi)); return r; }
typedef _Float16 f16x2 __attribute__((ext_vector_type(2)));
typedef _Float16 f16x8 __attribute__((ext_vector_type(8)));
__device__ __forceinline__ unsigned cvt_pk_f16(float lo, float hi) { const f16x2 v = {(_Float16)lo, (_Float16)hi}; return __builtin_bit_cast(unsigned, v); }
#ifndef H_TRIM
#define H_TRIM 2
#endif
__device__ __forceinline__ unsigned cvt_pk_h(float lo, float hi) { const unsigned w = cvt_pk_f16(lo, hi);
    if constexpr (H_TRIM > 0) { constexpr unsigned almost_half = ((1u << (H_TRIM - 1)) - 1u) * 0x00010001u, mask = ~(((1u << H_TRIM) - 1u) * 0x00010001u);
        return (w + almost_half + ((w >> H_TRIM) & 0x00010001u)) & mask; } else return w; }
template <bool F16> __device__ __forceinline__ unsigned cvt_pk16(float lo, float hi) { const unsigned b = cvt_pk_bf16(lo, hi); if constexpr (F16) return cvt_pk_f16(__uint_as_float(b << 16), __uint_as_float(b & 0xffff0000u)); else return b; }
__device__ __forceinline__ f32x4 f16x4_to_f32(u32x2 k) { const unsigned ka = k.x, kb = k.y; const f16x2 a = __builtin_bit_cast(f16x2, ka); const f16x2 b = __builtin_bit_cast(f16x2, kb);
    return (f32x4){(float)a.x, (float)a.y, (float)b.x, (float)b.y}; }
__device__ __forceinline__ f32x4 bf16x4_to_f32(u32x2 k) { return (f32x4){__uint_as_float(k.x << 16), __uint_as_float(k.x & 0xffff0000u), __uint_as_float(k.y << 16), __uint_as_float(k.y & 0xffff0000u)}; }
__device__ __forceinline__ float wave_sum(float v) {
#pragma unroll
    for (int o = 1; o < 64; o <<= 1) v += __shfl_xor(v, o);
    return v;
}
__device__ __forceinline__ float fast_sigmoid(float x) { return __builtin_amdgcn_rcpf(1.0f + __builtin_amdgcn_exp2f(-1.44269504089f * x)); }

constexpr int BATCH = 4, SEQ = 4096, D = 2048, DEPTH = 4, FF = 5632, MEML = 256, NH = 4, HD = 512, LH = 16;
constexpr int M = BATCH * SEQ;
constexpr int MM = BATCH * MEML;
constexpr float EPS = 1e-6f;

namespace pg8 {
constexpr int BM = 256, BK = 64, HALF = 128, HTB = HALF * BK * 2, STAGE_BYTES = 8 * HTB, NXCD = 8;
__host__ __device__ __forceinline__ int lds_byte(int r, int c) { const int st = (r >> 4) * 2 + (c >> 5), rr = r & 15, cc = c & 31, ob = rr * 64 + cc * 2; return st * 1024 + (ob ^ (((ob >> 9) & 1) << 5)); }
__host__ __device__ __forceinline__ void stage_rc(int b, int& R, int& C) { const int st = b / 1024, sb = b % 1024, swz = sb ^ (((sb >> 9) & 1) << 5); R = (st >> 1) * 16 + swz / 64; C = (st & 1) * 32 + (swz % 64) / 2; }
__host__ __device__ __forceinline__ int perm32(int rho) { const int n = rho >> 4, i = rho & 15; return 8 * (i >> 2) + 4 * n + (i & 3); }

struct Unit { int pm, pn; const char* a; const char* b; };

template <int nM, int nN, int WGM = 8> __device__ __forceinline__ bool unit_order(int i, int G, int c, int& pm, int& pn) {
    constexpr int nwg = nM * nN;
    const int L = i * G + c; if (L >= nwg) return false;
    int wgid = L; { constexpr int q = nwg / NXCD, r = nwg % NXCD; const int xcd = wgid % NXCD, off = wgid / NXCD; wgid = (xcd < r ? xcd * (q + 1) : r * (q + 1) + (xcd - r) * q) + off; }
    constexpr int nig = WGM * nN; const int gid = wgid / nig, fm = gid * WGM, gsz = (nM - fm) < WGM ? (nM - fm) : WGM;
    pm = fm + ((wgid % nig) % gsz); pn = (wgid % nig) / gsz; return true;
}
template <int MR, int NC, int K_, int LDA, int LDB, int APM, int APN, int ASH, int BPN, int BPM, int BSH, bool KREV_ = false, bool F16_ = false, int WGM_ = 8>
struct Sched {
    static constexpr int K = K_, lda = LDA, ldb = LDB; static constexpr bool KREV = KREV_, F16 = F16_;
    const char* A; const char* B; int G, c;
    __device__ __forceinline__ bool next(int i, Unit& u) const {
        if (!unit_order<MR / BM, NC / BM, WGM_>(i, G, c, u.pm, u.pn)) return false;
        u.a = A + (size_t)u.pm * APM + (size_t)(u.pn >> ASH) * APN + (KREV ? (K - BK) * 2 : 0); u.b = B + (size_t)u.pn * BPN + (size_t)(u.pm >> BSH) * BPM + (KREV ? (K - BK) * 2 : 0); return true;
    }
};
struct SchedG {
    static constexpr int K = 512, lda = 16384, ldb = 2048; static constexpr bool KREV = false, F16 = false;
    const char* KV; const char* WQN; int G, c;
    __device__ __forceinline__ bool next(int i, Unit& u) const {
        if (!unit_order<64, 8>(i, G, c, u.pm, u.pn)) return false;
        const int L = u.pm >> 4, b = (u.pm >> 2) & 3, h = u.pm & 3;
        u.a = KV + ((size_t)(b * 256) * 16384 + L * 2048 + h * 512) * 2; u.b = WQN + ((size_t)L * 2048 * 2048 + (size_t)u.pn * 256 * 2048 + h * 512) * 2; return true;
    }
};
struct SchedH {
    static constexpr int K = 512, lda = 2048, ldb = 16384; static constexpr bool KREV = false, F16 = false;
    const char* WOT; const char* KV; int G, c;
    __device__ __forceinline__ bool next(int i, Unit& u) const {
        if (!unit_order<32, 16>(i, G, c, u.pm, u.pn)) return false;
        const int L = u.pm >> 3, b = u.pn >> 2, h = u.pn & 3;
        u.a = WOT + ((size_t)u.pm * 256 * 2048 + h * 512) * 2; u.b = KV + ((size_t)(b * 256) * 16384 + 8192 + L * 2048 + h * 512) * 2; return true;
    }
};

__device__ __forceinline__ float row_rstd(const float* part, int row, int fq) {
    const f32x4* p = (const f32x4*)(part + (size_t)row * 32 + fq * 8);
    const f32x4 a = p[0], b = p[1];
    float s = ((a.x + a.y) + (a.z + a.w)) + ((b.x + b.y) + (b.z + b.w));
    s += __shfl_xor(s, 16); s += __shfl_xor(s, 32);
    return rsqrtf(s * (1.0f / 2048.0f) + EPS);
}

__device__ __forceinline__ void rstd_table(LAS float* tbl, const float* part, int pm, int tid) {
    if (tid < 256) { const f32x4* p = (const f32x4*)(part + (size_t)(pm * BM + tid) * 32); float sm = 0.f;
#pragma unroll
        for (int q = 0; q < 8; ++q) { const f32x4 a = p[q]; sm += (a[0] + a[1]) + (a[2] + a[3]); }
        tbl[tid] = rsqrtf(sm * (1.0f / 2048.0f) + EPS); }
    if (tid == 0) ((LAS int*)tbl)[256] = pm;
}
#define EPI_NO_PREPARE __device__ __forceinline__ void prepare(const Unit&, int) const {}
struct EpiSwiGLU {
    static constexpr bool PERM = true, AFTER_DRAIN = false, IS_RESID = false, IS_GU = true;
    bf16_t* O; const float* part; LAS float* tbl;
    __device__ __forceinline__ void prepare(const Unit& u, int tid) const { rstd_table(tbl, part, u.pm, tid); }
    __device__ __forceinline__ void operator()(f32x4 (&acc)[2][2][4][2], const Unit& u, int wr, int wc, int fr, int fq) const {
        const int row0 = u.pm * BM + wr * 64 + fr, col0 = u.pn * HALF + wc * 32 + 8 * fq;
        const bool tb = __builtin_amdgcn_readfirstlane(((const LAS int*)tbl)[256]) == u.pm;
#pragma unroll
        for (int ai = 0; ai < 2; ++ai)
#pragma unroll
            for (int m = 0; m < 4; ++m) { const int row = row0 + ai * HALF + m * 16; const float rs = tb ? tbl[ai * HALF + wr * 64 + m * 16 + fr] : row_rstd(part, row, fq);
                const f32x2 rsl = (f32x2){-1.44269504089f * rs, -1.44269504089f * rs}, rs2 = (f32x2){rs * rs, rs * rs}; f32x2 o[4];
#pragma unroll
                for (int n = 0; n < 2; ++n)
#pragma unroll
                    for (int jp = 0; jp < 2; ++jp) { const f32x2 ag = (f32x2){acc[ai][0][m][n][2 * jp], acc[ai][0][m][n][2 * jp + 1]}, au = (f32x2){acc[ai][1][m][n][2 * jp], acc[ai][1][m][n][2 * jp + 1]};
                        const f32x2 t = ag * rsl; f32x2 d = (f32x2){__builtin_amdgcn_exp2f(t.x), __builtin_amdgcn_exp2f(t.y)}; d = d + 1.0f;
                        const f32x2 r = (f32x2){__builtin_amdgcn_rcpf(d.x), __builtin_amdgcn_rcpf(d.y)}; o[n * 2 + jp] = (ag * au) * (r * rs2); }
                u32x4 w; w.x = cvt_pk_bf16(o[0].x, o[0].y); w.y = cvt_pk_bf16(o[1].x, o[1].y); w.z = cvt_pk_bf16(o[2].x, o[2].y); w.w = cvt_pk_bf16(o[3].x, o[3].y);
                *(u32x4*)(O + (size_t)row * FF + col0) = w; }
    }
};
struct EpiResid {
    EPI_NO_PREPARE
    static constexpr bool PERM = true, AFTER_DRAIN = false, IS_RESID = true, IS_GU = false;
    bf16_t* hb; float* part; float alpha;
    __device__ __forceinline__ void load_half(u32x4 (&xk)[4][2], int ai, int row0, int col0) const {
#pragma unroll
        for (int m = 0; m < 4; ++m) { const bf16_t* bp = hb + (size_t)(row0 + ai * HALF + m * 16) * D + col0; xk[m][0] = *(const u32x4*)bp; xk[m][1] = *(const u32x4*)(bp + HALF); }
    }
    __device__ __forceinline__ void fold_half(f32x4 (&acc)[2][2][4][2], const u32x4 (&xk)[4][2], int ai) const {
#pragma unroll
        for (int m = 0; m < 4; ++m)
#pragma unroll
            for (int bj = 0; bj < 2; ++bj) { const u32x4 k = xk[m][bj];
                const f32x4 x0 = f16x4_to_f32((u32x2){k.x, k.y}), x1 = f16x4_to_f32((u32x2){k.z, k.w});
                acc[ai][bj][m][0] = x0 + acc[ai][bj][m][0] * alpha; acc[ai][bj][m][1] = x1 + acc[ai][bj][m][1] * alpha; }
    }
    __device__ __forceinline__ void store_half(const f32x4 (&acc)[2][2][4][2], int ai, int row0, int col0, int slot, int fq) const {
#pragma unroll
        for (int m = 0; m < 4; ++m) { const int row = row0 + ai * HALF + m * 16; bf16_t* bp = hb + (size_t)row * D + col0; float ss = 0.f;
#pragma unroll
            for (int bj = 0; bj < 2; ++bj) { const f32x4 x0 = acc[ai][bj][m][0], x1 = acc[ai][bj][m][1];
                u32x4 w; w.x = cvt_pk_h(x0[0], x0[1]); w.y = cvt_pk_h(x0[2], x0[3]); w.z = cvt_pk_h(x1[0], x1[1]); w.w = cvt_pk_h(x1[2], x1[3]);
                *(u32x4*)(bp + bj * HALF) = w;
                ss += ((x0[0] * x0[0] + x0[1] * x0[1]) + (x0[2] * x0[2] + x0[3] * x0[3])) + ((x1[0] * x1[0] + x1[1] * x1[1]) + (x1[2] * x1[2] + x1[3] * x1[3])); }
            ss += __shfl_xor(ss, 16); ss += __shfl_xor(ss, 32);
            if (fq == 0) part[(size_t)row * 32 + slot] = ss; }
    }
    __device__ __forceinline__ void operator()(f32x4 (&acc)[2][2][4][2], const Unit& u, int wr, int wc, int fr, int fq) const {
        const int row0 = u.pm * BM + wr * 64 + fr, col0 = u.pn * BM + wc * 32 + 8 * fq, slot = u.pn * 4 + wc;
        u32x4 xk[4][2], xk1[4][2];
        load_half(xk, 0, row0, col0);
#pragma unroll
        for (int m = 0; m < 3; ++m) { const bf16_t* bp = hb + (size_t)(row0 + HALF + m * 16) * D + col0; xk1[m][0] = *(const u32x4*)bp; xk1[m][1] = *(const u32x4*)(bp + HALF); }
        asm volatile("" ::: "memory");
        fold_half(acc, xk, 0); asm volatile("" ::: "memory");
        { const bf16_t* bp = hb + (size_t)(row0 + HALF + 3 * 16) * D + col0; xk1[3][0] = *(const u32x4*)bp; xk1[3][1] = *(const u32x4*)(bp + HALF); }
        asm volatile("" ::: "memory");
        store_half(acc, 0, row0, col0, slot, fq); asm volatile("" ::: "memory");
        fold_half(acc, xk1, 1);
        store_half(acc, 1, row0, col0, slot, fq);
    }
};
struct EpiRowScale {
    EPI_NO_PREPARE
    static constexpr bool PERM = true, AFTER_DRAIN = false, IS_RESID = false, IS_GU = false;
    bf16_t* O; int ldo; const float* part;
    __device__ __forceinline__ void operator()(f32x4 (&acc)[2][2][4][2], const Unit& u, int wr, int wc, int fr, int fq) const {
        const int row0 = u.pm * BM + wr * 64 + fr, col0 = u.pn * BM + wc * 32 + 8 * fq;
#pragma unroll
        for (int ai = 0; ai < 2; ++ai)
#pragma unroll
            for (int m = 0; m < 4; ++m) { const int row = row0 + ai * HALF + m * 16; const float rs = row_rstd(part, row, fq); bf16_t* rp = O + (size_t)row * ldo + col0;
#pragma unroll
                for (int bj = 0; bj < 2; ++bj) { const f32x4 v0 = acc[ai][bj][m][0] * rs, v1 = acc[ai][bj][m][1] * rs;
                    u32x4 w; w.x = cvt_pk_bf16(v0[0], v0[1]); w.y = cvt_pk_bf16(v0[2], v0[3]); w.z = cvt_pk_bf16(v1[0], v1[1]); w.w = cvt_pk_bf16(v1[2], v1[3]);
                    *(u32x4*)(rp + bj * HALF) = w; } }
    }
};
template <bool F16OUT> struct EpiPlain {
    EPI_NO_PREPARE
    static constexpr bool PERM = true, AFTER_DRAIN = false, IS_RESID = false, IS_GU = false;
    bf16_t* O; int ldo;
    __device__ __forceinline__ void operator()(f32x4 (&acc)[2][2][4][2], const Unit& u, int wr, int wc, int fr, int fq) const {
        const int row0 = u.pm * BM + wr * 64 + fr, col0 = u.pn * BM + wc * 32 + 8 * fq;
#pragma unroll
        for (int ai = 0; ai < 2; ++ai)
#pragma unroll
            for (int m = 0; m < 4; ++m) { bf16_t* rp = O + (size_t)(row0 + ai * HALF + m * 16) * ldo + col0;
#pragma unroll
                for (int bj = 0; bj < 2; ++bj) { const f32x4 v0 = acc[ai][bj][m][0], v1 = acc[ai][bj][m][1];
                    u32x4 w; w.x = cvt_pk16<F16OUT>(v0[0], v0[1]); w.y = cvt_pk16<F16OUT>(v0[2], v0[3]); w.z = cvt_pk16<F16OUT>(v1[0], v1[1]); w.w = cvt_pk16<F16OUT>(v1[2], v1[3]);
                    *(u32x4*)(rp + bj * HALF) = w; } }
    }
};
struct EpiLruIn {
    static constexpr bool PERM = true, AFTER_DRAIN = false, IS_RESID = false, IS_GU = false;
    bf16_t* gg; bf16_t* xr; const float* part; LAS float* tbl;
    __device__ __forceinline__ void prepare(const Unit& u, int tid) const { rstd_table(tbl, part, u.pm, tid); }
    __device__ __forceinline__ void operator()(f32x4 (&acc)[2][2][4][2], const Unit& u, int wr, int wc, int fr, int fq) const {
        const int row0 = u.pm * BM + wr * 64 + fr; const bool isg = u.pn < 8; const int col0 = (isg ? u.pn : u.pn - 8) * BM + wc * 32 + 8 * fq; bf16_t* O = isg ? gg : xr;
        const bool tb = __builtin_amdgcn_readfirstlane(((const LAS int*)tbl)[256]) == u.pm;
#pragma unroll
        for (int ai = 0; ai < 2; ++ai)
#pragma unroll
            for (int m = 0; m < 4; ++m) { const int row = row0 + ai * HALF + m * 16; const float rs = tb ? tbl[ai * HALF + wr * 64 + m * 16 + fr] : row_rstd(part, row, fq);
#pragma unroll
                for (int bj = 0; bj < 2; ++bj) { const f32x4 v0 = acc[ai][bj][m][0] * rs, v1 = acc[ai][bj][m][1] * rs; float o[8];
#pragma unroll
                    for (int j = 0; j < 8; ++j) { const float x = j < 4 ? v0[j] : v1[j - 4]; o[j] = isg ? x * fast_sigmoid(1.5957691216f * (x + 0.044715f * x * x * x)) : x; }
                    u32x4 w; w.x = cvt_pk_bf16(o[0], o[1]); w.y = cvt_pk_bf16(o[2], o[3]); w.z = cvt_pk_bf16(o[4], o[5]); w.w = cvt_pk_bf16(o[6], o[7]);
                    *(u32x4*)(O + (size_t)row * D + col0 + bj * HALF) = w; } }
    }
};
struct EpiGates {
    EPI_NO_PREPARE
    static constexpr bool PERM = true, AFTER_DRAIN = false, IS_RESID = false, IS_GU = false;
    bf16_t* LA; bf16_t* Bt; const bf16_t* xc; const float* ba; const float* bx; const float* sp8;
    __device__ __forceinline__ void operator()(f32x4 (&acc)[2][2][4][2], const Unit& u, int wr, int wc, int fr, int fq) const {
        const int row0 = u.pm * BM + wr * 64 + fr, c0 = u.pn * HALF + wc * 32 + 8 * fq;
        f32x4 bav[2], bxv[2], spv[2];
#pragma unroll
        for (int n = 0; n < 2; ++n) { bav[n] = *(const f32x4*)(ba + c0 + 4 * n); bxv[n] = *(const f32x4*)(bx + c0 + 4 * n); spv[n] = *(const f32x4*)(sp8 + c0 + 4 * n) * 1.44269504089f; }
        u32x4 xkv[8];
#pragma unroll
        for (int g = 0; g < 8; ++g) xkv[g] = *(const u32x4*)(xc + (size_t)(row0 + (g >> 2) * HALF + (g & 3) * 16) * D + c0);
        asm volatile("" ::: "memory");
#pragma unroll
        for (int ai = 0; ai < 2; ++ai)
#pragma unroll
            for (int m = 0; m < 4; ++m) { const int row = row0 + ai * HALF + m * 16; const u32x4 xk = xkv[ai * 4 + m]; float lo[8], bo[8];
#pragma unroll
                for (int n = 0; n < 2; ++n) { const unsigned k0 = n == 0 ? xk.x : xk.z, k1 = n == 0 ? xk.y : xk.w;
                    const f32x4 xv = (f32x4){__uint_as_float(k0 << 16), __uint_as_float(k0 & 0xffff0000u), __uint_as_float(k1 << 16), __uint_as_float(k1 & 0xffff0000u)};
#pragma unroll
                    for (int j = 0; j < 4; ++j) { const float r = fast_sigmoid(acc[ai][0][m][n][j] + bav[n][j]), ig = fast_sigmoid(acc[ai][1][m][n][j] + bxv[n][j]);
                        const float l2 = -r * spv[n][j];
                        const float l2r = __uint_as_float(cvt_pk_bf16(l2, l2) << 16);
                        const float t = 1.38629436112f * l2r;
                        const float ser = -t * (1.0f + 0.5f * t * (1.0f + (1.0f / 3.0f) * t * (1.0f + 0.25f * t * (1.0f + 0.2f * t * (1.0f + (1.0f / 6.0f) * t)))));
                        const float om = t > -0.3f ? ser : 1.0f - __builtin_amdgcn_exp2f(2.0f * l2r);
                        lo[n * 4 + j] = l2; bo[n * 4 + j] = sqrtf(om) * ig * xv[j]; } }
                u32x4 wl, wb; wl.x = cvt_pk_bf16(lo[0], lo[1]); wl.y = cvt_pk_bf16(lo[2], lo[3]); wl.z = cvt_pk_bf16(lo[4], lo[5]); wl.w = cvt_pk_bf16(lo[6], lo[7]);
                wb.x = cvt_pk_bf16(bo[0], bo[1]); wb.y = cvt_pk_bf16(bo[2], bo[3]); wb.z = cvt_pk_bf16(bo[4], bo[5]); wb.w = cvt_pk_bf16(bo[6], bo[7]);
                *(u32x4*)(LA + (size_t)row * D + c0) = wl; *(u32x4*)(Bt + (size_t)row * D + c0) = wb; }
    }
};
struct EpiSoftmax {
    EPI_NO_PREPARE
    static constexpr bool PERM = true, AFTER_DRAIN = true, IS_RESID = false, IS_GU = false;
    bf16_t* P; const float* part;
    __device__ __forceinline__ void fused(f32x4 (&acc)[2][2][4][2], const Unit& u, int wr, int wc, int fr, int fq, LAS unsigned char* lds, int wid, int lane) const {
        LAS float* X = (LAS float*)lds; LAS float* Y = (LAS float*)(lds + 4096);
#pragma unroll
        for (int ai = 0; ai < 2; ++ai)
#pragma unroll
            for (int m = 0; m < 4; ++m) { float mx = -3.0e38f; const float rs = row_rstd(part, u.pm * BM + ai * HALF + wr * 64 + m * 16 + fr, fq);
#pragma unroll
                for (int bj = 0; bj < 2; ++bj)
#pragma unroll
                    for (int n = 0; n < 2; ++n) { acc[ai][bj][m][n] = acc[ai][bj][m][n] * rs; const f32x4 x = acc[ai][bj][m][n]; mx = fmaxf(mx, fmaxf(fmaxf(x[0], x[1]), fmaxf(x[2], x[3]))); }
                mx = fmaxf(mx, __shfl_xor(mx, 16)); mx = fmaxf(mx, __shfl_xor(mx, 32));
                if (fq == 0) X[(ai * HALF + wr * 64 + m * 16 + fr) * 4 + wc] = mx; }
        LDS_WAIT(); __builtin_amdgcn_s_barrier(); asm volatile("" ::: "memory");
#pragma unroll
        for (int ai = 0; ai < 2; ++ai)
#pragma unroll
            for (int m = 0; m < 4; ++m) { const int r = ai * HALF + wr * 64 + m * 16 + fr; const f32x4 v = *(const LAS f32x4*)(X + r * 4);
                const float mx = fmaxf(fmaxf(v[0], v[1]), fmaxf(v[2], v[3])) * 1.44269504089f; float s = 0.f;
#pragma unroll
                for (int bj = 0; bj < 2; ++bj)
#pragma unroll
                    for (int n = 0; n < 2; ++n)
#pragma unroll
                        for (int j = 0; j < 4; ++j) { const float p = __builtin_amdgcn_exp2f(acc[ai][bj][m][n][j] * 1.44269504089f - mx); acc[ai][bj][m][n][j] = p; s += p; }
                s += __shfl_xor(s, 16); s += __shfl_xor(s, 32);
                if (fq == 0) Y[r * 4 + wc] = s; }
        LDS_WAIT(); __builtin_amdgcn_s_barrier(); asm volatile("" ::: "memory");
#pragma unroll
        for (int ai = 0; ai < 2; ++ai)
#pragma unroll
            for (int m = 0; m < 4; ++m) { const int r = ai * HALF + wr * 64 + m * 16 + fr; const f32x4 v = *(const LAS f32x4*)(Y + r * 4);
                const float inv = 1.0f / ((v[0] + v[1]) + (v[2] + v[3])); bf16_t* rp = P + (size_t)(u.pm * BM + r) * 1024 + u.pn * BM + wc * 32 + 8 * fq;
#pragma unroll
                for (int bj = 0; bj < 2; ++bj) { const f32x4 v0 = acc[ai][bj][m][0] * inv, v1 = acc[ai][bj][m][1] * inv;
                    u32x4 w; w.x = cvt_pk_bf16(v0[0], v0[1]); w.y = cvt_pk_bf16(v0[2], v0[3]); w.z = cvt_pk_bf16(v1[0], v1[1]); w.w = cvt_pk_bf16(v1[2], v1[3]);
                    *(u32x4*)(rp + bj * HALF) = w; } }
    }
};

template <bool F16> __device__ __forceinline__ f32x4 mma16(bf16x8 b, bf16x8 a, f32x4 c) {
    if constexpr (F16) return __builtin_amdgcn_mfma_f32_16x16x32_f16(__builtin_bit_cast(f16x8, b), __builtin_bit_cast(f16x8, a), c, 0, 0, 0);
    else return __builtin_amdgcn_mfma_f32_16x16x32_bf16(b, a, c, 0, 0, 0);
}
template <class Epi, bool ALIGN_EPI, int PID, class SchedT>
__device__ __forceinline__ void gemm_phase(LAS unsigned char* lds, const SchedT& S, const Epi& E, unsigned long long& pacc) {
    unsigned long long pt0 = 0, pt1 = 0; (void)pt0; (void)pt1;
    if constexpr (PROF_TAG == PID * 10 + 0) pt0 = PROF_NOW();
    { constexpr int ticks = Epi::IS_RESID ? STAGGER_TICKS : Epi::IS_GU ? STAGGER_GU_TICKS : 0;
      if constexpr (ticks > 0) { const unsigned grp = (blockIdx.x >> 3) & (Epi::IS_RESID ? (STAGGER_GROUPS - 1) : (STAGGER_GU_GROUPS - 1));
        if (grp) { const unsigned long long t0 = __builtin_amdgcn_s_memrealtime(), want = (unsigned long long)ticks * grp; while (__builtin_amdgcn_s_memrealtime() - t0 < want) __builtin_amdgcn_s_sleep(8); } } }
    int tid_ = threadIdx.x; asm volatile("" : "+v"(tid_));
    const int tid = tid_, wid = __builtin_amdgcn_readfirstlane(tid >> 6), lane = tid & 63, wr = wid >> 2, wc = wid & 3, fr = lane & 15, fq = lane >> 4;
    constexpr int K = SchedT::K, nt = K / BK;
    static_assert(K % 128 == 0 && K >= 256, "K multiple of 128, >= 256");
    unsigned voffA[2], voffB[2];
#pragma unroll
    for (int i = 0; i < 2; ++i) { int R, C; stage_rc(tid * 16 + i * 8192, R, C); const int Rb = Epi::PERM ? ((R & ~31) + perm32(R & 31)) : R;
        voffA[i] = (unsigned)(R * SchedT::lda + C) * 2u; voffB[i] = (unsigned)(Rb * SchedT::ldb + C) * 2u; }
    constexpr long kstep = SchedT::KREV ? -(long)(BK * 2) : (long)(BK * 2);
    constexpr size_t hstepA = (size_t)HALF * SchedT::lda * 2, hstepB = (size_t)HALF * SchedT::ldb * 2;
    const unsigned ldsw = (unsigned)wid * 1024u;
    const int aoff = lds_byte(wr * 64 + fr, fq * 8), boff = lds_byte(wc * 32 + fr, fq * 8);
#define PG8_SA(b, h) (((b) * 2 + (h)) * HTB)
#define PG8_SB(b, h) ((4 + (b) * 2 + (h)) * HTB)
#define PG8_STAGE(bufoff, gbase, voff) do { _Pragma("unroll") for (int _i = 0; _i < 2; ++_i) \
        __builtin_amdgcn_global_load_lds((const unsigned*)((const char*)(gbase) + (voff)[_i]), (LAS unsigned*)(lds + (bufoff) + ldsw + _i * 8192), 16, 0, 0); } while (0)
#define PG8_LDA(dst, b, h) do { _Pragma("unroll") for (int m = 0; m < 4; ++m) _Pragma("unroll") for (int k = 0; k < 2; ++k) dst[m][k] = *(const LAS bf16x8*)(lds + PG8_SA(b, h) + aoff + m * 2048 + k * 1024); } while (0)
#define PG8_LDB(dst, b, h) do { _Pragma("unroll") for (int n = 0; n < 2; ++n) _Pragma("unroll") for (int k = 0; k < 2; ++k) dst[n][k] = *(const LAS bf16x8*)(lds + PG8_SB(b, h) + boff + n * 2048 + k * 1024); } while (0)
#define PG8_MMA(ai, bj, At, Bt) do { _Pragma("unroll") for (int k = 0; k < 2; ++k) { __builtin_amdgcn_s_setprio(1); _Pragma("unroll") for (int m = 0; m < 4; ++m) _Pragma("unroll") for (int n = 0; n < 2; ++n) \
        acc[ai][bj][m][n] = mma16<SchedT::F16>(Bt[n][k], At[m][k], acc[ai][bj][m][n]); __builtin_amdgcn_s_setprio(0); } } while (0)
#define PG8_WAIT_V(n) asm volatile("s_waitcnt vmcnt(" #n ")" ::: "memory")
#define PG8_WAIT_L(n) asm volatile("s_waitcnt lgkmcnt(" #n ")" ::: "memory")
#define PG8_BAR __builtin_amdgcn_s_barrier()
#define PG8_SCHED __builtin_amdgcn_sched_barrier(0)
    Unit cur, nxt; int ui = 0;
    if (!S.next(0, cur)) return;
    E.prepare(cur, tid);
    f32x4 acc[2][2][4][2];
#pragma unroll
    for (int a = 0; a < 2; ++a)
#pragma unroll
        for (int b = 0; b < 2; ++b)
#pragma unroll
            for (int m = 0; m < 4; ++m)
#pragma unroll
                for (int n = 0; n < 2; ++n) acc[a][b][m][n] = (f32x4){0.f, 0.f, 0.f, 0.f};
    bf16x8 At[4][2], B0[2][2], B1[2][2];
    const char* cA = cur.a; const char* cB = cur.b;
    PG8_STAGE(PG8_SB(0, 0), cB, voffB); PG8_STAGE(PG8_SB(0, 1), cB + hstepB, voffB); PG8_STAGE(PG8_SA(0, 0), cA, voffA); PG8_STAGE(PG8_SA(0, 1), cA + hstepA, voffA);
    if (wr == 1) PG8_BAR;
    PG8_WAIT_V(2); PG8_BAR;
    PG8_STAGE(PG8_SB(1, 0), cB + kstep, voffB); PG8_STAGE(PG8_SA(1, 0), cA + kstep, voffA); PG8_STAGE(PG8_SB(1, 1), cB + hstepB + kstep, voffB);
    PG8_WAIT_V(6); PG8_BAR;
    for (;;) {
        const bool has_next = S.next(ui + 1, nxt);
        const char* nA = has_next ? nxt.a : cA; const char* nB = has_next ? nxt.b : cB;
        if constexpr (PROF_TAG == PID * 10 + 1) pt0 = PROF_NOW();
#pragma unroll 1
        for (int t = 0; t < nt; t += 2) {
            const bool last = (t == nt - 2);
            if constexpr (PROF_TAG == PID * 10 + 4) { if (t == 0) pt0 = PROF_NOW(); }
            if constexpr (PROF_TAG == PID * 10 + 5) { if (t == 2) pt0 = PROF_NOW(); }
            const char* a1 = cA + (long)(t + 1) * kstep;
            const char* a2 = last ? nA : cA + (long)(t + 2) * kstep; const char* b2 = last ? nB : cB + (long)(t + 2) * kstep;
            const char* a3 = a2 + kstep; const char* b3 = b2 + kstep;
            PG8_LDB(B0, 0, 0); PG8_LDB(B1, 0, 1); PG8_SCHED; PG8_LDA(At, 0, 0); PG8_STAGE(PG8_SA(1, 1), a1 + hstepA, voffA);
            PG8_WAIT_V(8); PG8_WAIT_L(0); PG8_BAR; PG8_MMA(0, 0, At, B0); PG8_MMA(0, 1, At, B1); PG8_BAR; PG8_SCHED;
            PG8_LDA(At, 0, 1); PG8_STAGE(PG8_SB(0, 0), b2, voffB); PG8_STAGE(PG8_SB(0, 1), b2 + hstepB, voffB); PG8_STAGE(PG8_SA(0, 0), a2, voffA);
            PG8_WAIT_V(8); PG8_WAIT_L(0); PG8_BAR; PG8_MMA(1, 0, At, B0); PG8_MMA(1, 1, At, B1); PG8_BAR; PG8_SCHED;
            PG8_LDB(B0, 1, 0); PG8_LDB(B1, 1, 1); PG8_SCHED; PG8_LDA(At, 1, 0); PG8_STAGE(PG8_SA(0, 1), a2 + hstepA, voffA);
            PG8_WAIT_V(8); PG8_WAIT_L(0); PG8_BAR; PG8_MMA(0, 0, At, B0); PG8_MMA(0, 1, At, B1); PG8_BAR; PG8_SCHED;
            PG8_LDA(At, 1, 1); PG8_STAGE(PG8_SB(1, 0), b3, voffB); PG8_STAGE(PG8_SB(1, 1), b3 + hstepB, voffB); PG8_STAGE(PG8_SA(1, 0), a3, voffA);
            PG8_WAIT_V(8); PG8_WAIT_L(0); PG8_BAR; PG8_MMA(1, 0, At, B0); PG8_MMA(1, 1, At, B1); PG8_BAR; PG8_SCHED;
            if constexpr (PROF_TAG == PID * 10 + 4) { if (t == 0) pacc += PROF_NOW() - pt0; }
            if constexpr (PROF_TAG == PID * 10 + 5) { if (t == 2) pacc += PROF_NOW() - pt0; }
        }
        if constexpr (PROF_TAG == PID * 10 + 1) pacc += PROF_NOW() - pt0;
        if constexpr (PROF_TAG == PID * 10 + 2) pt0 = PROF_NOW();
        if constexpr (ALIGN_EPI) { if (wr == 0) PG8_BAR; }
        if constexpr (PROF_TAG == PID * 10 + 3) pt0 = PROF_NOW();
        if constexpr (!Epi::AFTER_DRAIN) { E(acc, cur, wr, wc, fr, fq); }
        if constexpr (PROF_TAG == PID * 10 + 2 || PROF_TAG == PID * 10 + 3) pacc += PROF_NOW() - pt0;
        if (!has_next) break;
#pragma unroll
        for (int a = 0; a < 2; ++a)
#pragma unroll
            for (int b = 0; b < 2; ++b)
#pragma unroll
                for (int m = 0; m < 4; ++m)
#pragma unroll
                    for (int n = 0; n < 2; ++n) acc[a][b][m][n] = (f32x4){0.f, 0.f, 0.f, 0.f};
        cur = nxt; cA = nA; cB = nB; ++ui;
        if constexpr (ALIGN_EPI) { if (wr == 1) PG8_BAR; }
    }
    PG8_WAIT_V(0);
    if constexpr (!ALIGN_EPI) { if (wr == 0) PG8_BAR; }
    PG8_BAR;
    if constexpr (Epi::AFTER_DRAIN) { E.fused(acc, cur, wr, wc, fr, fq, lds, wid, lane); }
    if constexpr (PROF_TAG == PID * 10 + 0) pacc += PROF_NOW() - pt0;
#undef PG8_SA
#undef PG8_SB
#undef PG8_STAGE
#undef PG8_LDA
#undef PG8_LDB
#undef PG8_MMA
#undef PG8_WAIT_V
#undef PG8_WAIT_L
#undef PG8_BAR
#undef PG8_SCHED
}
}

constexpr size_t MiB = 1u << 20;
constexpr size_t WS_CTL = 0, CTL_ZERO_BYTES = 1 * MiB;
constexpr size_t WS_SP = 1 * MiB;
constexpr size_t WS_CHA = 2 * MiB, WS_CHB = 4 * MiB;
constexpr size_t WS_PART = 6 * MiB;
constexpr size_t WS_MB = 8 * MiB;
constexpr size_t WS_KV = 12 * MiB;
constexpr size_t WS_WGU = 48 * MiB;
constexpr size_t WS_WD = 400 * MiB;
constexpr size_t WS_WQN = 576 * MiB;
constexpr size_t WS_WK = 608 * MiB, WS_WV = 640 * MiB, WS_WO = 672 * MiB;
constexpr size_t WS_WIN = 704 * MiB;
constexpr size_t WS_WOUT = 736 * MiB;
constexpr size_t WS_WP = 752 * MiB;
constexpr size_t WS_WGATE = 756 * MiB;
constexpr size_t WS_HB = 760 * MiB;
constexpr size_t WS_ACT = 824 * MiB;
constexpr size_t WS_S = 1000 * MiB;
constexpr size_t WS_P = WS_S;
constexpr size_t WS_POOLED = WS_S;
constexpr size_t WS_GG = WS_S, WS_BT = WS_S + 64 * MiB, WS_XCB = WS_S + 192 * MiB;
constexpr size_t WS_XR = WS_ACT;
constexpr size_t WS_LA = WS_ACT + 64 * MiB;
constexpr size_t WS_GALL = WS_S + 256 * MiB;
constexpr size_t WS_HALL = WS_S + 320 * MiB;
constexpr size_t WS_END = WS_S + 384 * MiB;
constexpr int CW_BAR = 4096;
constexpr int LDS_BYTES = 147456, MISC_OFF = LDS_BYTES - 512, EPI_TBL_OFF = 131072;

#define XB_TMO      128
#define XB_XCNT(j)  (256  + 64 * (j))
#define XB_XSUB(j)  (1280 + 64 * (j))
#define XB_XGEN(j)  (2304 + 64 * (j))
#define XB_TOP      3328
#define XB_TOPGEN   3392
#define XCD_BAR_WORDS 3456
#define XB_SPIN_CAP (1u << 18)
__device__ __forceinline__ unsigned xb_ld(unsigned* p)              { return __hip_atomic_load(p, __ATOMIC_RELAXED, __HIP_MEMORY_SCOPE_AGENT); }
__device__ __forceinline__ unsigned xb_add(unsigned* p, unsigned v) { return __hip_atomic_fetch_add(p, v, __ATOMIC_RELAXED, __HIP_MEMORY_SCOPE_AGENT); }
__device__ __forceinline__ unsigned xb_xcc_id() { return (unsigned)__builtin_amdgcn_s_getreg((3 << 11) | 20) & 0xFu; }
#define XB_SPIN(cond, bar) do { unsigned _sp = 0; while (cond) { __builtin_amdgcn_s_sleep(1); \
    if ((++_sp & 255u) == 0u) { if (xb_ld(&(bar)[XB_TMO])) break; if (_sp > XB_SPIN_CAP) { atomicAdd(&(bar)[XB_TMO], 1u); break; } } } } while (0)
struct XcdBarrier { unsigned* bar; unsigned x; volatile LAS unsigned* st; };
__device__ __forceinline__ XcdBarrier xcd_barrier_post(unsigned* bar, volatile LAS unsigned* st) {
    XcdBarrier b; b.bar = bar; b.x = xb_xcc_id(); b.st = st;
    if (threadIdx.x == 0) (void)xb_add(&bar[XB_XCNT(b.x)], 1u);
    return b;
}
__device__ __forceinline__ void xcd_barrier_complete(unsigned* bar, unsigned x, unsigned& nloc, unsigned& nx) {
    const unsigned G = gridDim.x * gridDim.y * gridDim.z;
    unsigned sum, cnt, mine, sp = 0u;
    for (;;) {
        sum = 0u; cnt = 0u; mine = 0u;
#pragma unroll
        for (unsigned j = 0; j < 16; ++j) { const unsigned c = xb_ld(&bar[XB_XCNT(j)]); sum += c; cnt += (c > 0u) ? 1u : 0u; mine = (j == x) ? c : mine; }
        if (sum == G) break;
        __builtin_amdgcn_s_sleep(1);
        if ((++sp & 255u) == 0u) { if (xb_ld(&bar[XB_TMO])) break; if (sp > XB_SPIN_CAP) { atomicAdd(&bar[XB_TMO], 1u); break; } }
    }
    nloc = mine > 0u ? mine : 1u; nx = cnt > 0u ? cnt : 1u;
}
__device__ __forceinline__ void xcd_barrier(const XcdBarrier& b) {
    asm volatile("s_waitcnt vmcnt(0)" ::: "memory");
    __syncthreads();
    if (threadIdx.x == 0) {
        unsigned* bar = b.bar;
        __builtin_amdgcn_s_waitcnt(0);
        unsigned nloc = b.st[0], nx = b.st[1];
        if (nloc == 0u) { xcd_barrier_complete(bar, b.x, nloc, nx); b.st[0] = nloc; b.st[1] = nx; }
        const unsigned old = xb_add(&bar[XB_XSUB(b.x)], 1u);
        const unsigned gen = old / nloc;
        if (old + 1u == (gen + 1u) * nloc) {
            __builtin_amdgcn_fence(__ATOMIC_RELEASE, "agent");
            asm volatile("s_waitcnt vmcnt(0)" ::: "memory");
            const unsigned og = xb_add(&bar[XB_TOP], 1u);
            const unsigned tg = og / nx;
            if (og + 1u == (tg + 1u) * nx) xb_add(&bar[XB_TOPGEN], 1u);
            else XB_SPIN(xb_ld(&bar[XB_TOPGEN]) == tg, bar);
            __builtin_amdgcn_fence(__ATOMIC_ACQUIRE, "agent");
            xb_add(&bar[XB_XGEN(b.x)], 1u);
            asm volatile("s_waitcnt vmcnt(0)" ::: "memory");
        } else {
            XB_SPIN(xb_ld(&bar[XB_XGEN(b.x)]) == gen, bar);
            __builtin_amdgcn_fence(__ATOMIC_ACQUIRE, "agent");
            asm volatile("s_waitcnt vmcnt(0)" ::: "memory");
        }
    }
    __syncthreads();
}

template <bool F16OUT = false>
__device__ __forceinline__ void tr_item(const float* src, int ldw, bf16_t* dst, int ldd, const float* ks, const float* ns, float sc, bf16_t* dstz, LAS float* scr, int lane) {
    f32x4 v[16];
    const float* s0 = src + (size_t)(lane >> 4) * ldw + (lane & 15) * 4;
#pragma unroll
    for (int i = 0; i < 16; ++i) v[i] = *(const f32x4*)(s0 + (size_t)(4 * i) * ldw);
#pragma unroll
    for (int i = 0; i < 16; ++i) { LAS float* p = scr + ((lane >> 4) + 4 * i) * 65 + (lane & 15) * 4; p[0] = v[i][0]; p[1] = v[i][1]; p[2] = v[i][2]; p[3] = v[i][3]; }
    LDS_WAIT(); asm volatile("" ::: "memory");
    const int c = lane & 7;
    f32x4 k0v = (f32x4){sc, sc, sc, sc}, k1v = k0v;
    if (ks) { k0v = *(const f32x4*)(ks + 8 * c) * sc; k1v = *(const f32x4*)(ks + 8 * c + 4) * sc; }
#pragma unroll
    for (int j = 0; j < 8; ++j) { const int n = (lane >> 3) + 8 * j; const LAS float* s = scr + (8 * c) * 65 + n; const float nsv = ns ? ns[n] : 1.0f;
        u32x4 o; o.x = cvt_pk16<F16OUT>(s[0 * 65] * k0v[0] * nsv, s[1 * 65] * k0v[1] * nsv); o.y = cvt_pk16<F16OUT>(s[2 * 65] * k0v[2] * nsv, s[3 * 65] * k0v[3] * nsv);
        o.z = cvt_pk16<F16OUT>(s[4 * 65] * k1v[0] * nsv, s[5 * 65] * k1v[1] * nsv); o.w = cvt_pk16<F16OUT>(s[6 * 65] * k1v[2] * nsv, s[7 * 65] * k1v[3] * nsv);
        *(u32x4*)(dst + (size_t)n * ldd + 8 * c) = o;
        if (dstz) *(u32x4*)(dstz + (size_t)n * ldd + 8 * c) = (u32x4){0u, 0u, 0u, 0u}; }
    LDS_WAIT(); asm volatile("" ::: "memory");
}

struct TrItem { const float* src; bf16_t* dst; const float* ks; const float* ns; bf16_t* dstz; int ldw, ldd, f16; };
__device__ __forceinline__ void tr_load(const TrItem& t, f32x4 (&v)[16], int lane) {
    const float* s0 = t.src + (size_t)(lane >> 4) * t.ldw + (lane & 15) * 4;
#pragma unroll
    for (int i = 0; i < 16; ++i) v[i] = *(const f32x4*)(s0 + (size_t)(4 * i) * t.ldw);
}
template <bool F16OUT>
__device__ __forceinline__ void tr_finish_t(const TrItem& t, const f32x4 (&v)[16], LAS float* scr, int lane) {
#pragma unroll
    for (int i = 0; i < 16; ++i) { LAS float* p = scr + ((lane >> 4) + 4 * i) * 65 + (lane & 15) * 4; p[0] = v[i][0]; p[1] = v[i][1]; p[2] = v[i][2]; p[3] = v[i][3]; }
    LDS_WAIT(); asm volatile("" ::: "memory");
    const int c = lane & 7;
    f32x4 k0v = (f32x4){1.f, 1.f, 1.f, 1.f}, k1v = k0v;
    if (t.ks) { k0v = *(const f32x4*)(t.ks + 8 * c); k1v = *(const f32x4*)(t.ks + 8 * c + 4); }
#pragma unroll
    for (int j = 0; j < 8; ++j) { const int n = (lane >> 3) + 8 * j; const LAS float* s = scr + (8 * c) * 65 + n; const float nsv = t.ns ? t.ns[n] : 1.0f;
        u32x4 o; o.x = cvt_pk16<F16OUT>(s[0 * 65] * k0v[0] * nsv, s[1 * 65] * k0v[1] * nsv); o.y = cvt_pk16<F16OUT>(s[2 * 65] * k0v[2] * nsv, s[3 * 65] * k0v[3] * nsv);
        o.z = cvt_pk16<F16OUT>(s[4 * 65] * k1v[0] * nsv, s[5 * 65] * k1v[1] * nsv); o.w = cvt_pk16<F16OUT>(s[6 * 65] * k1v[2] * nsv, s[7 * 65] * k1v[3] * nsv);
        *(u32x4*)(t.dst + (size_t)n * t.ldd + 8 * c) = o;
        if (t.dstz) *(u32x4*)(t.dstz + (size_t)n * t.ldd + 8 * c) = (u32x4){0u, 0u, 0u, 0u}; }
    LDS_WAIT(); asm volatile("" ::: "memory");
}
__device__ __forceinline__ void tr_finish(const TrItem& t, const f32x4 (&v)[16], LAS float* scr, int lane) { if (t.f16) tr_finish_t<true>(t, v, scr, lane); else tr_finish_t<false>(t, v, scr, lane); }
template <class T> __device__ __forceinline__ T* uniform_ptr(T* p) {
    const unsigned long long v = (unsigned long long)p; const unsigned lo = __builtin_amdgcn_readfirstlane((unsigned)v), hi = __builtin_amdgcn_readfirstlane((unsigned)(v >> 32));
    return (T*)(((unsigned long long)hi << 32) | lo);
}
struct Args { const float* in[25]; float* out; unsigned char* ws; int step, phase; };

__device__ __forceinline__ void prologue(const Args& args, LAS unsigned char* lds, int lane, int wave, int bx, int G) {
    unsigned char* ws = args.ws;
    LAS float* scr = (LAS float*)(lds + wave * 16640);
    const int gw = bx * 8 + wave, NGW = G * 8;
    constexpr int I_GU = 32 * 88, N_GU = 16 * I_GU, I_D = 88 * 32, N_D = 8 * I_D, I_SQ = 32 * 32, N_SQ = 12 * I_SQ, I_IN = 32 * 64, N_IN = 2 * I_IN, I_OUT = 32 * 32, N_OUT = 2 * I_OUT,
                  I_P = 8 * 8, N_P = 8 * I_P, I_G = 4, N_G = 64 * I_G, NITEMS = N_GU + N_D + N_SQ + N_IN + N_OUT + N_P + N_G;
#define TR_KB(item, NB) (2 * (((item) >> 3) / ((NB) / 4)) + (((item) & 7) >> 2))
#define TR_NB(item, NB) (4 * (((item) >> 3) % ((NB) / 4)) + ((item) & 3))
    auto decode = [&](int it) -> TrItem { TrItem t; t.ks = nullptr; t.ns = nullptr; t.dstz = nullptr; t.f16 = 0; int r = it;
        if (r < N_GU) { const int mat = r / I_GU, item = r % I_GU, lw = mat >> 1, up = mat & 1, k0 = TR_KB(item, 88) * 64, n0 = TR_NB(item, 88) * 64;
            t.src = (up ? args.in[4] : args.in[3]) + (size_t)lw * D * FF + (size_t)k0 * FF + n0; t.ldw = FF;
            t.dst = (bf16_t*)(ws + WS_WGU) + (size_t)lw * (2 * FF) * D + (size_t)(256 * (n0 >> 7) + (n0 & 127) + up * 128) * D + k0; t.ldd = D; t.ks = args.in[2] + lw * D + k0; t.f16 = 1; return t; }
        r -= N_GU;
        if (r < N_D) { const int lw = r / I_D, item = r % I_D, k0 = TR_KB(item, 32) * 64, n0 = TR_NB(item, 32) * 64;
            t.src = args.in[5] + (size_t)lw * FF * D + (size_t)k0 * D + n0; t.ldw = D; t.dst = (bf16_t*)(ws + WS_WD) + (size_t)lw * D * FF + (size_t)n0 * FF + k0; t.ldd = FF; return t; }
        r -= N_D;
        if (r < N_SQ) { const int mat = r / I_SQ, item = r % I_SQ, which = mat >> 2, L = mat & 3, k0 = TR_KB(item, 32) * 64, n0 = TR_NB(item, 32) * 64;
            t.src = (which == 0 ? args.in[21] : which == 1 ? args.in[22] : args.in[23]) + (size_t)L * D * D + (size_t)k0 * D + n0; t.ldw = D;
            t.dst = (bf16_t*)(ws + WS_WK + (size_t)which * 32 * MiB) + (size_t)L * D * D + (size_t)n0 * D + k0; t.ldd = D; return t; }
        r -= N_SQ;
        if (r < N_IN) { const int j = r / I_IN, item = r % I_IN, k0 = TR_KB(item, 64) * 64, n0 = TR_NB(item, 64) * 64;
            t.src = args.in[9] + (size_t)j * D * 4096 + (size_t)k0 * 4096 + n0; t.ldw = 4096; t.dst = (bf16_t*)(ws + WS_WIN) + (size_t)j * 4096 * D + (size_t)n0 * D + k0; t.ldd = D; t.ks = args.in[6] + (2 * j + 1) * D + k0; t.f16 = 1; return t; }
        r -= N_IN;
        if (r < N_OUT) { const int j = r / I_OUT, item = r % I_OUT, k0 = TR_KB(item, 32) * 64, n0 = TR_NB(item, 32) * 64;
            t.src = args.in[17] + (size_t)j * D * D + (size_t)k0 * D + n0; t.ldw = D; t.dst = (bf16_t*)(ws + WS_WOUT) + (size_t)j * D * D + (size_t)n0 * D + k0; t.ldd = D; return t; }
        r -= N_OUT;
        if (r < N_P) { const int mat = r / I_P, item = r % I_P, j = mat >> 2, g = mat & 3, k0 = TR_KB(item, 8) * 64, n0 = TR_NB(item, 8) * 64;
            t.src = args.in[7] + (size_t)mat * 512 * 512 + (size_t)k0 * 512 + n0; t.ldw = 512; t.dst = (bf16_t*)(ws + WS_WP) + (size_t)j * D * 512 + (size_t)(g * 512 + n0) * 512 + k0; t.ldd = 512;
            t.ks = args.in[6] + (2 * j) * D + g * 512 + k0; t.ns = args.in[8] + j * D + g * 512 + n0; return t; }
        r -= N_P;
        { const int mat = r / I_G, item = r % I_G, j = mat >> 5, isx = (mat >> 4) & 1, hh = mat & 15, k0 = (item >> 1) * 64, n0 = (item & 1) * 64;
            bf16_t* rowp = (bf16_t*)(ws + WS_WGATE) + (size_t)j * 4096 * 256 + (size_t)(hh * 256 + isx * 128 + n0) * 256;
            t.src = (isx ? args.in[14] : args.in[12]) + (size_t)(j * 16 + hh) * 128 * 128 + (size_t)k0 * 128 + n0; t.ldw = 128; t.dst = rowp + (hh & 1) * 128 + k0; t.ldd = 256; t.dstz = rowp + ((hh & 1) ^ 1) * 128 + k0; return t; } };
    if (gw < NITEMS) { int it = gw; TrItem a = decode(it), b = a; f32x4 va[16], vb[16]; tr_load(a, va, lane);
        for (;;) { const int itb = it + NGW; const bool hasb = itb < NITEMS;
            if (hasb) { b = decode(itb); tr_load(b, vb, lane); }
            asm volatile("" ::: "memory");
            tr_finish(a, va, scr, lane);
            if (!hasb) break;
            const int ita = itb + NGW; const bool hasa = ita < NITEMS;
            if (hasa) { a = decode(ita); tr_load(a, va, lane); }
            asm volatile("" ::: "memory");
            tr_finish(b, vb, scr, lane);
            if (!hasa) break;
            it = ita; } }
    { bf16_t* wqn = (bf16_t*)(ws + WS_WQN);
      for (int row = gw; row < 4 * D; row += NGW) { const float sck = args.in[18][row] * 0.04419417382415922f; const f32x4* xr = (const f32x4*)(args.in[20] + (size_t)row * D) + lane; u32x2* br = (u32x2*)(wqn + (size_t)row * D) + lane;
#pragma unroll
          for (int j = 0; j < 8; ++j) { const f32x4 v = xr[64 * j] * sck; u32x2 w; w.x = cvt_pk_bf16(v[0], v[1]); w.y = cvt_pk_bf16(v[2], v[3]); br[64 * j] = w; } } }
    { const float* x = args.in[0]; bf16_t* hb = (bf16_t*)(ws + WS_HB); float* part = (float*)(ws + WS_PART);
      for (int row = gw; row < M; row += NGW) { const f32x4* xr = (const f32x4*)(x + (size_t)row * D) + lane; f32x4 v[8]; float ss = 0.f;
#pragma unroll
          for (int j = 0; j < 8; ++j) { v[j] = xr[64 * j]; ss += (v[j][0] * v[j][0] + v[j][1] * v[j][1]) + (v[j][2] * v[j][2] + v[j][3] * v[j][3]); }
          ss = wave_sum(ss);
          u32x2* br = (u32x2*)(hb + (size_t)row * D) + lane;
#pragma unroll
          for (int j = 0; j < 8; ++j) { u32x2 w; w.x = cvt_pk_h(v[j][0], v[j][1]); w.y = cvt_pk_h(v[j][2], v[j][3]); br[64 * j] = w; }
          if (lane < 32) part[(size_t)row * 32 + lane] = lane == 0 ? ss : 0.f; } }
    { const float* mem = args.in[1]; const float* g = args.in[19]; bf16_t* mb = (bf16_t*)(ws + WS_MB);
      for (int row = gw; row < MM; row += NGW) { const f32x4* xr = (const f32x4*)(mem + (size_t)row * D) + lane; f32x4 v[8]; float ss = 0.f;
#pragma unroll
          for (int j = 0; j < 8; ++j) { v[j] = xr[64 * j]; ss += (v[j][0] * v[j][0] + v[j][1] * v[j][1]) + (v[j][2] * v[j][2] + v[j][3] * v[j][3]); }
          const float rs = rsqrtf(wave_sum(ss) * (1.0f / 2048.0f) + EPS); u32x2* br = (u32x2*)(mb + (size_t)row * D) + lane;
#pragma unroll
          for (int j = 0; j < 8; ++j) { const f32x4 gv = *((const f32x4*)g + lane + 64 * j); const f32x4 o = v[j] * rs * gv; u32x2 w; w.x = cvt_pk_bf16(o[0], o[1]); w.y = cvt_pk_bf16(o[2], o[3]); br[64 * j] = w; } } }
    { const float* lam = args.in[16]; float* sp = (float*)(ws + WS_SP);
      for (int i = gw * 64 + lane; i < 2 * D; i += NGW * 64) { const float z = -lam[i]; sp[i] = 8.0f * (fmaxf(z, 0.f) + log1pf(expf(-fabsf(z)))); } }
}

constexpr int PD = 256 * D * 2;
typedef pg8::Sched<M,      2 * FF,  D,   D,    D,      PD,            0,       0,   PD,             0,                0, false, true> ShGU;
typedef pg8::Sched<M,      D,       FF,  FF,   FF,     256 * FF * 2,  0,       0,   256 * FF * 2,   0,                0, DOWN_KREV, false, DOWN_WGM> ShDown;
typedef pg8::Sched<M,      D,       512, D,    512,    PD,            512 * 2, 1,   256 * 512 * 2,  0,                0> ShPool;
typedef pg8::Sched<M,      2 * D,   D,   D,    D,      PD,            0,       0,   PD,             0,                0, false, true> ShLruIn;
typedef pg8::Sched<M,      2 * D,   256, D,    256,    PD,            256 * 2, 1,   256 * 256 * 2,  0,                0> ShGates;
typedef pg8::Sched<M,      D,       D,   D,    D,      PD,            0,       0,   PD,             0,                0> ShDD;
typedef pg8::Sched<M,      NH*MEML, D,   D,    D,      PD,            0,       0,   256 * D * 2,    1024 * D * 2,     4, false, true> ShScore;
typedef pg8::Sched<M,      D,       1024, 1024, 4096,  256 * 1024 * 2, 0,      0,   256 * 4096 * 2, 1024 * 2,         4> ShAO;
typedef pg8::Sched<MM,     8 * D,   D,   D,    D,      PD,            0,       0,   PD,             0,                0> ShKV;

#define LD_BF4P(p) f16x4_to_f32(*(const u32x2*)(p))
__device__ __forceinline__ unsigned long long launder_u64(unsigned long long v) {
    unsigned lo = (unsigned)v, hi = (unsigned)(v >> 32); asm volatile("" : "+v"(lo), "+v"(hi));
    return ((unsigned long long)(unsigned)__builtin_amdgcn_readfirstlane(hi) << 32) | (unsigned)__builtin_amdgcn_readfirstlane(lo);
}
#define PHASE_VARS() int tid = threadIdx.x; asm volatile("" : "+v"(tid)); unsigned char* ws = (unsigned char*)(GAS unsigned char*)launder_u64((unsigned long long)args.ws); float* h = (float*)(GAS float*)launder_u64((unsigned long long)args.out); \
    bf16_t* hb = (bf16_t*)(ws + WS_HB); float* part = (float*)(ws + WS_PART); (void)tid; (void)h; (void)hb; (void)part
__global__ void __launch_bounds__(512, 2) mk_fwd(Args args) {
    extern __shared__ __attribute__((aligned(16))) unsigned char lds_raw[];
    LAS unsigned char* lds = (LAS unsigned char*)lds_raw;
    const int G = gridDim.x, bx = blockIdx.x;
    unsigned long long prof_acc = 0;
#if MK_SINGLE
    volatile LAS unsigned* MISC = (volatile LAS unsigned*)(lds + MISC_OFF);
    if (threadIdx.x < 32) MISC[threadIdx.x] = 0u;
    __syncthreads();
    XcdBarrier bar = xcd_barrier_post((unsigned*)(args.ws + WS_CTL) + CW_BAR, MISC + 8);
#define GRID_BAR() xcd_barrier(bar)
#define PH(k) true
    const int s_lo = 0, s_hi = 8; const bool do_pro = true, do_fin = true;
#else
#define GRID_BAR() do {} while (0)
#define PH(k) (args.phase == (k))
    const int s_lo = args.step, s_hi = (args.step >= 0 && args.step < 8) ? args.step + 1 : args.step; const bool do_pro = args.step == -1, do_fin = args.step == 8;
#endif

    if (do_pro) {
        if (PH(0)) { for (int rep = 0; rep < REP_PRO; ++rep) { PHASE_VARS(); unsigned long long pt_ = 0; if constexpr (PROF_TAG == 110) pt_ = PROF_NOW(); prologue(args, lds, tid & 63, __builtin_amdgcn_readfirstlane(tid >> 6), bx, G); GRID_BAR(); if constexpr (PROF_TAG == 110) prof_acc += PROF_NOW() - pt_; } }
        if (PH(1)) {
            PHASE_VARS(); ShKV S{(const char*)(ws + WS_MB), (const char*)(ws + WS_WK), G, bx}; pg8::EpiPlain<false> E{(bf16_t*)(ws + WS_KV), 8 * D}; pg8::gemm_phase<pg8::EpiPlain<false>, true, 9>(lds, S, E, prof_acc); GRID_BAR(); }
        if (PH(2)) {
            { PHASE_VARS(); pg8::SchedG S{(const char*)(ws + WS_KV), (const char*)(ws + WS_WQN), G, bx}; pg8::EpiPlain<true> E{(bf16_t*)(ws + WS_GALL), D}; pg8::gemm_phase<pg8::EpiPlain<true>, true, 10>(lds, S, E, prof_acc); }
            { PHASE_VARS(); pg8::SchedH S{(const char*)(ws + WS_WO), (const char*)(ws + WS_KV), G, bx}; pg8::EpiPlain<false> E{(bf16_t*)(ws + WS_HALL), 4096}; pg8::gemm_phase<pg8::EpiPlain<false>, true, 10>(lds, S, E, prof_acc); }
        }
    }
#pragma unroll 1
    for (int s = s_lo; s < s_hi; ++s) {
        const int L = s >> 1, lw = s;
        if (PH(0)) for (int rep = 0; rep < REP_GU; ++rep) { PHASE_VARS(); ShGU S{(const char*)hb, (const char*)(ws + WS_WGU) + (size_t)lw * (2 * FF) * D * 2, G, bx};
            pg8::EpiSwiGLU E{(bf16_t*)(ws + WS_ACT), part, (LAS float*)(lds + EPI_TBL_OFF)};
            pg8::gemm_phase<pg8::EpiSwiGLU, true, 1>(lds, S, E, prof_acc); GRID_BAR(); }
        if (PH(1)) for (int rep = 0; rep < REP_DOWN; ++rep) { PHASE_VARS(); ShDown S{(const char*)(ws + WS_ACT), (const char*)(ws + WS_WD) + (size_t)lw * D * FF * 2, G, bx};
            pg8::EpiResid E{hb, part, 0.5f};
            pg8::gemm_phase<pg8::EpiResid, true, 2>(lds, S, E, prof_acc); GRID_BAR(); }
        if ((s & 1) == 0) {
            const int j = L >> 1;
            if ((L & 1) == 0) {
                if (PH(2)) for (int rep = 0; rep < REP_THIN; ++rep) { PHASE_VARS(); unsigned long long pt_ = 0; if constexpr (PROF_TAG == 120) pt_ = PROF_NOW(); bf16_t* pooled = (bf16_t*)(ws + WS_POOLED); LAS float* R = (LAS float*)lds;
                    for (int blk = bx; blk < M / 64; blk += G) { const int t0 = blk * 64, seq0 = (t0 / SEQ) * SEQ;
                        if (tid < 79) { const int row = t0 - 15 + tid; float rs = 0.f;
                            if (row >= seq0) { const f32x4* p = (const f32x4*)(part + (size_t)row * 32); float sacc = 0.f;
#pragma unroll
                                for (int q = 0; q < 8; ++q) { const f32x4 a = p[q]; sacc += (a[0] + a[1]) + (a[2] + a[3]); }
                                rs = rsqrtf(sacc * (1.0f / 2048.0f) + EPS); }
                            R[tid] = rs; }
                        __syncthreads();
                        const int w = 2 << (tid >> 7); const bf16_t* hc = hb + 4 * tid; f32x4 S4 = (f32x4){0.f, 0.f, 0.f, 0.f};
                        { u32x2 hk[15];
#pragma unroll
                          for (int i = 0; i < 15; ++i) { const int r = t0 - 15 + i; hk[i] = (i >= 16 - w && r >= seq0) ? *(const u32x2*)(hc + (size_t)r * D) : (u32x2){0u, 0u}; }
#pragma unroll
                          for (int i = 0; i < 15; ++i) S4 = S4 + f16x4_to_f32(hk[i]) * R[i]; }
                        u32x2 nb[2][8], ob[2][8];
#define POOL_LOAD(b) do { _Pragma("unroll") for (int i = 0; i < 8; ++i) { const int t_ = t0 + 8 * (b) + i, to_ = t_ - w; nb[(b) & 1][i] = *(const u32x2*)(hc + (size_t)t_ * D); \
                              ob[(b) & 1][i] = to_ >= seq0 ? *(const u32x2*)(hc + (size_t)to_ * D) : (u32x2){0u, 0u}; } } while (0)
                        POOL_LOAD(0);
#pragma unroll
                        for (int b = 0; b < 8; ++b) { if (b + 1 < 8) POOL_LOAD(b + 1);
                            asm volatile("" ::: "memory");
#pragma unroll
                            for (int i = 0; i < 8; ++i) { const int idx = 8 * b + i, t = t0 + idx, tt = t - seq0; const f32x4 uv = f16x4_to_f32(nb[b & 1][i]) * R[idx + 15]; S4 = S4 + uv;
                                if (idx > 0 && tt >= w) S4 = S4 - f16x4_to_f32(ob[b & 1][i]) * R[idx - w + 15];
                                const float ic = 1.0f / (float)(tt + 1 < w ? tt + 1 : w); const f32x4 o = S4 * ic - uv;
                                u32x2 pk; pk.x = cvt_pk_bf16(o[0], o[1]); pk.y = cvt_pk_bf16(o[2], o[3]); *(u32x2*)(pooled + (size_t)t * D + 4 * tid) = pk; }
                            asm volatile("" ::: "memory"); }
#undef POOL_LOAD
                        __syncthreads(); }
                    GRID_BAR(); if constexpr (PROF_TAG == 120) prof_acc += PROF_NOW() - pt_; }
                if (PH(3)) { PHASE_VARS(); ShPool S{(const char*)(ws + WS_POOLED), (const char*)(ws + WS_WP) + (size_t)j * D * 512 * 2, G, bx};
                    pg8::EpiResid E{hb, part, 1.0f};
                    pg8::gemm_phase<pg8::EpiResid, true, 3>(lds, S, E, prof_acc); GRID_BAR(); }
            } else {
                if (PH(2)) { PHASE_VARS(); ShLruIn S{(const char*)hb, (const char*)(ws + WS_WIN) + (size_t)j * 4096 * D * 2, G, bx};
                    pg8::EpiLruIn E{(bf16_t*)(ws + WS_GG), (bf16_t*)(ws + WS_XR), part, (LAS float*)(lds + EPI_TBL_OFF)};
                    pg8::gemm_phase<pg8::EpiLruIn, true, 4>(lds, S, E, prof_acc); GRID_BAR(); }
                if (PH(3)) for (int rep = 0; rep < REP_THIN; ++rep) { PHASE_VARS(); unsigned long long pt_ = 0; if constexpr (PROF_TAG == 130) pt_ = PROF_NOW(); const bf16_t* xr = (const bf16_t*)(ws + WS_XR); bf16_t* xcb = (bf16_t*)(ws + WS_XCB);
                    const float* cw = args.in[10] + (size_t)j * 4 * D + 4 * tid; const f32x4 w0 = *(const f32x4*)cw, w1 = *(const f32x4*)(cw + D), w2 = *(const f32x4*)(cw + 2 * D), w3 = *(const f32x4*)(cw + 3 * D);
                    const f32x4 cb = *(const f32x4*)(args.in[11] + (size_t)j * D + 4 * tid);
                    for (int blk = bx; blk < M / 64; blk += G) { const int t0 = blk * 64, seq0 = (t0 / SEQ) * SEQ; const bf16_t* xp = xr + 4 * tid; const f32x4 z = (f32x4){0.f, 0.f, 0.f, 0.f};
                        f32x4 x0 = z, x1 = z, x2 = z; if (t0 > seq0) { x0 = bf16x4_to_f32(*(const u32x2*)(xp + (size_t)(t0 - 3) * D)); x1 = bf16x4_to_f32(*(const u32x2*)(xp + (size_t)(t0 - 2) * D)); x2 = bf16x4_to_f32(*(const u32x2*)(xp + (size_t)(t0 - 1) * D)); }
                        u32x2 xb[2][16];
#define CONV_LOAD(b) do { _Pragma("unroll") for (int i = 0; i < 16; ++i) xb[(b) & 1][i] = *(const u32x2*)(xp + (size_t)(t0 + 16 * (b) + i) * D); } while (0)
                        CONV_LOAD(0);
#pragma unroll
                        for (int b = 0; b < 4; ++b) { if (b + 1 < 4) CONV_LOAD(b + 1);
                            asm volatile("" ::: "memory");
#pragma unroll
                            for (int i = 0; i < 16; ++i) { const int t = t0 + 16 * b + i; const f32x4 x3 = bf16x4_to_f32(xb[b & 1][i]); const f32x4 o = cb + x0 * w0 + x1 * w1 + x2 * w2 + x3 * w3;
                                u32x2 pk; pk.x = cvt_pk_bf16(o[0], o[1]); pk.y = cvt_pk_bf16(o[2], o[3]); *(u32x2*)(xcb + (size_t)t * D + 4 * tid) = pk;
                                x0 = x1; x1 = x2; x2 = x3; }
                            asm volatile("" ::: "memory"); }
#undef CONV_LOAD
                    }
                    GRID_BAR(); if constexpr (PROF_TAG == 130) prof_acc += PROF_NOW() - pt_; }
                if (PH(4)) { PHASE_VARS(); ShGates S{(const char*)(ws + WS_XCB), (const char*)(ws + WS_WGATE) + (size_t)j * 4096 * 256 * 2, G, bx};
                    pg8::EpiGates E{(bf16_t*)(ws + WS_LA), (bf16_t*)(ws + WS_BT), (const bf16_t*)(ws + WS_XCB), args.in[13] + (size_t)j * D, args.in[15] + (size_t)j * D, (const float*)(ws + WS_SP) + (size_t)j * D};
                    pg8::gemm_phase<pg8::EpiGates, true, 5>(lds, S, E, prof_acc); GRID_BAR(); }
#define EXP2_4(v) ((f32x4){__builtin_amdgcn_exp2f((v)[0]), __builtin_amdgcn_exp2f((v)[1]), __builtin_amdgcn_exp2f((v)[2]), __builtin_amdgcn_exp2f((v)[3])})
                if (PH(5)) for (int rep = 0; rep < REP_THIN; ++rep) { PHASE_VARS(); unsigned long long pt_ = 0; if constexpr (PROF_TAG == 140) pt_ = PROF_NOW(); const bf16_t* lav = (const bf16_t*)(ws + WS_LA) + 4 * tid; const bf16_t* bv = (const bf16_t*)(ws + WS_BT) + 4 * tid; float* chA = (float*)(ws + WS_CHA); float* chB = (float*)(ws + WS_CHB);
                    for (int blk = bx; blk < M / 64; blk += G) { const int t0 = blk * 64; f32x4 Ls = (f32x4){0.f, 0.f, 0.f, 0.f}, Hs = (f32x4){0.f, 0.f, 0.f, 0.f};
                        u32x2 lb[2][8], bb[2][8];
#define SC1_LOAD(b) do { _Pragma("unroll") for (int i = 0; i < 8; ++i) { const size_t o_ = (size_t)(t0 + 8 * (b) + i) * D; lb[(b) & 1][i] = *(const u32x2*)(lav + o_); bb[(b) & 1][i] = *(const u32x2*)(bv + o_); } } while (0)
                        SC1_LOAD(0);
#pragma unroll
                        for (int b = 0; b < 8; ++b) { if (b + 1 < 8) SC1_LOAD(b + 1);
                            asm volatile("" ::: "memory");
#pragma unroll
                            for (int i = 0; i < 8; ++i) { const f32x4 l4 = bf16x4_to_f32(lb[b & 1][i]), b4 = bf16x4_to_f32(bb[b & 1][i]); const f32x4 a4 = EXP2_4(l4); Hs = a4 * Hs + b4; Ls = Ls + l4; } }
#undef SC1_LOAD
                        *(f32x4*)(chA + (size_t)blk * D + 4 * tid) = EXP2_4(Ls); *(f32x4*)(chB + (size_t)blk * D + 4 * tid) = Hs; }
                    GRID_BAR(); if constexpr (PROF_TAG == 140) prof_acc += PROF_NOW() - pt_; }
                if (PH(6)) for (int rep = 0; rep < REP_THIN; ++rep) { PHASE_VARS(); unsigned long long pt_ = 0; if constexpr (PROF_TAG == 150) pt_ = PROF_NOW(); const bf16_t* lav = (const bf16_t*)(ws + WS_LA) + 4 * tid; const bf16_t* bv = (const bf16_t*)(ws + WS_BT) + 4 * tid;
                    const float* chA = (const float*)(ws + WS_CHA) + 4 * tid; const float* chB = (const float*)(ws + WS_CHB) + 4 * tid; const bf16_t* gg = (const bf16_t*)(ws + WS_GG) + 4 * tid; bf16_t* yb = (bf16_t*)(ws + WS_XCB) + 4 * tid;
                    for (int blk = bx; blk < M / 64; blk += G) { const int t0 = blk * 64, c0 = (blk / 64) * 64; f32x4 Hs = (f32x4){0.f, 0.f, 0.f, 0.f};
                        u32x2 lb[2][8], bb[2][8], gb[2][8];
#define SC2_LOAD(b) do { _Pragma("unroll") for (int i = 0; i < 8; ++i) { const size_t o_ = (size_t)(t0 + 8 * (b) + i) * D; lb[(b) & 1][i] = *(const u32x2*)(lav + o_); bb[(b) & 1][i] = *(const u32x2*)(bv + o_); gb[(b) & 1][i] = *(const u32x2*)(gg + o_); } } while (0)
                        SC2_LOAD(0);
                        int c = c0;
                        for (; c + 8 <= blk; c += 8) { f32x4 ca[8], cb8[8];
#pragma unroll
                            for (int i = 0; i < 8; ++i) { ca[i] = *(const f32x4*)(chA + (size_t)(c + i) * D); cb8[i] = *(const f32x4*)(chB + (size_t)(c + i) * D); }
#pragma unroll
                            for (int i = 0; i < 8; ++i) Hs = ca[i] * Hs + cb8[i]; }
                        for (; c < blk; ++c) { const f32x4 a4 = *(const f32x4*)(chA + (size_t)c * D), b4 = *(const f32x4*)(chB + (size_t)c * D); Hs = a4 * Hs + b4; }
#pragma unroll
                        for (int b = 0; b < 8; ++b) { if (b + 1 < 8) SC2_LOAD(b + 1);
                            asm volatile("" ::: "memory");
#pragma unroll
                            for (int i = 0; i < 8; ++i) { const int t = t0 + 8 * b + i; const f32x4 l4 = bf16x4_to_f32(lb[b & 1][i]), b4 = bf16x4_to_f32(bb[b & 1][i]), g4 = bf16x4_to_f32(gb[b & 1][i]); const f32x4 a4 = EXP2_4(l4); Hs = a4 * Hs + b4;
                                u32x2 pk; pk.x = cvt_pk_bf16(Hs[0] * g4[0], Hs[1] * g4[1]); pk.y = cvt_pk_bf16(Hs[2] * g4[2], Hs[3] * g4[3]); *(u32x2*)(yb + (size_t)t * D) = pk; }
                            asm volatile("" ::: "memory"); }
#undef SC2_LOAD
                    }
                    GRID_BAR(); if constexpr (PROF_TAG == 150) prof_acc += PROF_NOW() - pt_; }
#undef EXP2_4
                if (PH(7)) { PHASE_VARS(); ShDD S{(const char*)(ws + WS_XCB), (const char*)(ws + WS_WOUT) + (size_t)j * D * D * 2, G, bx};
                    pg8::EpiResid E{hb, part, 1.0f};
                    pg8::gemm_phase<pg8::EpiResid, true, 6>(lds, S, E, prof_acc); GRID_BAR(); }
            }
            if (PH(8)) { PHASE_VARS(); ShScore S{(const char*)hb, (const char*)(ws + WS_GALL) + (size_t)L * 4096 * D * 2, G, bx};
                pg8::EpiSoftmax E{(bf16_t*)(ws + WS_P), part};
                pg8::gemm_phase<pg8::EpiSoftmax, false, 7>(lds, S, E, prof_acc); GRID_BAR(); }
            if (PH(9)) for (int rep = 0; rep < REP_RES2K; ++rep) { PHASE_VARS(); ShAO S{(const char*)(ws + WS_P), (const char*)(ws + WS_HALL) + (size_t)L * D * 4096 * 2, G, bx};
                pg8::EpiResid E{hb, part, 1.0f};
                pg8::gemm_phase<pg8::EpiResid, true, 8>(lds, S, E, prof_acc); GRID_BAR(); }
        }
    }
    if (do_fin) { unsigned long long pt_ = 0; if constexpr (PROF_TAG == 160) pt_ = PROF_NOW(); PHASE_VARS(); const float* g = args.in[24]; const int lane = tid & 63, gw = bx * 8 + (tid >> 6), NGW = G * 8;
        for (int row = gw; row < M; row += NGW) { const u32x2* br = (const u32x2*)(hb + (size_t)row * D) + lane; f32x4* orow = (f32x4*)(h + (size_t)row * D) + lane; f32x4 v[8]; float ss = 0.f;
#pragma unroll
            for (int jj = 0; jj < 8; ++jj) { v[jj] = f16x4_to_f32(br[64 * jj]);
                ss += (v[jj][0] * v[jj][0] + v[jj][1] * v[jj][1]) + (v[jj][2] * v[jj][2] + v[jj][3] * v[jj][3]); }
            const float rs = rsqrtf(wave_sum(ss) * (1.0f / 2048.0f) + EPS);
#pragma unroll
            for (int jj = 0; jj < 8; ++jj) { const f32x4 gv = *((const f32x4*)g + lane + 64 * jj); orow[64 * jj] = v[jj] * rs * gv; } }
        if constexpr (PROF_TAG == 160) { VM_WAIT(); prof_acc += PROF_NOW() - pt_; } }
    if constexpr (PROF_TAG != 0) { const unsigned long long t0 = PROF_NOW(); while (PROF_NOW() - t0 < prof_acc) __builtin_amdgcn_s_sleep(4); }
}

extern "C" void kernel_launch(void* const* d_in, const int* in_sizes, int n_in, void* d_out, int out_size, void* d_ws, size_t ws_size, hipStream_t stream) {
    static int grid = 0;
    if (grid == 0) {
        if (n_in != 25 || in_sizes[0] != M * D || out_size != M * D || ws_size < WS_END) { fprintf(stderr, "kernel_launch: unexpected shapes (n_in %d, in0 %d, out %d, ws %zu, need %zu); nothing launched\n", n_in, n_in > 0 ? in_sizes[0] : -1, out_size, ws_size, (size_t)WS_END); grid = -1; return; }
        int dev = 0, cus = 0, per_cu = 0;
        if (hipGetDevice(&dev) != hipSuccess || hipDeviceGetAttribute(&cus, hipDeviceAttributeMultiprocessorCount, dev) != hipSuccess) { fprintf(stderr, "kernel_launch: device query failed\n"); grid = -1; return; }
        if (hipFuncSetAttribute((const void*)mk_fwd, hipFuncAttributeMaxDynamicSharedMemorySize, LDS_BYTES) != hipSuccess) { fprintf(stderr, "kernel_launch: hipFuncSetAttribute failed\n"); grid = -1; return; }
        if (hipOccupancyMaxActiveBlocksPerMultiprocessor(&per_cu, (const void*)mk_fwd, 512, LDS_BYTES) != hipSuccess || per_cu < 1) fprintf(stderr, "kernel_launch: occupancy query says %d\n", per_cu);
        (void)hipGetLastError();
        grid = cus;
        if (grid != 256) { fprintf(stderr, "kernel_launch: built for 256 CUs, found %d; nothing launched\n", cus); grid = -1; return; }
    }
    if (grid < 0) return;
    Args a{};
    for (int i = 0; i < 25; ++i) a.in[i] = (const float*)d_in[i];
    a.out = (float*)d_out; a.ws = (unsigned char*)d_ws;
#if MK_SINGLE
    if (hipMemsetAsync((char*)d_ws + WS_CTL, 0, CTL_ZERO_BYTES, stream) != hipSuccess) { fprintf(stderr, "kernel_launch: memset failed\n"); return; }
    a.step = 0; a.phase = 0;
    hipLaunchKernelGGL(mk_fwd, dim3(grid), dim3(512), LDS_BYTES, stream, a);
#else
    auto launch = [&](int s, int p) { a.step = s; a.phase = p; hipLaunchKernelGGL(mk_fwd, dim3(grid), dim3(512), LDS_BYTES, stream, a); };
    launch(-1, 0); launch(-1, 1); launch(-1, 2);
    for (int s = 0; s < 8; ++s) { launch(s, 0); launch(s, 1);
        if ((s & 1) == 0) { const int L = s >> 1;
            if ((L & 1) == 0) { launch(s, 2); launch(s, 3); } else { for (int p = 2; p <= 7; ++p) launch(s, p); }
            for (int p = 8; p <= 9; ++p) launch(s, p); } }
    launch(8, 0);
#endif
    const hipError_t le = hipPeekAtLastError();
    if (le != hipSuccess) fprintf(stderr, "kernel_launch: launch failed: %s\n", hipGetErrorName(le));
}
```

```cpp
#include <hip/hip_runtime.h>
#include <cstdio>
#include <cstdint>

#ifndef MK_SINGLE
#define MK_SINGLE 1
#endif

#ifndef PROF_TAG
#define PROF_TAG 0
#endif
#define PROF_NOW() __builtin_amdgcn_s_memrealtime()
#ifndef DOWN_WGM
#define DOWN_WGM 4
#endif
#ifndef DOWN_KREV
#define DOWN_KREV true
#endif
#ifndef REP_PRO
#define REP_PRO 1
#endif
#ifndef REP_GU
#define REP_GU 1
#endif
#ifndef REP_DOWN
#define REP_DOWN 1
#endif
#ifndef REP_THIN
#define REP_THIN 1
#endif
#ifndef STAGGER_TICKS
#define STAGGER_TICKS 0
#endif
#ifndef STAGGER_GROUPS
#define STAGGER_GROUPS 2
#endif
#ifndef STAGGER_GU_TICKS
#define STAGGER_GU_TICKS 0
#endif
#ifndef STAGGER_GU_GROUPS
#define STAGGER_GU_GROUPS 4
#endif
#ifndef REP_RES2K
#define REP_RES2K 1
#endif
#define LAS __attribute__((address_space(3)))
#define GAS __attribute__((address_space(1)))
typedef unsigned short bf16_t;
typedef short bf16x8 __attribute__((ext_vector_type(8)));
typedef float f32x4 __attribute__((ext_vector_type(4)));
typedef float f32x2 __attribute__((ext_vector_type(2)));
typedef unsigned u32x4 __attribute__((ext_vector_type(4)));
typedef unsigned u32x2 __attribute__((ext_vector_type(2)));
typedef GAS unsigned gu32;
#define LDS_WAIT() asm volatile("s_waitcnt lgkmcnt(0)" ::: "memory")
#define VM_WAIT() asm volatile("s_waitcnt vmcnt(0)" ::: "memory")

__device__ __forceinline__ unsigned cvt_pk_bf16(float lo, float hi) { unsigned r; asm volatile("v_cvt_pk_bf16_f32 %0, %1, %2" : "=v"(r) : "v"(lo), "v"(hi)); return r; }
typedef _Float16 f16x2 __attribute__((ext_vector_type(2)));
typedef _Float16 f16x8 __attribute__((ext_vector_type(8)));
__device__ __forceinline__ unsigned cvt_pk_f16(float lo, float hi) { const f16x2 v = {(_Float16)lo, (_Float16)hi}; return __builtin_bit_cast(unsigned, v); }
#ifndef H_TRIM
#define H_TRIM 2
#define FIRST_ITER_RELAX 1
#endif
__device__ __forceinline__ unsigned cvt_pk_h(float lo, float hi) { const unsigned w = cvt_pk_f16(lo, hi);
    if constexpr (H_TRIM > 0) { constexpr unsigned almost_half = ((1u << (H_TRIM - 1)) - 1u) * 0x00010001u, mask = ~(((1u << H_TRIM) - 1u) * 0x00010001u);
        return (w + almost_half + ((w >> H_TRIM) & 0x00010001u)) & mask; } else return w; }
template <bool F16> __device__ __forceinline__ unsigned cvt_pk16(float lo, float hi) { const unsigned b = cvt_pk_bf16(lo, hi); if constexpr (F16) return cvt_pk_f16(__uint_as_float(b << 16), __uint_as_float(b & 0xffff0000u)); else return b; }
__device__ __forceinline__ f32x4 f16x4_to_f32(u32x2 k) { const unsigned ka = k.x, kb = k.y; const f16x2 a = __builtin_bit_cast(f16x2, ka); const f16x2 b = __builtin_bit_cast(f16x2, kb);
    return (f32x4){(float)a.x, (float)a.y, (float)b.x, (float)b.y}; }
__device__ __forceinline__ f32x4 bf16x4_to_f32(u32x2 k) { return (f32x4){__uint_as_float(k.x << 16), __uint_as_float(k.x & 0xffff0000u), __uint_as_float(k.y << 16), __uint_as_float(k.y & 0xffff0000u)}; }
__device__ __forceinline__ float wave_sum(float v) {
#pragma unroll
    for (int o = 1; o < 64; o <<= 1) v += __shfl_xor(v, o);
    return v;
}
__device__ __forceinline__ float fast_sigmoid(float x) { return __builtin_amdgcn_rcpf(1.0f + __builtin_amdgcn_exp2f(-1.44269504089f * x)); }

constexpr int BATCH = 4, SEQ = 4096, D = 2048, DEPTH = 4, FF = 5632, MEML = 256, NH = 4, HD = 512, LH = 16;
constexpr int M = BATCH * SEQ;
constexpr int MM = BATCH * MEML;
constexpr float EPS = 1e-6f;

namespace pg8 {
constexpr int BM = 256, BK = 64, HALF = 128, HTB = HALF * BK * 2, STAGE_BYTES = 8 * HTB, NXCD = 8;
__host__ __device__ __forceinline__ int lds_byte(int r, int c) { const int st = (r >> 4) * 2 + (c >> 5), rr = r & 15, cc = c & 31, ob = rr * 64 + cc * 2; return st * 1024 + (ob ^ (((ob >> 9) & 1) << 5)); }
__host__ __device__ __forceinline__ void stage_rc(int b, int& R, int& C) { const int st = b / 1024, sb = b % 1024, swz = sb ^ (((sb >> 9) & 1) << 5); R = (st >> 1) * 16 + swz / 64; C = (st & 1) * 32 + (swz % 64) / 2; }
__host__ __device__ __forceinline__ int perm32(int rho) { const int n = rho >> 4, i = rho & 15; return 8 * (i >> 2) + 4 * n + (i & 3); }

struct Unit { int pm, pn; const char* a; const char* b; };

template <int nM, int nN, int WGM = 8> __device__ __forceinline__ bool unit_order(int i, int G, int c, int& pm, int& pn) {
    constexpr int nwg = nM * nN;
    const int L = i * G + c; if (L >= nwg) return false;
    int wgid = L; { constexpr int q = nwg / NXCD, r = nwg % NXCD; const int xcd = wgid % NXCD, off = wgid / NXCD; wgid = (xcd < r ? xcd * (q + 1) : r * (q + 1) + (xcd - r) * q) + off; }
    constexpr int nig = WGM * nN; const int gid = wgid / nig, fm = gid * WGM, gsz = (nM - fm) < WGM ? (nM - fm) : WGM;
    pm = fm + ((wgid % nig) % gsz); pn = (wgid % nig) / gsz; return true;
}
template <int MR, int NC, int K_, int LDA, int LDB, int APM, int APN, int ASH, int BPN, int BPM, int BSH, bool KREV_ = false, bool F16_ = false, int WGM_ = 8>
struct Sched {
    static constexpr int K = K_, lda = LDA, ldb = LDB; static constexpr bool KREV = KREV_, F16 = F16_;
    const char* A; const char* B; int G, c;
    __device__ __forceinline__ bool next(int i, Unit& u) const {
        if (!unit_order<MR / BM, NC / BM, WGM_>(i, G, c, u.pm, u.pn)) return false;
        u.a = A + (size_t)u.pm * APM + (size_t)(u.pn >> ASH) * APN + (KREV ? (K - BK) * 2 : 0); u.b = B + (size_t)u.pn * BPN + (size_t)(u.pm >> BSH) * BPM + (KREV ? (K - BK) * 2 : 0); return true;
    }
};
struct SchedG {
    static constexpr int K = 512, lda = 16384, ldb = 2048; static constexpr bool KREV = false, F16 = false;
    const char* KV; const char* WQN; int G, c;
    __device__ __forceinline__ bool next(int i, Unit& u) const {
        if (!unit_order<64, 8>(i, G, c, u.pm, u.pn)) return false;
        const int L = u.pm >> 4, b = (u.pm >> 2) & 3, h = u.pm & 3;
        u.a = KV + ((size_t)(b * 256) * 16384 + L * 2048 + h * 512) * 2; u.b = WQN + ((size_t)L * 2048 * 2048 + (size_t)u.pn * 256 * 2048 + h * 512) * 2; return true;
    }
};
struct SchedH {
    static constexpr int K = 512, lda = 2048, ldb = 16384; static constexpr bool KREV = false, F16 = false;
    const char* WOT; const char* KV; int G, c;
    __device__ __forceinline__ bool next(int i, Unit& u) const {
        if (!unit_order<32, 16>(i, G, c, u.pm, u.pn)) return false;
        const int L = u.pm >> 3, b = u.pn >> 2, h = u.pn & 3;
        u.a = WOT + ((size_t)u.pm * 256 * 2048 + h * 512) * 2; u.b = KV + ((size_t)(b * 256) * 16384 + 8192 + L * 2048 + h * 512) * 2; return true;
    }
};

__device__ __forceinline__ float row_rstd(const float* part, int row, int fq) {
    const f32x4* p = (const f32x4*)(part + (size_t)row * 32 + fq * 8);
    const f32x4 a = p[0], b = p[1];
    float s = ((a.x + a.y) + (a.z + a.w)) + ((b.x + b.y) + (b.z + b.w));
    s += __shfl_xor(s, 16); s += __shfl_xor(s, 32);
    return rsqrtf(s * (1.0f / 2048.0f) + EPS);
}

__device__ __forceinline__ void rstd_table(LAS float* tbl, const float* part, int pm, int tid) {
    if (tid < 256) { const f32x4* p = (const f32x4*)(part + (size_t)(pm * BM + tid) * 32); float sm = 0.f;
#pragma unroll
        for (int q = 0; q < 8; ++q) { const f32x4 a = p[q]; sm += (a[0] + a[1]) + (a[2] + a[3]); }
        tbl[tid] = rsqrtf(sm * (1.0f / 2048.0f) + EPS); }
    if (tid == 0) ((LAS int*)tbl)[256] = pm;
}
#define EPI_NO_PREPARE __device__ __forceinline__ void prepare(const Unit&, int) const {}
struct EpiSwiGLU {
    static constexpr bool PERM = true, AFTER_DRAIN = false, IS_RESID = false, IS_GU = true;
    bf16_t* O; const float* part; LAS float* tbl;
    __device__ __forceinline__ void prepare(const Unit& u, int tid) const { rstd_table(tbl, part, u.pm, tid); }
    __device__ __forceinline__ void operator()(f32x4 (&acc)[2][2][4][2], const Unit& u, int wr, int wc, int fr, int fq) const {
        const int row0 = u.pm * BM + wr * 64 + fr, col0 = u.pn * HALF + wc * 32 + 8 * fq;
        const bool tb = __builtin_amdgcn_readfirstlane(((const LAS int*)tbl)[256]) == u.pm;
#pragma unroll
        for (int ai = 0; ai < 2; ++ai)
#pragma unroll
            for (int m = 0; m < 4; ++m) { const int row = row0 + ai * HALF + m * 16; const float rs = tb ? tbl[ai * HALF + wr * 64 + m * 16 + fr] : row_rstd(part, row, fq);
                const f32x2 rsl = (f32x2){-1.44269504089f * rs, -1.44269504089f * rs}, rs2 = (f32x2){rs * rs, rs * rs}; f32x2 o[4];
#pragma unroll
                for (int n = 0; n < 2; ++n)
#pragma unroll
                    for (int jp = 0; jp < 2; ++jp) { const f32x2 ag = (f32x2){acc[ai][0][m][n][2 * jp], acc[ai][0][m][n][2 * jp + 1]}, au = (f32x2){acc[ai][1][m][n][2 * jp], acc[ai][1][m][n][2 * jp + 1]};
                        const f32x2 t = ag * rsl; f32x2 d = (f32x2){__builtin_amdgcn_exp2f(t.x), __builtin_amdgcn_exp2f(t.y)}; d = d + 1.0f;
                        const f32x2 r = (f32x2){__builtin_amdgcn_rcpf(d.x), __builtin_amdgcn_rcpf(d.y)}; o[n * 2 + jp] = (ag * au) * (r * rs2); }
                u32x4 w; w.x = cvt_pk_bf16(o[0].x, o[0].y); w.y = cvt_pk_bf16(o[1].x, o[1].y); w.z = cvt_pk_bf16(o[2].x, o[2].y); w.w = cvt_pk_bf16(o[3].x, o[3].y);
                *(u32x4*)(O + (size_t)row * FF + col0) = w; }
    }
};
struct EpiResid {
    EPI_NO_PREPARE
    static constexpr bool PERM = true, AFTER_DRAIN = false, IS_RESID = true, IS_GU = false;
    bf16_t* hb; float* part; float alpha;
    __device__ __forceinline__ void load_half(u32x4 (&xk)[4][2], int ai, int row0, int col0) const {
#pragma unroll
        for (int m = 0; m < 4; ++m) { const bf16_t* bp = hb + (size_t)(row0 + ai * HALF + m * 16) * D + col0; xk[m][0] = *(const u32x4*)bp; xk[m][1] = *(const u32x4*)(bp + HALF); }
    }
    __device__ __forceinline__ void fold_half(f32x4 (&acc)[2][2][4][2], const u32x4 (&xk)[4][2], int ai) const {
#pragma unroll
        for (int m = 0; m < 4; ++m)
#pragma unroll
            for (int bj = 0; bj < 2; ++bj) { const u32x4 k = xk[m][bj];
                const f32x4 x0 = f16x4_to_f32((u32x2){k.x, k.y}), x1 = f16x4_to_f32((u32x2){k.z, k.w});
                acc[ai][bj][m][0] = x0 + acc[ai][bj][m][0] * alpha; acc[ai][bj][m][1] = x1 + acc[ai][bj][m][1] * alpha; }
    }
    __device__ __forceinline__ void store_half(const f32x4 (&acc)[2][2][4][2], int ai, int row0, int col0, int slot, int fq) const {
#pragma unroll
        for (int m = 0; m < 4; ++m) { const int row = row0 + ai * HALF + m * 16; bf16_t* bp = hb + (size_t)row * D + col0; float ss = 0.f;
#pragma unroll
            for (int bj = 0; bj < 2; ++bj) { const f32x4 x0 = acc[ai][bj][m][0], x1 = acc[ai][bj][m][1];
                u32x4 w; w.x = cvt_pk_h(x0[0], x0[1]); w.y = cvt_pk_h(x0[2], x0[3]); w.z = cvt_pk_h(x1[0], x1[1]); w.w = cvt_pk_h(x1[2], x1[3]);
                *(u32x4*)(bp + bj * HALF) = w;
                ss += ((x0[0] * x0[0] + x0[1] * x0[1]) + (x0[2] * x0[2] + x0[3] * x0[3])) + ((x1[0] * x1[0] + x1[1] * x1[1]) + (x1[2] * x1[2] + x1[3] * x1[3])); }
            ss += __shfl_xor(ss, 16); ss += __shfl_xor(ss, 32);
            if (fq == 0) part[(size_t)row * 32 + slot] = ss; }
    }
    __device__ __forceinline__ void operator()(f32x4 (&acc)[2][2][4][2], const Unit& u, int wr, int wc, int fr, int fq) const {
        const int row0 = u.pm * BM + wr * 64 + fr, col0 = u.pn * BM + wc * 32 + 8 * fq, slot = u.pn * 4 + wc;
        u32x4 xk[4][2], xk1[4][2];
        load_half(xk, 0, row0, col0);
#pragma unroll
        for (int m = 0; m < 3; ++m) { const bf16_t* bp = hb + (size_t)(row0 + HALF + m * 16) * D + col0; xk1[m][0] = *(const u32x4*)bp; xk1[m][1] = *(const u32x4*)(bp + HALF); }
        asm volatile("" ::: "memory");
        fold_half(acc, xk, 0); asm volatile("" ::: "memory");
        { const bf16_t* bp = hb + (size_t)(row0 + HALF + 3 * 16) * D + col0; xk1[3][0] = *(const u32x4*)bp; xk1[3][1] = *(const u32x4*)(bp + HALF); }
        asm volatile("" ::: "memory");
        store_half(acc, 0, row0, col0, slot, fq); asm volatile("" ::: "memory");
        fold_half(acc, xk1, 1);
        store_half(acc, 1, row0, col0, slot, fq);
    }
};
struct EpiRowScale {
    EPI_NO_PREPARE
    static constexpr bool PERM = true, AFTER_DRAIN = false, IS_RESID = false, IS_GU = false;
    bf16_t* O; int ldo; const float* part;
    __device__ __forceinline__ void operator()(f32x4 (&acc)[2][2][4][2], const Unit& u, int wr, int wc, int fr, int fq) const {
        const int row0 = u.pm * BM + wr * 64 + fr, col0 = u.pn * BM + wc * 32 + 8 * fq;
#pragma unroll
        for (int ai = 0; ai < 2; ++ai)
#pragma unroll
            for (int m = 0; m < 4; ++m) { const int row = row0 + ai * HALF + m * 16; const float rs = row_rstd(part, row, fq); bf16_t* rp = O + (size_t)row * ldo + col0;
#pragma unroll
                for (int bj = 0; bj < 2; ++bj) { const f32x4 v0 = acc[ai][bj][m][0] * rs, v1 = acc[ai][bj][m][1] * rs;
                    u32x4 w; w.x = cvt_pk_bf16(v0[0], v0[1]); w.y = cvt_pk_bf16(v0[2], v0[3]); w.z = cvt_pk_bf16(v1[0], v1[1]); w.w = cvt_pk_bf16(v1[2], v1[3]);
                    *(u32x4*)(rp + bj * HALF) = w; } }
    }
};
template <bool F16OUT> struct EpiPlain {
    EPI_NO_PREPARE
    static constexpr bool PERM = true, AFTER_DRAIN = false, IS_RESID = false, IS_GU = false;
    bf16_t* O; int ldo;
    __device__ __forceinline__ void operator()(f32x4 (&acc)[2][2][4][2], const Unit& u, int wr, int wc, int fr, int fq) const {
        const int row0 = u.pm * BM + wr * 64 + fr, col0 = u.pn * BM + wc * 32 + 8 * fq;
#pragma unroll
        for (int ai = 0; ai < 2; ++ai)
#pragma unroll
            for (int m = 0; m < 4; ++m) { bf16_t* rp = O + (size_t)(row0 + ai * HALF + m * 16) * ldo + col0;
#pragma unroll
                for (int bj = 0; bj < 2; ++bj) { const f32x4 v0 = acc[ai][bj][m][0], v1 = acc[ai][bj][m][1];
                    u32x4 w; w.x = cvt_pk16<F16OUT>(v0[0], v0[1]); w.y = cvt_pk16<F16OUT>(v0[2], v0[3]); w.z = cvt_pk16<F16OUT>(v1[0], v1[1]); w.w = cvt_pk16<F16OUT>(v1[2], v1[3]);
                    *(u32x4*)(rp + bj * HALF) = w; } }
    }
};
struct EpiLruIn {
    static constexpr bool PERM = true, AFTER_DRAIN = false, IS_RESID = false, IS_GU = false;
    bf16_t* gg; bf16_t* xr; const float* part; LAS float* tbl;
    __device__ __forceinline__ void prepare(const Unit& u, int tid) const { rstd_table(tbl, part, u.pm, tid); }
    __device__ __forceinline__ void operator()(f32x4 (&acc)[2][2][4][2], const Unit& u, int wr, int wc, int fr, int fq) const {
        const int row0 = u.pm * BM + wr * 64 + fr; const bool isg = u.pn < 8; const int col0 = (isg ? u.pn : u.pn - 8) * BM + wc * 32 + 8 * fq; bf16_t* O = isg ? gg : xr;
        const bool tb = __builtin_amdgcn_readfirstlane(((const LAS int*)tbl)[256]) == u.pm;
#pragma unroll
        for (int ai = 0; ai < 2; ++ai)
#pragma unroll
            for (int m = 0; m < 4; ++m) { const int row = row0 + ai * HALF + m * 16; const float rs = tb ? tbl[ai * HALF + wr * 64 + m * 16 + fr] : row_rstd(part, row, fq);
#pragma unroll
                for (int bj = 0; bj < 2; ++bj) { const f32x4 v0 = acc[ai][bj][m][0] * rs, v1 = acc[ai][bj][m][1] * rs; float o[8];
#pragma unroll
                    for (int j = 0; j < 8; ++j) { const float x = j < 4 ? v0[j] : v1[j - 4]; o[j] = isg ? x * fast_sigmoid(1.5957691216f * (x + 0.044715f * x * x * x)) : x; }
                    u32x4 w; w.x = cvt_pk_bf16(o[0], o[1]); w.y = cvt_pk_bf16(o[2], o[3]); w.z = cvt_pk_bf16(o[4], o[5]); w.w = cvt_pk_bf16(o[6], o[7]);
                    *(u32x4*)(O + (size_t)row * D + col0 + bj * HALF) = w; } }
    }
};
struct EpiGates {
    EPI_NO_PREPARE
    static constexpr bool PERM = true, AFTER_DRAIN = false, IS_RESID = false, IS_GU = false;
    bf16_t* LA; bf16_t* Bt; const bf16_t* xc; const float* ba; const float* bx; const float* sp8;
    __device__ __forceinline__ void operator()(f32x4 (&acc)[2][2][4][2], const Unit& u, int wr, int wc, int fr, int fq) const {
        const int row0 = u.pm * BM + wr * 64 + fr, c0 = u.pn * HALF + wc * 32 + 8 * fq;
        f32x4 bav[2], bxv[2], spv[2];
#pragma unroll
        for (int n = 0; n < 2; ++n) { bav[n] = *(const f32x4*)(ba + c0 + 4 * n); bxv[n] = *(const f32x4*)(bx + c0 + 4 * n); spv[n] = *(const f32x4*)(sp8 + c0 + 4 * n) * 1.44269504089f; }
        u32x4 xkv[8];
#pragma unroll
        for (int g = 0; g < 8; ++g) xkv[g] = *(const u32x4*)(xc + (size_t)(row0 + (g >> 2) * HALF + (g & 3) * 16) * D + c0);
        asm volatile("" ::: "memory");
#pragma unroll
        for (int ai = 0; ai < 2; ++ai)
#pragma unroll
            for (int m = 0; m < 4; ++m) { const int row = row0 + ai * HALF + m * 16; const u32x4 xk = xkv[ai * 4 + m]; float lo[8], bo[8];
#pragma unroll
                for (int n = 0; n < 2; ++n) { const unsigned k0 = n == 0 ? xk.x : xk.z, k1 = n == 0 ? xk.y : xk.w;
                    const f32x4 xv = (f32x4){__uint_as_float(k0 << 16), __uint_as_float(k0 & 0xffff0000u), __uint_as_float(k1 << 16), __uint_as_float(k1 & 0xffff0000u)};
#pragma unroll
                    for (int j = 0; j < 4; ++j) { const float r = fast_sigmoid(acc[ai][0][m][n][j] + bav[n][j]), ig = fast_sigmoid(acc[ai][1][m][n][j] + bxv[n][j]);
                        const float l2 = -r * spv[n][j];
                        const float l2r = __uint_as_float(cvt_pk_bf16(l2, l2) << 16);
                        const float t = 1.38629436112f * l2r;
                        const float ser = -t * (1.0f + 0.5f * t * (1.0f + (1.0f / 3.0f) * t * (1.0f + 0.25f * t * (1.0f + 0.2f * t * (1.0f + (1.0f / 6.0f) * t)))));
                        const float om = t > -0.3f ? ser : 1.0f - __builtin_amdgcn_exp2f(2.0f * l2r);
                        lo[n * 4 + j] = l2; bo[n * 4 + j] = sqrtf(om) * ig * xv[j]; } }
                u32x4 wl, wb; wl.x = cvt_pk_bf16(lo[0], lo[1]); wl.y = cvt_pk_bf16(lo[2], lo[3]); wl.z = cvt_pk_bf16(lo[4], lo[5]); wl.w = cvt_pk_bf16(lo[6], lo[7]);
                wb.x = cvt_pk_bf16(bo[0], bo[1]); wb.y = cvt_pk_bf16(bo[2], bo[3]); wb.z = cvt_pk_bf16(bo[4], bo[5]); wb.w = cvt_pk_bf16(bo[6], bo[7]);
                *(u32x4*)(LA + (size_t)row * D + c0) = wl; *(u32x4*)(Bt + (size_t)row * D + c0) = wb; }
    }
};
struct EpiSoftmax {
    EPI_NO_PREPARE
    static constexpr bool PERM = true, AFTER_DRAIN = true, IS_RESID = false, IS_GU = false;
    bf16_t* P; const float* part;
    __device__ __forceinline__ void fused(f32x4 (&acc)[2][2][4][2], const Unit& u, int wr, int wc, int fr, int fq, LAS unsigned char* lds, int wid, int lane) const {
        LAS float* X = (LAS float*)lds; LAS float* Y = (LAS float*)(lds + 4096);
#pragma unroll
        for (int ai = 0; ai < 2; ++ai)
#pragma unroll
            for (int m = 0; m < 4; ++m) { float mx = -3.0e38f; const float rs = row_rstd(part, u.pm * BM + ai * HALF + wr * 64 + m * 16 + fr, fq);
#pragma unroll
                for (int bj = 0; bj < 2; ++bj)
#pragma unroll
                    for (int n = 0; n < 2; ++n) { acc[ai][bj][m][n] = acc[ai][bj][m][n] * rs; const f32x4 x = acc[ai][bj][m][n]; mx = fmaxf(mx, fmaxf(fmaxf(x[0], x[1]), fmaxf(x[2], x[3]))); }
                mx = fmaxf(mx, __shfl_xor(mx, 16)); mx = fmaxf(mx, __shfl_xor(mx, 32));
                if (fq == 0) X[(ai * HALF + wr * 64 + m * 16 + fr) * 4 + wc] = mx; }
        LDS_WAIT(); __builtin_amdgcn_s_barrier(); asm volatile("" ::: "memory");
#pragma unroll
        for (int ai = 0; ai < 2; ++ai)
#pragma unroll
            for (int m = 0; m < 4; ++m) { const int r = ai * HALF + wr * 64 + m * 16 + fr; const f32x4 v = *(const LAS f32x4*)(X + r * 4);
                const float mx = fmaxf(fmaxf(v[0], v[1]), fmaxf(v[2], v[3])) * 1.44269504089f; float s = 0.f;
#pragma unroll
                for (int bj = 0; bj < 2; ++bj)
#pragma unroll
                    for (int n = 0; n < 2; ++n)
#pragma unroll
                        for (int j = 0; j < 4; ++j) { const float p = __builtin_amdgcn_exp2f(acc[ai][bj][m][n][j] * 1.44269504089f - mx); acc[ai][bj][m][n][j] = p; s += p; }
                s += __shfl_xor(s, 16); s += __shfl_xor(s, 32);
                if (fq == 0) Y[r * 4 + wc] = s; }
        LDS_WAIT(); __builtin_amdgcn_s_barrier(); asm volatile("" ::: "memory");
#pragma unroll
        for (int ai = 0; ai < 2; ++ai)
#pragma unroll
            for (int m = 0; m < 4; ++m) { const int r = ai * HALF + wr * 64 + m * 16 + fr; const f32x4 v = *(const LAS f32x4*)(Y + r * 4);
                const float inv = 1.0f / ((v[0] + v[1]) + (v[2] + v[3])); bf16_t* rp = P + (size_t)(u.pm * BM + r) * 1024 + u.pn * BM + wc * 32 + 8 * fq;
#pragma unroll
                for (int bj = 0; bj < 2; ++bj) { const f32x4 v0 = acc[ai][bj][m][0] * inv, v1 = acc[ai][bj][m][1] * inv;
                    u32x4 w; w.x = cvt_pk_bf16(v0[0], v0[1]); w.y = cvt_pk_bf16(v0[2], v0[3]); w.z = cvt_pk_bf16(v1[0], v1[1]); w.w = cvt_pk_bf16(v1[2], v1[3]);
                    *(u32x4*)(rp + bj * HALF) = w; } }
    }
};

template <bool F16> __device__ __forceinline__ f32x4 mma16(bf16x8 b, bf16x8 a, f32x4 c) {
    if constexpr (F16) return __builtin_amdgcn_mfma_f32_16x16x32_f16(__builtin_bit_cast(f16x8, b), __builtin_bit_cast(f16x8, a), c, 0, 0, 0);
    else return __builtin_amdgcn_mfma_f32_16x16x32_bf16(b, a, c, 0, 0, 0);
}
template <class Epi, bool ALIGN_EPI, int PID, class SchedT>
__device__ __forceinline__ void gemm_phase(LAS unsigned char* lds, const SchedT& S, const Epi& E, unsigned long long& pacc) {
    unsigned long long pt0 = 0, pt1 = 0; (void)pt0; (void)pt1;
    if constexpr (PROF_TAG == PID * 10 + 0) pt0 = PROF_NOW();
    { constexpr int ticks = Epi::IS_RESID ? STAGGER_TICKS : Epi::IS_GU ? STAGGER_GU_TICKS : 0;
      if constexpr (ticks > 0) { const unsigned grp = (blockIdx.x >> 3) & (Epi::IS_RESID ? (STAGGER_GROUPS - 1) : (STAGGER_GU_GROUPS - 1));
        if (grp) { const unsigned long long t0 = __builtin_amdgcn_s_memrealtime(), want = (unsigned long long)ticks * grp; while (__builtin_amdgcn_s_memrealtime() - t0 < want) __builtin_amdgcn_s_sleep(8); } } }
    int tid_ = threadIdx.x; asm volatile("" : "+v"(tid_));
    const int tid = tid_, wid = __builtin_amdgcn_readfirstlane(tid >> 6), lane = tid & 63, wr = wid >> 2, wc = wid & 3, fr = lane & 15, fq = lane >> 4;
    constexpr int K = SchedT::K, nt = K / BK;
    static_assert(K % 128 == 0 && K >= 256, "K multiple of 128, >= 256");
    unsigned voffA[2], voffB[2];
#pragma unroll
    for (int i = 0; i < 2; ++i) { int R, C; stage_rc(tid * 16 + i * 8192, R, C); const int Rb = Epi::PERM ? ((R & ~31) + perm32(R & 31)) : R;
        voffA[i] = (unsigned)(R * SchedT::lda + C) * 2u; voffB[i] = (unsigned)(Rb * SchedT::ldb + C) * 2u; }
    constexpr long kstep = SchedT::KREV ? -(long)(BK * 2) : (long)(BK * 2);
    constexpr size_t hstepA = (size_t)HALF * SchedT::lda * 2, hstepB = (size_t)HALF * SchedT::ldb * 2;
    const unsigned ldsw = (unsigned)wid * 1024u;
    const int aoff = lds_byte(wr * 64 + fr, fq * 8), boff = lds_byte(wc * 32 + fr, fq * 8);
#define PG8_SA(b, h) (((b) * 2 + (h)) * HTB)
#define PG8_SB(b, h) ((4 + (b) * 2 + (h)) * HTB)
#define PG8_STAGE(bufoff, gbase, voff) do { _Pragma("unroll") for (int _i = 0; _i < 2; ++_i) \
        __builtin_amdgcn_global_load_lds((const unsigned*)((const char*)(gbase) + (voff)[_i]), (LAS unsigned*)(lds + (bufoff) + ldsw + _i * 8192), 16, 0, 0); } while (0)
#define PG8_LDA(dst, b, h) do { _Pragma("unroll") for (int m = 0; m < 4; ++m) _Pragma("unroll") for (int k = 0; k < 2; ++k) dst[m][k] = *(const LAS bf16x8*)(lds + PG8_SA(b, h) + aoff + m * 2048 + k * 1024); } while (0)
#define PG8_LDB(dst, b, h) do { _Pragma("unroll") for (int n = 0; n < 2; ++n) _Pragma("unroll") for (int k = 0; k < 2; ++k) dst[n][k] = *(const LAS bf16x8*)(lds + PG8_SB(b, h) + boff + n * 2048 + k * 1024); } while (0)
#define PG8_MMA(ai, bj, At, Bt) do { __builtin_amdgcn_s_setprio(1); _Pragma("unroll") for (int m = 0; m < 4; ++m) _Pragma("unroll") for (int n = 0; n < 2; ++n) _Pragma("unroll") for (int k = 0; k < 2; ++k) \
        acc[ai][bj][m][n] = mma16<SchedT::F16>(Bt[n][k], At[m][k], acc[ai][bj][m][n]); __builtin_amdgcn_s_setprio(0); } while (0)
#define PG8_WAIT_V(n) asm volatile("s_waitcnt vmcnt(" #n ")" ::: "memory")
#define PG8_WAIT_L(n) asm volatile("s_waitcnt lgkmcnt(" #n ")" ::: "memory")
#define PG8_BAR __builtin_amdgcn_s_barrier()
#define PG8_SCHED __builtin_amdgcn_sched_barrier(0)
    Unit cur, nxt; int ui = 0;
    if (!S.next(0, cur)) return;
    E.prepare(cur, tid);
    f32x4 acc[2][2][4][2];
#pragma unroll
    for (int a = 0; a < 2; ++a)
#pragma unroll
        for (int b = 0; b < 2; ++b)
#pragma unroll
            for (int m = 0; m < 4; ++m)
#pragma unroll
                for (int n = 0; n < 2; ++n) acc[a][b][m][n] = (f32x4){0.f, 0.f, 0.f, 0.f};
    bf16x8 At[4][2], B0[2][2], B1[2][2];
    const char* cA = cur.a; const char* cB = cur.b;
    PG8_STAGE(PG8_SB(0, 0), cB, voffB); PG8_STAGE(PG8_SB(0, 1), cB + hstepB, voffB); PG8_STAGE(PG8_SA(0, 0), cA, voffA); PG8_STAGE(PG8_SA(0, 1), cA + hstepA, voffA);
    if (wr == 1) PG8_BAR;
    PG8_WAIT_V(2); PG8_BAR;
    PG8_STAGE(PG8_SB(1, 0), cB + kstep, voffB); PG8_STAGE(PG8_SA(1, 0), cA + kstep, voffA); PG8_STAGE(PG8_SB(1, 1), cB + hstepB + kstep, voffB);
    PG8_WAIT_V(6); PG8_BAR;
    for (;;) {
        const bool has_next = S.next(ui + 1, nxt);
        const char* nA = has_next ? nxt.a : cA; const char* nB = has_next ? nxt.b : cB;
        if constexpr (PROF_TAG == PID * 10 + 1) pt0 = PROF_NOW();
#define PG8_KITER(W1, W2, W3, W4, ST1) \
              \
            PG8_LDB(B0, 0, 0); PG8_LDB(B1, 0, 1); PG8_SCHED; PG8_LDA(At, 0, 0); if constexpr (!(ST1)) PG8_STAGE(PG8_SA(1, 1), a1 + hstepA, voffA); \
            PG8_WAIT_V(W1); PG8_WAIT_L(0); PG8_BAR; PG8_MMA(0, 0, At, B0); PG8_MMA(0, 1, At, B1); PG8_BAR; PG8_SCHED; \
              \
            PG8_LDA(At, 0, 1); PG8_STAGE(PG8_SB(0, 0), b2, voffB); PG8_STAGE(PG8_SB(0, 1), b2 + hstepB, voffB); PG8_STAGE(PG8_SA(0, 0), a2, voffA); \
            PG8_WAIT_V(W2); PG8_WAIT_L(0); PG8_BAR; PG8_MMA(1, 0, At, B0); PG8_MMA(1, 1, At, B1); PG8_BAR; PG8_SCHED; \
              \
            PG8_LDB(B0, 1, 0); PG8_LDB(B1, 1, 1); PG8_SCHED; PG8_LDA(At, 1, 0); PG8_STAGE(PG8_SA(0, 1), a2 + hstepA, voffA); \
            PG8_WAIT_V(W3); PG8_WAIT_L(0); PG8_BAR; PG8_MMA(0, 0, At, B0); PG8_MMA(0, 1, At, B1); PG8_BAR; PG8_SCHED; \
              \
            PG8_LDA(At, 1, 1); PG8_STAGE(PG8_SB(1, 0), b3, voffB); PG8_STAGE(PG8_SB(1, 1), b3 + hstepB, voffB); PG8_STAGE(PG8_SA(1, 0), a3, voffA); \
            PG8_WAIT_V(W4); PG8_WAIT_L(0); PG8_BAR; PG8_MMA(1, 0, At, B0); PG8_MMA(1, 1, At, B1); PG8_BAR; PG8_SCHED;
        int tp = 0;
        if constexpr (ALIGN_EPI && FIRST_ITER_RELAX) { tp = ui > 0 ? 2 : 0; asm volatile("" : "+v"(tp)); tp = __builtin_amdgcn_readfirstlane(tp); }
#pragma unroll 1
        for (int t = 0; t < tp; t += 2) {
            asm volatile("" : "+v"(voffA[0]), "+v"(voffA[1]), "+v"(voffB[0]), "+v"(voffB[1]));
            const char* a1 = cA + (long)(t + 1) * kstep; (void)a1;
            const char* a2 = cA + (long)(t + 2) * kstep; const char* b2 = cB + (long)(t + 2) * kstep;
            const char* a3 = a2 + kstep; const char* b3 = b2 + kstep;
            PG8_KITER(14, 14, 14, 8, true)
        }
#pragma unroll 1
        for (int t = tp; t < nt; t += 2) {
            asm volatile("" : "+v"(voffA[0]), "+v"(voffA[1]), "+v"(voffB[0]), "+v"(voffB[1]));
            const bool last = (t == nt - 2);
            if constexpr (PROF_TAG == PID * 10 + 4) { if (t == 0) pt0 = PROF_NOW(); }
            if constexpr (PROF_TAG == PID * 10 + 5) { if (t == 2) pt0 = PROF_NOW(); }
            const char* a1 = cA + (long)(t + 1) * kstep;
            const char* a2 = last ? nA : cA + (long)(t + 2) * kstep; const char* b2 = last ? nB : cB + (long)(t + 2) * kstep;
            const char* a3 = a2 + kstep; const char* b3 = b2 + kstep;
            PG8_KITER(8, 8, 8, 8, false)
            if constexpr (PROF_TAG == PID * 10 + 4) { if (t == 0) pacc += PROF_NOW() - pt0; }
            if constexpr (PROF_TAG == PID * 10 + 5) { if (t == 2) pacc += PROF_NOW() - pt0; }
        }
        if constexpr (PROF_TAG == PID * 10 + 1) pacc += PROF_NOW() - pt0;
        if constexpr (PROF_TAG == PID * 10 + 2) pt0 = PROF_NOW();
        if constexpr (ALIGN_EPI) { if (wr == 0) PG8_BAR; }
        if constexpr (ALIGN_EPI && FIRST_ITER_RELAX) { if (has_next) PG8_STAGE(PG8_SA(1, 1), nA + kstep + hstepA, voffA); }
        if constexpr (PROF_TAG == PID * 10 + 3) pt0 = PROF_NOW();
        if constexpr (!Epi::AFTER_DRAIN) { E(acc, cur, wr, wc, fr, fq); }
        if constexpr (PROF_TAG == PID * 10 + 2 || PROF_TAG == PID * 10 + 3) pacc += PROF_NOW() - pt0;
        if (!has_next) break;
#pragma unroll
        for (int a = 0; a < 2; ++a)
#pragma unroll
            for (int b = 0; b < 2; ++b)
#pragma unroll
                for (int m = 0; m < 4; ++m)
#pragma unroll
                    for (int n = 0; n < 2; ++n) acc[a][b][m][n] = (f32x4){0.f, 0.f, 0.f, 0.f};
        cur = nxt; cA = nA; cB = nB; ++ui;
        if constexpr (ALIGN_EPI) { if (wr == 1) PG8_BAR; }
    }
    PG8_WAIT_V(0);
    if constexpr (!ALIGN_EPI) { if (wr == 0) PG8_BAR; }
    PG8_BAR;
    if constexpr (Epi::AFTER_DRAIN) { E.fused(acc, cur, wr, wc, fr, fq, lds, wid, lane); }
    if constexpr (PROF_TAG == PID * 10 + 0) pacc += PROF_NOW() - pt0;
#undef PG8_SA
#undef PG8_SB
#undef PG8_STAGE
#undef PG8_LDA
#undef PG8_LDB
#undef PG8_MMA
#undef PG8_WAIT_V
#undef PG8_WAIT_L
#undef PG8_BAR
#undef PG8_SCHED
}
}

constexpr size_t MiB = 1u << 20;
constexpr size_t WS_CTL = 0, CTL_ZERO_BYTES = 1 * MiB;
constexpr size_t WS_SP = 1 * MiB;
constexpr size_t WS_CHA = 2 * MiB, WS_CHB = 4 * MiB;
constexpr size_t WS_PART = 6 * MiB;
constexpr size_t WS_MB = 8 * MiB;
constexpr size_t WS_KV = 12 * MiB;
constexpr size_t WS_WGU = 48 * MiB;
constexpr size_t WS_WD = 400 * MiB;
constexpr size_t WS_WQN = 576 * MiB;
constexpr size_t WS_WK = 608 * MiB, WS_WV = 640 * MiB, WS_WO = 672 * MiB;
constexpr size_t WS_WIN = 704 * MiB;
constexpr size_t WS_WOUT = 736 * MiB;
constexpr size_t WS_WP = 752 * MiB;
constexpr size_t WS_WGATE = 756 * MiB;
constexpr size_t WS_HB = 760 * MiB;
constexpr size_t WS_ACT = 824 * MiB;
constexpr size_t WS_S = 1000 * MiB;
constexpr size_t WS_P = WS_S;
constexpr size_t WS_POOLED = WS_S;
constexpr size_t WS_GG = WS_S, WS_BT = WS_S + 64 * MiB, WS_XCB = WS_S + 192 * MiB;
constexpr size_t WS_XR = WS_ACT;
constexpr size_t WS_LA = WS_ACT + 64 * MiB;
constexpr size_t WS_GALL = WS_S + 256 * MiB;
constexpr size_t WS_HALL = WS_S + 320 * MiB;
constexpr size_t WS_END = WS_S + 384 * MiB;
constexpr int CW_BAR = 4096;
constexpr int LDS_BYTES = 147456, MISC_OFF = LDS_BYTES - 512, EPI_TBL_OFF = 131072;

#define XB_TMO      128
#define XB_XCNT(j)  (256  + 64 * (j))
#define XB_XSUB(j)  (1280 + 64 * (j))
#define XB_XGEN(j)  (2304 + 64 * (j))
#define XB_TOP      3328
#define XB_TOPGEN   3392
#define XCD_BAR_WORDS 3456
#define XB_SPIN_CAP (1u << 18)
__device__ __forceinline__ unsigned xb_ld(unsigned* p)              { return __hip_atomic_load(p, __ATOMIC_RELAXED, __HIP_MEMORY_SCOPE_AGENT); }
__device__ __forceinline__ unsigned xb_add(unsigned* p, unsigned v) { return __hip_atomic_fetch_add(p, v, __ATOMIC_RELAXED, __HIP_MEMORY_SCOPE_AGENT); }
__device__ __forceinline__ unsigned xb_xcc_id() { return (unsigned)__builtin_amdgcn_s_getreg((3 << 11) | 20) & 0xFu; }
#define XB_SPIN(cond, bar) do { unsigned _sp = 0; while (cond) { __builtin_amdgcn_s_sleep(1); \
    if ((++_sp & 255u) == 0u) { if (xb_ld(&(bar)[XB_TMO])) break; if (_sp > XB_SPIN_CAP) { atomicAdd(&(bar)[XB_TMO], 1u); break; } } } } while (0)
struct XcdBarrier { unsigned* bar; unsigned x; volatile LAS unsigned* st; };
__device__ __forceinline__ XcdBarrier xcd_barrier_post(unsigned* bar, volatile LAS unsigned* st) {
    XcdBarrier b; b.bar = bar; b.x = xb_xcc_id(); b.st = st;
    if (threadIdx.x == 0) (void)xb_add(&bar[XB_XCNT(b.x)], 1u);
    return b;
}
__device__ __forceinline__ void xcd_barrier_complete(unsigned* bar, unsigned x, unsigned& nloc, unsigned& nx) {
    const unsigned G = gridDim.x * gridDim.y * gridDim.z;
    unsigned sum, cnt, mine, sp = 0u;
    for (;;) {
        sum = 0u; cnt = 0u; mine = 0u;
#pragma unroll
        for (unsigned j = 0; j < 16; ++j) { const unsigned c = xb_ld(&bar[XB_XCNT(j)]); sum += c; cnt += (c > 0u) ? 1u : 0u; mine = (j == x) ? c : mine; }
        if (sum == G) break;
        __builtin_amdgcn_s_sleep(1);
        if ((++sp & 255u) == 0u) { if (xb_ld(&bar[XB_TMO])) break; if (sp > XB_SPIN_CAP) { atomicAdd(&bar[XB_TMO], 1u); break; } }
    }
    nloc = mine > 0u ? mine : 1u; nx = cnt > 0u ? cnt : 1u;
}
__device__ __forceinline__ void xcd_barrier(const XcdBarrier& b) {
    asm volatile("s_waitcnt vmcnt(0)" ::: "memory");
    __syncthreads();
    if (threadIdx.x == 0) {
        unsigned* bar = b.bar;
        __builtin_amdgcn_s_waitcnt(0);
        unsigned nloc = b.st[0], nx = b.st[1];
        if (nloc == 0u) { xcd_barrier_complete(bar, b.x, nloc, nx); b.st[0] = nloc; b.st[1] = nx; }
        const unsigned old = xb_add(&bar[XB_XSUB(b.x)], 1u);
        const unsigned gen = old / nloc;
        if (old + 1u == (gen + 1u) * nloc) {
            __builtin_amdgcn_fence(__ATOMIC_RELEASE, "agent");
            asm volatile("s_waitcnt vmcnt(0)" ::: "memory");
            const unsigned og = xb_add(&bar[XB_TOP], 1u);
            const unsigned tg = og / nx;
            if (og + 1u == (tg + 1u) * nx) xb_add(&bar[XB_TOPGEN], 1u);
            else XB_SPIN(xb_ld(&bar[XB_TOPGEN]) == tg, bar);
            __builtin_amdgcn_fence(__ATOMIC_ACQUIRE, "agent");
            xb_add(&bar[XB_XGEN(b.x)], 1u);
            asm volatile("s_waitcnt vmcnt(0)" ::: "memory");
        } else {
            XB_SPIN(xb_ld(&bar[XB_XGEN(b.x)]) == gen, bar);
            __builtin_amdgcn_fence(__ATOMIC_ACQUIRE, "agent");
            asm volatile("s_waitcnt vmcnt(0)" ::: "memory");
        }
    }
    __syncthreads();
}

template <bool F16OUT = false>
__device__ __forceinline__ void tr_item(const float* src, int ldw, bf16_t* dst, int ldd, const float* ks, const float* ns, float sc, bf16_t* dstz, LAS float* scr, int lane) {
    f32x4 v[16];
    const float* s0 = src + (size_t)(lane >> 4) * ldw + (lane & 15) * 4;
#pragma unroll
    for (int i = 0; i < 16; ++i) v[i] = *(const f32x4*)(s0 + (size_t)(4 * i) * ldw);
#pragma unroll
    for (int i = 0; i < 16; ++i) { LAS float* p = scr + ((lane >> 4) + 4 * i) * 65 + (lane & 15) * 4; p[0] = v[i][0]; p[1] = v[i][1]; p[2] = v[i][2]; p[3] = v[i][3]; }
    LDS_WAIT(); asm volatile("" ::: "memory");
    const int c = lane & 7;
    f32x4 k0v = (f32x4){sc, sc, sc, sc}, k1v = k0v;
    if (ks) { k0v = *(const f32x4*)(ks + 8 * c) * sc; k1v = *(const f32x4*)(ks + 8 * c + 4) * sc; }
#pragma unroll
    for (int j = 0; j < 8; ++j) { const int n = (lane >> 3) + 8 * j; const LAS float* s = scr + (8 * c) * 65 + n; const float nsv = ns ? ns[n] : 1.0f;
        u32x4 o; o.x = cvt_pk16<F16OUT>(s[0 * 65] * k0v[0] * nsv, s[1 * 65] * k0v[1] * nsv); o.y = cvt_pk16<F16OUT>(s[2 * 65] * k0v[2] * nsv, s[3 * 65] * k0v[3] * nsv);
        o.z = cvt_pk16<F16OUT>(s[4 * 65] * k1v[0] * nsv, s[5 * 65] * k1v[1] * nsv); o.w = cvt_pk16<F16OUT>(s[6 * 65] * k1v[2] * nsv, s[7 * 65] * k1v[3] * nsv);
        *(u32x4*)(dst + (size_t)n * ldd + 8 * c) = o;
        if (dstz) *(u32x4*)(dstz + (size_t)n * ldd + 8 * c) = (u32x4){0u, 0u, 0u, 0u}; }
    LDS_WAIT(); asm volatile("" ::: "memory");
}

struct TrItem { const float* src; bf16_t* dst; const float* ks; const float* ns; bf16_t* dstz; int ldw, ldd, f16; };
__device__ __forceinline__ void tr_load(const TrItem& t, f32x4 (&v)[16], int lane) {
    const float* s0 = t.src + (size_t)(lane >> 4) * t.ldw + (lane & 15) * 4;
#pragma unroll
    for (int i = 0; i < 16; ++i) v[i] = *(const f32x4*)(s0 + (size_t)(4 * i) * t.ldw);
}
template <bool F16OUT>
__device__ __forceinline__ void tr_finish_t(const TrItem& t, const f32x4 (&v)[16], LAS float* scr, int lane) {
#pragma unroll
    for (int i = 0; i < 16; ++i) { LAS float* p = scr + ((lane >> 4) + 4 * i) * 65 + (lane & 15) * 4; p[0] = v[i][0]; p[1] = v[i][1]; p[2] = v[i][2]; p[3] = v[i][3]; }
    LDS_WAIT(); asm volatile("" ::: "memory");
    const int c = lane & 7;
    f32x4 k0v = (f32x4){1.f, 1.f, 1.f, 1.f}, k1v = k0v;
    if (t.ks) { k0v = *(const f32x4*)(t.ks + 8 * c); k1v = *(const f32x4*)(t.ks + 8 * c + 4); }
#pragma unroll
    for (int j = 0; j < 8; ++j) { const int n = (lane >> 3) + 8 * j; const LAS float* s = scr + (8 * c) * 65 + n; const float nsv = t.ns ? t.ns[n] : 1.0f;
        u32x4 o; o.x = cvt_pk16<F16OUT>(s[0 * 65] * k0v[0] * nsv, s[1 * 65] * k0v[1] * nsv); o.y = cvt_pk16<F16OUT>(s[2 * 65] * k0v[2] * nsv, s[3 * 65] * k0v[3] * nsv);
        o.z = cvt_pk16<F16OUT>(s[4 * 65] * k1v[0] * nsv, s[5 * 65] * k1v[1] * nsv); o.w = cvt_pk16<F16OUT>(s[6 * 65] * k1v[2] * nsv, s[7 * 65] * k1v[3] * nsv);
        *(u32x4*)(t.dst + (size_t)n * t.ldd + 8 * c) = o;
        if (t.dstz) *(u32x4*)(t.dstz + (size_t)n * t.ldd + 8 * c) = (u32x4){0u, 0u, 0u, 0u}; }
    LDS_WAIT(); asm volatile("" ::: "memory");
}
__device__ __forceinline__ void tr_finish(const TrItem& t, const f32x4 (&v)[16], LAS float* scr, int lane) { if (t.f16) tr_finish_t<true>(t, v, scr, lane); else tr_finish_t<false>(t, v, scr, lane); }
template <class T> __device__ __forceinline__ T* uniform_ptr(T* p) {
    const unsigned long long v = (unsigned long long)p; const unsigned lo = __builtin_amdgcn_readfirstlane((unsigned)v), hi = __builtin_amdgcn_readfirstlane((unsigned)(v >> 32));
    return (T*)(((unsigned long long)hi << 32) | lo);
}
struct Args { const float* in[25]; float* out; unsigned char* ws; int step, phase; };

__device__ __forceinline__ void prologue(const Args& args, LAS unsigned char* lds, int lane, int wave, int bx, int G) {
    unsigned char* ws = args.ws;
    LAS float* scr = (LAS float*)(lds + wave * 16640);
    const int gw = bx * 8 + wave, NGW = G * 8;
    constexpr int I_GU = 32 * 88, N_GU = 16 * I_GU, I_D = 88 * 32, N_D = 8 * I_D, I_SQ = 32 * 32, N_SQ = 12 * I_SQ, I_IN = 32 * 64, N_IN = 2 * I_IN, I_OUT = 32 * 32, N_OUT = 2 * I_OUT,
                  I_P = 8 * 8, N_P = 8 * I_P, I_G = 4, N_G = 64 * I_G, NITEMS = N_GU + N_D + N_SQ + N_IN + N_OUT + N_P + N_G;
#define TR_KB(item, NB) (2 * (((item) >> 3) / ((NB) / 4)) + (((item) & 7) >> 2))
#define TR_NB(item, NB) (4 * (((item) >> 3) % ((NB) / 4)) + ((item) & 3))
    auto decode = [&](int it) -> TrItem { TrItem t; t.ks = nullptr; t.ns = nullptr; t.dstz = nullptr; t.f16 = 0; int r = it;
        if (r < N_GU) { const int mat = r / I_GU, item = r % I_GU, lw = mat >> 1, up = mat & 1, k0 = TR_KB(item, 88) * 64, n0 = TR_NB(item, 88) * 64;
            t.src = (up ? args.in[4] : args.in[3]) + (size_t)lw * D * FF + (size_t)k0 * FF + n0; t.ldw = FF;
            t.dst = (bf16_t*)(ws + WS_WGU) + (size_t)lw * (2 * FF) * D + (size_t)(256 * (n0 >> 7) + (n0 & 127) + up * 128) * D + k0; t.ldd = D; t.ks = args.in[2] + lw * D + k0; t.f16 = 1; return t; }
        r -= N_GU;
        if (r < N_D) { const int lw = r / I_D, item = r % I_D, k0 = TR_KB(item, 32) * 64, n0 = TR_NB(item, 32) * 64;
            t.src = args.in[5] + (size_t)lw * FF * D + (size_t)k0 * D + n0; t.ldw = D; t.dst = (bf16_t*)(ws + WS_WD) + (size_t)lw * D * FF + (size_t)n0 * FF + k0; t.ldd = FF; return t; }
        r -= N_D;
        if (r < N_SQ) { const int mat = r / I_SQ, item = r % I_SQ, which = mat >> 2, L = mat & 3, k0 = TR_KB(item, 32) * 64, n0 = TR_NB(item, 32) * 64;
            t.src = (which == 0 ? args.in[21] : which == 1 ? args.in[22] : args.in[23]) + (size_t)L * D * D + (size_t)k0 * D + n0; t.ldw = D;
            t.dst = (bf16_t*)(ws + WS_WK + (size_t)which * 32 * MiB) + (size_t)L * D * D + (size_t)n0 * D + k0; t.ldd = D; return t; }
        r -= N_SQ;
        if (r < N_IN) { const int j = r / I_IN, item = r % I_IN, k0 = TR_KB(item, 64) * 64, n0 = TR_NB(item, 64) * 64;
            t.src = args.in[9] + (size_t)j * D * 4096 + (size_t)k0 * 4096 + n0; t.ldw = 4096; t.dst = (bf16_t*)(ws + WS_WIN) + (size_t)j * 4096 * D + (size_t)n0 * D + k0; t.ldd = D; t.ks = args.in[6] + (2 * j + 1) * D + k0; t.f16 = 1; return t; }
        r -= N_IN;
        if (r < N_OUT) { const int j = r / I_OUT, item = r % I_OUT, k0 = TR_KB(item, 32) * 64, n0 = TR_NB(item, 32) * 64;
            t.src = args.in[17] + (size_t)j * D * D + (size_t)k0 * D + n0; t.ldw = D; t.dst = (bf16_t*)(ws + WS_WOUT) + (size_t)j * D * D + (size_t)n0 * D + k0; t.ldd = D; return t; }
        r -= N_OUT;
        if (r < N_P) { const int mat = r / I_P, item = r % I_P, j = mat >> 2, g = mat & 3, k0 = TR_KB(item, 8) * 64, n0 = TR_NB(item, 8) * 64;
            t.src = args.in[7] + (size_t)mat * 512 * 512 + (size_t)k0 * 512 + n0; t.ldw = 512; t.dst = (bf16_t*)(ws + WS_WP) + (size_t)j * D * 512 + (size_t)(g * 512 + n0) * 512 + k0; t.ldd = 512;
            t.ks = args.in[6] + (2 * j) * D + g * 512 + k0; t.ns = args.in[8] + j * D + g * 512 + n0; return t; }
        r -= N_P;
        { const int mat = r / I_G, item = r % I_G, j = mat >> 5, isx = (mat >> 4) & 1, hh = mat & 15, k0 = (item >> 1) * 64, n0 = (item & 1) * 64;
            bf16_t* rowp = (bf16_t*)(ws + WS_WGATE) + (size_t)j * 4096 * 256 + (size_t)(hh * 256 + isx * 128 + n0) * 256;
            t.src = (isx ? args.in[14] : args.in[12]) + (size_t)(j * 16 + hh) * 128 * 128 + (size_t)k0 * 128 + n0; t.ldw = 128; t.dst = rowp + (hh & 1) * 128 + k0; t.ldd = 256; t.dstz = rowp + ((hh & 1) ^ 1) * 128 + k0; return t; } };
    if (gw < NITEMS) { int it = gw; TrItem a = decode(it), b = a; f32x4 va[16], vb[16]; tr_load(a, va, lane);
        for (;;) { const int itb = it + NGW; const bool hasb = itb < NITEMS;
            if (hasb) { b = decode(itb); tr_load(b, vb, lane); }
            asm volatile("" ::: "memory");
            tr_finish(a, va, scr, lane);
            if (!hasb) break;
            const int ita = itb + NGW; const bool hasa = ita < NITEMS;
            if (hasa) { a = decode(ita); tr_load(a, va, lane); }
            asm volatile("" ::: "memory");
            tr_finish(b, vb, scr, lane);
            if (!hasa) break;
            it = ita; } }
    { bf16_t* wqn = (bf16_t*)(ws + WS_WQN);
      for (int row = gw; row < 4 * D; row += NGW) { const float sck = args.in[18][row] * 0.04419417382415922f; const f32x4* xr = (const f32x4*)(args.in[20] + (size_t)row * D) + lane; u32x2* br = (u32x2*)(wqn + (size_t)row * D) + lane;
#pragma unroll
          for (int j = 0; j < 8; ++j) { const f32x4 v = xr[64 * j] * sck; u32x2 w; w.x = cvt_pk_bf16(v[0], v[1]); w.y = cvt_pk_bf16(v[2], v[3]); br[64 * j] = w; } } }
    { const float* x = args.in[0]; bf16_t* hb = (bf16_t*)(ws + WS_HB); float* part = (float*)(ws + WS_PART);
      for (int row = gw; row < M; row += NGW) { const f32x4* xr = (const f32x4*)(x + (size_t)row * D) + lane; f32x4 v[8]; float ss = 0.f;
#pragma unroll
          for (int j = 0; j < 8; ++j) { v[j] = xr[64 * j]; ss += (v[j][0] * v[j][0] + v[j][1] * v[j][1]) + (v[j][2] * v[j][2] + v[j][3] * v[j][3]); }
          ss = wave_sum(ss);
          u32x2* br = (u32x2*)(hb + (size_t)row * D) + lane;
#pragma unroll
          for (int j = 0; j < 8; ++j) { u32x2 w; w.x = cvt_pk_h(v[j][0], v[j][1]); w.y = cvt_pk_h(v[j][2], v[j][3]); br[64 * j] = w; }
          if (lane < 32) part[(size_t)row * 32 + lane] = lane == 0 ? ss : 0.f; } }
    { const float* mem = args.in[1]; const float* g = args.in[19]; bf16_t* mb = (bf16_t*)(ws + WS_MB);
      for (int row = gw; row < MM; row += NGW) { const f32x4* xr = (const f32x4*)(mem + (size_t)row * D) + lane; f32x4 v[8]; float ss = 0.f;
#pragma unroll
          for (int j = 0; j < 8; ++j) { v[j] = xr[64 * j]; ss += (v[j][0] * v[j][0] + v[j][1] * v[j][1]) + (v[j][2] * v[j][2] + v[j][3] * v[j][3]); }
          const float rs = rsqrtf(wave_sum(ss) * (1.0f / 2048.0f) + EPS); u32x2* br = (u32x2*)(mb + (size_t)row * D) + lane;
#pragma unroll
          for (int j = 0; j < 8; ++j) { const f32x4 gv = *((const f32x4*)g + lane + 64 * j); const f32x4 o = v[j] * rs * gv; u32x2 w; w.x = cvt_pk_bf16(o[0], o[1]); w.y = cvt_pk_bf16(o[2], o[3]); br[64 * j] = w; } } }
    { const float* lam = args.in[16]; float* sp = (float*)(ws + WS_SP);
      for (int i = gw * 64 + lane; i < 2 * D; i += NGW * 64) { const float z = -lam[i]; sp[i] = 8.0f * (fmaxf(z, 0.f) + log1pf(expf(-fabsf(z)))); } }
}

constexpr int PD = 256 * D * 2;
typedef pg8::Sched<M,      2 * FF,  D,   D,    D,      PD,            0,       0,   PD,             0,                0, false, true> ShGU;
typedef pg8::Sched<M,      D,       FF,  FF,   FF,     256 * FF * 2,  0,       0,   256 * FF * 2,   0,                0, DOWN_KREV, false, DOWN_WGM> ShDown;
typedef pg8::Sched<M,      D,       512, D,    512,    PD,            512 * 2, 1,   256 * 512 * 2,  0,                0> ShPool;
typedef pg8::Sched<M,      2 * D,   D,   D,    D,      PD,            0,       0,   PD,             0,                0, false, true> ShLruIn;
typedef pg8::Sched<M,      2 * D,   256, D,    256,    PD,            256 * 2, 1,   256 * 256 * 2,  0,                0> ShGates;
typedef pg8::Sched<M,      D,       D,   D,    D,      PD,            0,       0,   PD,             0,                0> ShDD;
typedef pg8::Sched<M,      NH*MEML, D,   D,    D,      PD,            0,       0,   256 * D * 2,    1024 * D * 2,     4, false, true> ShScore;
typedef pg8::Sched<M,      D,       1024, 1024, 4096,  256 * 1024 * 2, 0,      0,   256 * 4096 * 2, 1024 * 2,         4> ShAO;
typedef pg8::Sched<MM,     8 * D,   D,   D,    D,      PD,            0,       0,   PD,             0,                0> ShKV;

#define LD_BF4P(p) f16x4_to_f32(*(const u32x2*)(p))
__device__ __forceinline__ unsigned long long launder_u64(unsigned long long v) {
    unsigned lo = (unsigned)v, hi = (unsigned)(v >> 32); asm volatile("" : "+v"(lo), "+v"(hi));
    return ((unsigned long long)(unsigned)__builtin_amdgcn_readfirstlane(hi) << 32) | (unsigned)__builtin_amdgcn_readfirstlane(lo);
}
#define PHASE_VARS() int tid = threadIdx.x; asm volatile("" : "+v"(tid)); unsigned char* ws = (unsigned char*)(GAS unsigned char*)launder_u64((unsigned long long)args.ws); float* h = (float*)(GAS float*)launder_u64((unsigned long long)args.out); \
    bf16_t* hb = (bf16_t*)(ws + WS_HB); float* part = (float*)(ws + WS_PART); (void)tid; (void)h; (void)hb; (void)part
__global__ void __launch_bounds__(512, 2) mk_fwd(Args args) {
    extern __shared__ __attribute__((aligned(16))) unsigned char lds_raw[];
    LAS unsigned char* lds = (LAS unsigned char*)lds_raw;
    const int G = gridDim.x, bx = blockIdx.x;
    unsigned long long prof_acc = 0;
#if MK_SINGLE
    volatile LAS unsigned* MISC = (volatile LAS unsigned*)(lds + MISC_OFF);
    if (threadIdx.x < 32) MISC[threadIdx.x] = 0u;
    __syncthreads();
    XcdBarrier bar = xcd_barrier_post((unsigned*)(args.ws + WS_CTL) + CW_BAR, MISC + 8);
#define GRID_BAR() xcd_barrier(bar)
#define PH(k) true
    const int s_lo = 0, s_hi = 8; const bool do_pro = true, do_fin = true;
#else
#define GRID_BAR() do {} while (0)
#define PH(k) (args.phase == (k))
    const int s_lo = args.step, s_hi = (args.step >= 0 && args.step < 8) ? args.step + 1 : args.step; const bool do_pro = args.step == -1, do_fin = args.step == 8;
#endif

    if (do_pro) {
        if (PH(0)) { for (int rep = 0; rep < REP_PRO; ++rep) { PHASE_VARS(); unsigned long long pt_ = 0; if constexpr (PROF_TAG == 110) pt_ = PROF_NOW(); prologue(args, lds, tid & 63, __builtin_amdgcn_readfirstlane(tid >> 6), bx, G); GRID_BAR(); if constexpr (PROF_TAG == 110) prof_acc += PROF_NOW() - pt_; } }
        if (PH(1)) {
            PHASE_VARS(); ShKV S{(const char*)(ws + WS_MB), (const char*)(ws + WS_WK), G, bx}; pg8::EpiPlain<false> E{(bf16_t*)(ws + WS_KV), 8 * D}; pg8::gemm_phase<pg8::EpiPlain<false>, true, 9>(lds, S, E, prof_acc); GRID_BAR(); }
        if (PH(2)) {
            { PHASE_VARS(); pg8::SchedG S{(const char*)(ws + WS_KV), (const char*)(ws + WS_WQN), G, bx}; pg8::EpiPlain<true> E{(bf16_t*)(ws + WS_GALL), D}; pg8::gemm_phase<pg8::EpiPlain<true>, true, 10>(lds, S, E, prof_acc); }
            { PHASE_VARS(); pg8::SchedH S{(const char*)(ws + WS_WO), (const char*)(ws + WS_KV), G, bx}; pg8::EpiPlain<false> E{(bf16_t*)(ws + WS_HALL), 4096}; pg8::gemm_phase<pg8::EpiPlain<false>, true, 10>(lds, S, E, prof_acc); }
        }
    }
#pragma unroll 1
    for (int s = s_lo; s < s_hi; ++s) {
        const int L = s >> 1, lw = s;
        if (PH(0)) for (int rep = 0; rep < REP_GU; ++rep) { PHASE_VARS(); ShGU S{(const char*)hb, (const char*)(ws + WS_WGU) + (size_t)lw * (2 * FF) * D * 2, G, bx};
            pg8::EpiSwiGLU E{(bf16_t*)(ws + WS_ACT), part, (LAS float*)(lds + EPI_TBL_OFF)};
            pg8::gemm_phase<pg8::EpiSwiGLU, true, 1>(lds, S, E, prof_acc); GRID_BAR(); }
        if (PH(1)) for (int rep = 0; rep < REP_DOWN; ++rep) { PHASE_VARS(); ShDown S{(const char*)(ws + WS_ACT), (const char*)(ws + WS_WD) + (size_t)lw * D * FF * 2, G, bx};
            pg8::EpiResid E{hb, part, 0.5f};
            pg8::gemm_phase<pg8::EpiResid, true, 2>(lds, S, E, prof_acc); GRID_BAR(); }
        if ((s & 1) == 0) {
            const int j = L >> 1;
            if ((L & 1) == 0) {
                if (PH(2)) for (int rep = 0; rep < REP_THIN; ++rep) { PHASE_VARS(); unsigned long long pt_ = 0; if constexpr (PROF_TAG == 120) pt_ = PROF_NOW(); bf16_t* pooled = (bf16_t*)(ws + WS_POOLED); LAS float* R = (LAS float*)lds;
                    for (int blk = bx; blk < M / 64; blk += G) { const int t0 = blk * 64, seq0 = (t0 / SEQ) * SEQ;
                        if (tid < 79) { const int row = t0 - 15 + tid; float rs = 0.f;
                            if (row >= seq0) { const f32x4* p = (const f32x4*)(part + (size_t)row * 32); float sacc = 0.f;
#pragma unroll
                                for (int q = 0; q < 8; ++q) { const f32x4 a = p[q]; sacc += (a[0] + a[1]) + (a[2] + a[3]); }
                                rs = rsqrtf(sacc * (1.0f / 2048.0f) + EPS); }
                            R[tid] = rs; }
                        __syncthreads();
                        const int w = 2 << (tid >> 7); const bf16_t* hc = hb + 4 * tid; f32x4 S4 = (f32x4){0.f, 0.f, 0.f, 0.f};
                        { u32x2 hk[15];
#pragma unroll
                          for (int i = 0; i < 15; ++i) { const int r = t0 - 15 + i; hk[i] = (i >= 16 - w && r >= seq0) ? *(const u32x2*)(hc + (size_t)r * D) : (u32x2){0u, 0u}; }
#pragma unroll
                          for (int i = 0; i < 15; ++i) S4 = S4 + f16x4_to_f32(hk[i]) * R[i]; }
                        u32x2 nb[2][8], ob[2][8];
#define POOL_LOAD(b) do { _Pragma("unroll") for (int i = 0; i < 8; ++i) { const int t_ = t0 + 8 * (b) + i, to_ = t_ - w; nb[(b) & 1][i] = *(const u32x2*)(hc + (size_t)t_ * D); \
                              ob[(b) & 1][i] = to_ >= seq0 ? *(const u32x2*)(hc + (size_t)to_ * D) : (u32x2){0u, 0u}; } } while (0)
                        POOL_LOAD(0);
#pragma unroll
                        for (int b = 0; b < 8; ++b) { if (b + 1 < 8) POOL_LOAD(b + 1);
                            asm volatile("" ::: "memory");
#pragma unroll
                            for (int i = 0; i < 8; ++i) { const int idx = 8 * b + i, t = t0 + idx, tt = t - seq0; const f32x4 uv = f16x4_to_f32(nb[b & 1][i]) * R[idx + 15]; S4 = S4 + uv;
                                if (idx > 0 && tt >= w) S4 = S4 - f16x4_to_f32(ob[b & 1][i]) * R[idx - w + 15];
                                const float ic = 1.0f / (float)(tt + 1 < w ? tt + 1 : w); const f32x4 o = S4 * ic - uv;
                                u32x2 pk; pk.x = cvt_pk_bf16(o[0], o[1]); pk.y = cvt_pk_bf16(o[2], o[3]); *(u32x2*)(pooled + (size_t)t * D + 4 * tid) = pk; }
                            asm volatile("" ::: "memory"); }
#undef POOL_LOAD
                        __syncthreads(); }
                    GRID_BAR(); if constexpr (PROF_TAG == 120) prof_acc += PROF_NOW() - pt_; }
                if (PH(3)) { PHASE_VARS(); ShPool S{(const char*)(ws + WS_POOLED), (const char*)(ws + WS_WP) + (size_t)j * D * 512 * 2, G, bx};
                    pg8::EpiResid E{hb, part, 1.0f};
                    pg8::gemm_phase<pg8::EpiResid, true, 3>(lds, S, E, prof_acc); GRID_BAR(); }
            } else {
                if (PH(2)) { PHASE_VARS(); ShLruIn S{(const char*)hb, (const char*)(ws + WS_WIN) + (size_t)j * 4096 * D * 2, G, bx};
                    pg8::EpiLruIn E{(bf16_t*)(ws + WS_GG), (bf16_t*)(ws + WS_XR), part, (LAS float*)(lds + EPI_TBL_OFF)};
                    pg8::gemm_phase<pg8::EpiLruIn, true, 4>(lds, S, E, prof_acc); GRID_BAR(); }
                if (PH(3)) for (int rep = 0; rep < REP_THIN; ++rep) { PHASE_VARS(); unsigned long long pt_ = 0; if constexpr (PROF_TAG == 130) pt_ = PROF_NOW(); const bf16_t* xr = (const bf16_t*)(ws + WS_XR); bf16_t* xcb = (bf16_t*)(ws + WS_XCB);
                    const float* cw = args.in[10] + (size_t)j * 4 * D + 4 * tid; const f32x4 w0 = *(const f32x4*)cw, w1 = *(const f32x4*)(cw + D), w2 = *(const f32x4*)(cw + 2 * D), w3 = *(const f32x4*)(cw + 3 * D);
                    const f32x4 cb = *(const f32x4*)(args.in[11] + (size_t)j * D + 4 * tid);
                    for (int blk = bx; blk < M / 64; blk += G) { const int t0 = blk * 64, seq0 = (t0 / SEQ) * SEQ; const bf16_t* xp = xr + 4 * tid; const f32x4 z = (f32x4){0.f, 0.f, 0.f, 0.f};
                        f32x4 x0 = z, x1 = z, x2 = z; if (t0 > seq0) { x0 = bf16x4_to_f32(*(const u32x2*)(xp + (size_t)(t0 - 3) * D)); x1 = bf16x4_to_f32(*(const u32x2*)(xp + (size_t)(t0 - 2) * D)); x2 = bf16x4_to_f32(*(const u32x2*)(xp + (size_t)(t0 - 1) * D)); }
                        u32x2 xb[2][16];
#define CONV_LOAD(b) do { _Pragma("unroll") for (int i = 0; i < 16; ++i) xb[(b) & 1][i] = *(const u32x2*)(xp + (size_t)(t0 + 16 * (b) + i) * D); } while (0)
                        CONV_LOAD(0);
#pragma unroll
                        for (int b = 0; b < 4; ++b) { if (b + 1 < 4) CONV_LOAD(b + 1);
                            asm volatile("" ::: "memory");
#pragma unroll
                            for (int i = 0; i < 16; ++i) { const int t = t0 + 16 * b + i; const f32x4 x3 = bf16x4_to_f32(xb[b & 1][i]); const f32x4 o = cb + x0 * w0 + x1 * w1 + x2 * w2 + x3 * w3;
                                u32x2 pk; pk.x = cvt_pk_bf16(o[0], o[1]); pk.y = cvt_pk_bf16(o[2], o[3]); *(u32x2*)(xcb + (size_t)t * D + 4 * tid) = pk;
                                x0 = x1; x1 = x2; x2 = x3; }
                            asm volatile("" ::: "memory"); }
#undef CONV_LOAD
                    }
                    GRID_BAR(); if constexpr (PROF_TAG == 130) prof_acc += PROF_NOW() - pt_; }
                if (PH(4)) { PHASE_VARS(); ShGates S{(const char*)(ws + WS_XCB), (const char*)(ws + WS_WGATE) + (size_t)j * 4096 * 256 * 2, G, bx};
                    pg8::EpiGates E{(bf16_t*)(ws + WS_LA), (bf16_t*)(ws + WS_BT), (const bf16_t*)(ws + WS_XCB), args.in[13] + (size_t)j * D, args.in[15] + (size_t)j * D, (const float*)(ws + WS_SP) + (size_t)j * D};
                    pg8::gemm_phase<pg8::EpiGates, true, 5>(lds, S, E, prof_acc); GRID_BAR(); }
#define EXP2_4(v) ((f32x4){__builtin_amdgcn_exp2f((v)[0]), __builtin_amdgcn_exp2f((v)[1]), __builtin_amdgcn_exp2f((v)[2]), __builtin_amdgcn_exp2f((v)[3])})
                if (PH(5)) for (int rep = 0; rep < REP_THIN; ++rep) { PHASE_VARS(); unsigned long long pt_ = 0; if constexpr (PROF_TAG == 140) pt_ = PROF_NOW(); const bf16_t* lav = (const bf16_t*)(ws + WS_LA) + 4 * tid; const bf16_t* bv = (const bf16_t*)(ws + WS_BT) + 4 * tid; float* chA = (float*)(ws + WS_CHA); float* chB = (float*)(ws + WS_CHB);
                    for (int blk = bx; blk < M / 64; blk += G) { const int t0 = blk * 64; f32x4 Ls = (f32x4){0.f, 0.f, 0.f, 0.f}, Hs = (f32x4){0.f, 0.f, 0.f, 0.f};
                        u32x2 lb[2][8], bb[2][8];
#define SC1_LOAD(b) do { _Pragma("unroll") for (int i = 0; i < 8; ++i) { const size_t o_ = (size_t)(t0 + 8 * (b) + i) * D; lb[(b) & 1][i] = *(const u32x2*)(lav + o_); bb[(b) & 1][i] = *(const u32x2*)(bv + o_); } } while (0)
                        SC1_LOAD(0);
#pragma unroll
                        for (int b = 0; b < 8; ++b) { if (b + 1 < 8) SC1_LOAD(b + 1);
                            asm volatile("" ::: "memory");
#pragma unroll
                            for (int i = 0; i < 8; ++i) { const f32x4 l4 = bf16x4_to_f32(lb[b & 1][i]), b4 = bf16x4_to_f32(bb[b & 1][i]); const f32x4 a4 = EXP2_4(l4); Hs = a4 * Hs + b4; Ls = Ls + l4; } }
#undef SC1_LOAD
                        *(f32x4*)(chA + (size_t)blk * D + 4 * tid) = EXP2_4(Ls); *(f32x4*)(chB + (size_t)blk * D + 4 * tid) = Hs; }
                    GRID_BAR(); if constexpr (PROF_TAG == 140) prof_acc += PROF_NOW() - pt_; }
                if (PH(6)) for (int rep = 0; rep < REP_THIN; ++rep) { PHASE_VARS(); unsigned long long pt_ = 0; if constexpr (PROF_TAG == 150) pt_ = PROF_NOW(); const bf16_t* lav = (const bf16_t*)(ws + WS_LA) + 4 * tid; const bf16_t* bv = (const bf16_t*)(ws + WS_BT) + 4 * tid;
                    const float* chA = (const float*)(ws + WS_CHA) + 4 * tid; const float* chB = (const float*)(ws + WS_CHB) + 4 * tid; const bf16_t* gg = (const bf16_t*)(ws + WS_GG) + 4 * tid; bf16_t* yb = (bf16_t*)(ws + WS_XCB) + 4 * tid;
                    for (int blk = bx; blk < M / 64; blk += G) { const int t0 = blk * 64, c0 = (blk / 64) * 64; f32x4 Hs = (f32x4){0.f, 0.f, 0.f, 0.f};
                        u32x2 lb[2][8], bb[2][8], gb[2][8];
#define SC2_LOAD(b) do { _Pragma("unroll") for (int i = 0; i < 8; ++i) { const size_t o_ = (size_t)(t0 + 8 * (b) + i) * D; lb[(b) & 1][i] = *(const u32x2*)(lav + o_); bb[(b) & 1][i] = *(const u32x2*)(bv + o_); gb[(b) & 1][i] = *(const u32x2*)(gg + o_); } } while (0)
                        SC2_LOAD(0);
                        int c = c0;
                        for (; c + 8 <= blk; c += 8) { f32x4 ca[8], cb8[8];
#pragma unroll
                            for (int i = 0; i < 8; ++i) { ca[i] = *(const f32x4*)(chA + (size_t)(c + i) * D); cb8[i] = *(const f32x4*)(chB + (size_t)(c + i) * D); }
#pragma unroll
                            for (int i = 0; i < 8; ++i) Hs = ca[i] * Hs + cb8[i]; }
                        for (; c < blk; ++c) { const f32x4 a4 = *(const f32x4*)(chA + (size_t)c * D), b4 = *(const f32x4*)(chB + (size_t)c * D); Hs = a4 * Hs + b4; }
#pragma unroll
                        for (int b = 0; b < 8; ++b) { if (b + 1 < 8) SC2_LOAD(b + 1);
                            asm volatile("" ::: "memory");
#pragma unroll
                            for (int i = 0; i < 8; ++i) { const int t = t0 + 8 * b + i; const f32x4 l4 = bf16x4_to_f32(lb[b & 1][i]), b4 = bf16x4_to_f32(bb[b & 1][i]), g4 = bf16x4_to_f32(gb[b & 1][i]); const f32x4 a4 = EXP2_4(l4); Hs = a4 * Hs + b4;
                                u32x2 pk; pk.x = cvt_pk_bf16(Hs[0] * g4[0], Hs[1] * g4[1]); pk.y = cvt_pk_bf16(Hs[2] * g4[2], Hs[3] * g4[3]); *(u32x2*)(yb + (size_t)t * D) = pk; }
                            asm volatile("" ::: "memory"); }
#undef SC2_LOAD
                    }
                    GRID_BAR(); if constexpr (PROF_TAG == 150) prof_acc += PROF_NOW() - pt_; }
#undef EXP2_4
                if (PH(7)) { PHASE_VARS(); ShDD S{(const char*)(ws + WS_XCB), (const char*)(ws + WS_WOUT) + (size_t)j * D * D * 2, G, bx};
                    pg8::EpiResid E{hb, part, 1.0f};
                    pg8::gemm_phase<pg8::EpiResid, true, 6>(lds, S, E, prof_acc); GRID_BAR(); }
            }
            if (PH(8)) { PHASE_VARS(); ShScore S{(const char*)hb, (const char*)(ws + WS_GALL) + (size_t)L * 4096 * D * 2, G, bx};
                pg8::EpiSoftmax E{(bf16_t*)(ws + WS_P), part};
                pg8::gemm_phase<pg8::EpiSoftmax, false, 7>(lds, S, E, prof_acc); GRID_BAR(); }
            if (PH(9)) for (int rep = 0; rep < REP_RES2K; ++rep) { PHASE_VARS(); ShAO S{(const char*)(ws + WS_P), (const char*)(ws + WS_HALL) + (size_t)L * D * 4096 * 2, G, bx};
                pg8::EpiResid E{hb, part, 1.0f};
                pg8::gemm_phase<pg8::EpiResid, true, 8>(lds, S, E, prof_acc); GRID_BAR(); }
        }
    }
    if (do_fin) { unsigned long long pt_ = 0; if constexpr (PROF_TAG == 160) pt_ = PROF_NOW(); PHASE_VARS(); const float* g = args.in[24]; const int lane = tid & 63, gw = bx * 8 + (tid >> 6), NGW = G * 8;
        for (int row = gw; row < M; row += NGW) { const u32x2* br = (const u32x2*)(hb + (size_t)row * D) + lane; f32x4* orow = (f32x4*)(h + (size_t)row * D) + lane; f32x4 v[8]; float ss = 0.f;
#pragma unroll
            for (int jj = 0; jj < 8; ++jj) { v[jj] = f16x4_to_f32(br[64 * jj]);
                ss += (v[jj][0] * v[jj][0] + v[jj][1] * v[jj][1]) + (v[jj][2] * v[jj][2] + v[jj][3] * v[jj][3]); }
            const float rs = rsqrtf(wave_sum(ss) * (1.0f / 2048.0f) + EPS);
#pragma unroll
            for (int jj = 0; jj < 8; ++jj) { const f32x4 gv = *((const f32x4*)g + lane + 64 * jj); orow[64 * jj] = v[jj] * rs * gv; } }
        if constexpr (PROF_TAG == 160) { VM_WAIT(); prof_acc += PROF_NOW() - pt_; } }
    if constexpr (PROF_TAG != 0) { const unsigned long long t0 = PROF_NOW(); while (PROF_NOW() - t0 < prof_acc) __builtin_amdgcn_s_sleep(4); }
}

extern "C" void kernel_launch(void* const* d_in, const int* in_sizes, int n_in, void* d_out, int out_size, void* d_ws, size_t ws_size, hipStream_t stream) {
    static int grid = 0;
    if (grid == 0) {
        if (n_in != 25 || in_sizes[0] != M * D || out_size != M * D || ws_size < WS_END) { fprintf(stderr, "kernel_launch: unexpected shapes (n_in %d, in0 %d, out %d, ws %zu, need %zu); nothing launched\n", n_in, n_in > 0 ? in_sizes[0] : -1, out_size, ws_size, (size_t)WS_END); grid = -1; return; }
        int dev = 0, cus = 0, per_cu = 0;
        if (hipGetDevice(&dev) != hipSuccess || hipDeviceGetAttribute(&cus, hipDeviceAttributeMultiprocessorCount, dev) != hipSuccess) { fprintf(stderr, "kernel_launch: device query failed\n"); grid = -1; return; }
        if (hipFuncSetAttribute((const void*)mk_fwd, hipFuncAttributeMaxDynamicSharedMemorySize, LDS_BYTES) != hipSuccess) { fprintf(stderr, "kernel_launch: hipFuncSetAttribute failed\n"); grid = -1; return; }
        if (hipOccupancyMaxActiveBlocksPerMultiprocessor(&per_cu, (const void*)mk_fwd, 512, LDS_BYTES) != hipSuccess || per_cu < 1) fprintf(stderr, "kernel_launch: occupancy query says %d\n", per_cu);
        (void)hipGetLastError();
        grid = cus;
        if (grid != 256) { fprintf(stderr, "kernel_launch: built for 256 CUs, found %d; nothing launched\n", cus); grid = -1; return; }
    }
    if (grid < 0) return;
    Args a{};
    for (int i = 0; i < 25; ++i) a.in[i] = (const float*)d_in[i];
    a.out = (float*)d_out; a.ws = (unsigned char*)d_ws;
#if MK_SINGLE
    if (hipMemsetAsync((char*)d_ws + WS_CTL, 0, CTL_ZERO_BYTES, stream) != hipSuccess) { fprintf(stderr, "kernel_launch: memset failed\n"); return; }
    a.step = 0; a.phase = 0;
    hipLaunchKernelGGL(mk_fwd, dim3(grid), dim3(512), LDS_BYTES, stream, a);
#else
    auto launch = [&](int s, int p) { a.step = s; a.phase = p; hipLaunchKernelGGL(mk_fwd, dim3(grid), dim3(512), LDS_BYTES, stream, a); };
    launch(-1, 0); launch(-1, 1); launch(-1, 2);
    for (int s = 0; s < 8; ++s) { launch(s, 0); launch(s, 1);
        if ((s & 1) == 0) { const int L = s >> 1;
            if ((L & 1) == 0) { launch(s, 2); launch(s, 3); } else { for (int p = 2; p <= 7; ++p) launch(s, p); }
            for (int p = 8; p <= 9; ++p) launch(s, p); } }
    launch(8, 0);
#endif
    const hipError_t le = hipPeekAtLastError();
    if (le != hipSuccess) fprintf(stderr, "kernel_launch: launch failed: %s\n", hipGetErrorName(le));
}
```

```cpp
#include <hip/hip_runtime.h>
#include <cstdio>
#include <cstdint>

#ifndef MK_SINGLE
#define MK_SINGLE 1
#endif

#ifndef PROF_TAG
#define PROF_TAG 0
#endif
#define PROF_NOW() __builtin_amdgcn_s_memrealtime()
#ifndef DOWN_WGM
#define DOWN_WGM 4
#endif
#ifndef DOWN_KREV
#define DOWN_KREV true
#endif
#ifndef REP_PRO
#define REP_PRO 1
#endif
#ifndef REP_GU
#define REP_GU 1
#endif
#ifndef REP_DOWN
#define REP_DOWN 1
#endif
#ifndef REP_THIN
#define REP_THIN 1
#endif
#ifndef STAGGER_TICKS
#define STAGGER_TICKS 0
#endif
#ifndef STAGGER_GROUPS
#define STAGGER_GROUPS 2
#endif
#ifndef STAGGER_GU_TICKS
#define STAGGER_GU_TICKS 0
#endif
#ifndef STAGGER_GU_GROUPS
#define STAGGER_GU_GROUPS 4
#endif
#ifndef REP_RES2K
#define REP_RES2K 1
#endif
#define LAS __attribute__((address_space(3)))
#define GAS __attribute__((address_space(1)))
typedef unsigned short bf16_t;
typedef short bf16x8 __attribute__((ext_vector_type(8)));
typedef float f32x4 __attribute__((ext_vector_type(4)));
typedef float f32x2 __attribute__((ext_vector_type(2)));
typedef unsigned u32x4 __attribute__((ext_vector_type(4)));
typedef unsigned u32x2 __attribute__((ext_vector_type(2)));
typedef GAS unsigned gu32;
#define LDS_WAIT() asm volatile("s_waitcnt lgkmcnt(0)" ::: "memory")
#define VM_WAIT() asm volatile("s_waitcnt vmcnt(0)" ::: "memory")

__device__ __forceinline__ unsigned cvt_pk_bf16(float lo, float hi) { unsigned r; asm volatile("v_cvt_pk_bf16_f32 %0, %1, %2" : "=v"(r) : "v"(lo), "v"(hi)); return r; }
typedef _Float16 f16x2 __attribute__((ext_vector_type(2)));
typedef _Float16 f16x8 __attribute__((ext_vector_type(8)));
__device__ __forceinline__ unsigned cvt_pk_f16(float lo, float hi) { const f16x2 v = {(_Float16)lo, (_Float16)hi}; return __builtin_bit_cast(unsigned, v); }
#ifndef H_TRIM
#define H_TRIM 2
#endif
__device__ __forceinline__ unsigned cvt_pk_h(float lo, float hi) { const unsigned w = cvt_pk_f16(lo, hi);
    if constexpr (H_TRIM > 0) { constexpr unsigned almost_half = ((1u << (H_TRIM - 1)) - 1u) * 0x00010001u, mask = ~(((1u << H_TRIM) - 1u) * 0x00010001u);
        return (w + almost_half + ((w >> H_TRIM) & 0x00010001u)) & mask; } else return w; }
template <bool F16> __device__ __forceinline__ unsigned cvt_pk16(float lo, float hi) { const unsigned b = cvt_pk_bf16(lo, hi); if constexpr (F16) return cvt_pk_f16(__uint_as_float(b << 16), __uint_as_float(b & 0xffff0000u)); else return b; }
__device__ __forceinline__ f32x4 f16x4_to_f32(u32x2 k) { const unsigned ka = k.x, kb = k.y; const f16x2 a = __builtin_bit_cast(f16x2, ka); const f16x2 b = __builtin_bit_cast(f16x2, kb);
    return (f32x4){(float)a.x, (float)a.y, (float)b.x, (float)b.y}; }
__device__ __forceinline__ f32x4 bf16x4_to_f32(u32x2 k) { return (f32x4){__uint_as_float(k.x << 16), __uint_as_float(k.x & 0xffff0000u), __uint_as_float(k.y << 16), __uint_as_float(k.y & 0xffff0000u)}; }
__device__ __forceinline__ float wave_sum(float v) {
#pragma unroll
    for (int o = 1; o < 64; o <<= 1) v += __shfl_xor(v, o);
    return v;
}
__device__ __forceinline__ float fast_sigmoid(float x) { return __builtin_amdgcn_rcpf(1.0f + __builtin_amdgcn_exp2f(-1.44269504089f * x)); }

constexpr int BATCH = 4, SEQ = 4096, D = 2048, DEPTH = 4, FF = 5632, MEML = 256, NH = 4, HD = 512, LH = 16;
constexpr int M = BATCH * SEQ;
constexpr int MM = BATCH * MEML;
constexpr float EPS = 1e-6f;

namespace pg8 {
constexpr int BM = 256, BK = 64, HALF = 128, HTB = HALF * BK * 2, STAGE_BYTES = 8 * HTB, NXCD = 8;
__host__ __device__ __forceinline__ int lds_byte(int r, int c) { const int st = (r >> 4) * 2 + (c >> 5), rr = r & 15, cc = c & 31, ob = rr * 64 + cc * 2; return st * 1024 + (ob ^ (((ob >> 9) & 1) << 5)); }
__host__ __device__ __forceinline__ void stage_rc(int b, int& R, int& C) { const int st = b / 1024, sb = b % 1024, swz = sb ^ (((sb >> 9) & 1) << 5); R = (st >> 1) * 16 + swz / 64; C = (st & 1) * 32 + (swz % 64) / 2; }
__host__ __device__ __forceinline__ int perm32(int rho) { const int n = rho >> 4, i = rho & 15; return 8 * (i >> 2) + 4 * n + (i & 3); }

struct Unit { int pm, pn; const char* a; const char* b; };

template <int nM, int nN, int WGM = 8> __device__ __forceinline__ bool unit_order(int i, int G, int c, int& pm, int& pn) {
    constexpr int nwg = nM * nN;
    const int L = i * G + c; if (L >= nwg) return false;
    int wgid = L; { constexpr int q = nwg / NXCD, r = nwg % NXCD; const int xcd = wgid % NXCD, off = wgid / NXCD; wgid = (xcd < r ? xcd * (q + 1) : r * (q + 1) + (xcd - r) * q) + off; }
    constexpr int nig = WGM * nN; const int gid = wgid / nig, fm = gid * WGM, gsz = (nM - fm) < WGM ? (nM - fm) : WGM;
    pm = fm + ((wgid % nig) % gsz); pn = (wgid % nig) / gsz; return true;
}
template <int MR, int NC, int K_, int LDA, int LDB, int APM, int APN, int ASH, int BPN, int BPM, int BSH, bool KREV_ = false, bool F16_ = false, int WGM_ = 8>
struct Sched {
    static constexpr int K = K_, lda = LDA, ldb = LDB; static constexpr bool KREV = KREV_, F16 = F16_;
    const char* A; const char* B; int G, c;
    __device__ __forceinline__ bool next(int i, Unit& u) const {
        if (!unit_order<MR / BM, NC / BM, WGM_>(i, G, c, u.pm, u.pn)) return false;
        u.a = A + (size_t)u.pm * APM + (size_t)(u.pn >> ASH) * APN + (KREV ? (K - BK) * 2 : 0); u.b = B + (size_t)u.pn * BPN + (size_t)(u.pm >> BSH) * BPM + (KREV ? (K - BK) * 2 : 0); return true;
    }
};
struct SchedG {
    static constexpr int K = 512, lda = 16384, ldb = 2048; static constexpr bool KREV = false, F16 = false;
    const char* KV; const char* WQN; int G, c;
    __device__ __forceinline__ bool next(int i, Unit& u) const {
        if (!unit_order<64, 8>(i, G, c, u.pm, u.pn)) return false;
        const int L = u.pm >> 4, b = (u.pm >> 2) & 3, h = u.pm & 3;
        u.a = KV + ((size_t)(b * 256) * 16384 + L * 2048 + h * 512) * 2; u.b = WQN + ((size_t)L * 2048 * 2048 + (size_t)u.pn * 256 * 2048 + h * 512) * 2; return true;
    }
};
struct SchedH {
    static constexpr int K = 512, lda = 2048, ldb = 16384; static constexpr bool KREV = false, F16 = false;
    const char* WOT; const char* KV; int G, c;
    __device__ __forceinline__ bool next(int i, Unit& u) const {
        if (!unit_order<32, 16>(i, G, c, u.pm, u.pn)) return false;
        const int L = u.pm >> 3, b = u.pn >> 2, h = u.pn & 3;
        u.a = WOT + ((size_t)u.pm * 256 * 2048 + h * 512) * 2; u.b = KV + ((size_t)(b * 256) * 16384 + 8192 + L * 2048 + h * 512) * 2; return true;
    }
};

__device__ __forceinline__ float row_rstd(const float* part, int row, int fq) {
    const f32x4* p = (const f32x4*)(part + (size_t)row * 32 + fq * 8);
    const f32x4 a = p[0], b = p[1];
    float s = ((a.x + a.y) + (a.z + a.w)) + ((b.x + b.y) + (b.z + b.w));
    s += __shfl_xor(s, 16); s += __shfl_xor(s, 32);
    return rsqrtf(s * (1.0f / 2048.0f) + EPS);
}

__device__ __forceinline__ void rstd_table(LAS float* tbl, const float* part, int pm, int tid) {
    if (tid < 256) { const f32x4* p = (const f32x4*)(part + (size_t)(pm * BM + tid) * 32); float sm = 0.f;
#pragma unroll
        for (int q = 0; q < 8; ++q) { const f32x4 a = p[q]; sm += (a[0] + a[1]) + (a[2] + a[3]); }
        tbl[tid] = rsqrtf(sm * (1.0f / 2048.0f) + EPS); }
    if (tid == 0) ((LAS int*)tbl)[256] = pm;
}
#define EPI_NO_PREPARE __device__ __forceinline__ void prepare(const Unit&, int) const {}
struct EpiSwiGLU {
    static constexpr bool PERM = true, AFTER_DRAIN = false, IS_RESID = false, IS_GU = true;
    bf16_t* O; const float* part; LAS float* tbl;
    __device__ __forceinline__ void prepare(const Unit& u, int tid) const { rstd_table(tbl, part, u.pm, tid); }
    __device__ __forceinline__ void operator()(f32x4 (&acc)[2][2][4][2], const Unit& u, int wr, int wc, int fr, int fq) const {
        const int row0 = u.pm * BM + wr * 64 + fr, col0 = u.pn * HALF + wc * 32 + 8 * fq;
        const bool tb = __builtin_amdgcn_readfirstlane(((const LAS int*)tbl)[256]) == u.pm;
#pragma unroll
        for (int ai = 0; ai < 2; ++ai)
#pragma unroll
            for (int m = 0; m < 4; ++m) { const int row = row0 + ai * HALF + m * 16; const float rs = tb ? tbl[ai * HALF + wr * 64 + m * 16 + fr] : row_rstd(part, row, fq);
                const f32x2 rsl = (f32x2){-1.44269504089f * rs, -1.44269504089f * rs}, rs2 = (f32x2){rs * rs, rs * rs}; f32x2 o[4];
#pragma unroll
                for (int n = 0; n < 2; ++n)
#pragma unroll
                    for (int jp = 0; jp < 2; ++jp) { const f32x2 ag = (f32x2){acc[ai][0][m][n][2 * jp], acc[ai][0][m][n][2 * jp + 1]}, au = (f32x2){acc[ai][1][m][n][2 * jp], acc[ai][1][m][n][2 * jp + 1]};
                        const f32x2 t = ag * rsl; f32x2 d = (f32x2){__builtin_amdgcn_exp2f(t.x), __builtin_amdgcn_exp2f(t.y)}; d = d + 1.0f;
                        const f32x2 r = (f32x2){__builtin_amdgcn_rcpf(d.x), __builtin_amdgcn_rcpf(d.y)}; o[n * 2 + jp] = (ag * au) * (r * rs2); }
                u32x4 w; w.x = cvt_pk_bf16(o[0].x, o[0].y); w.y = cvt_pk_bf16(o[1].x, o[1].y); w.z = cvt_pk_bf16(o[2].x, o[2].y); w.w = cvt_pk_bf16(o[3].x, o[3].y);
                *(u32x4*)(O + (size_t)row * FF + col0) = w; }
    }
};
struct EpiResid {
    EPI_NO_PREPARE
    static constexpr bool PERM = true, AFTER_DRAIN = false, IS_RESID = true, IS_GU = false;
    bf16_t* hb; float* part; float alpha;
    __device__ __forceinline__ void load_half(u32x4 (&xk)[4][2], int ai, int row0, int col0) const {
#pragma unroll
        for (int m = 0; m < 4; ++m) { const bf16_t* bp = hb + (size_t)(row0 + ai * HALF + m * 16) * D + col0; xk[m][0] = *(const u32x4*)bp; xk[m][1] = *(const u32x4*)(bp + HALF); }
    }
    __device__ __forceinline__ void fold_half(f32x4 (&acc)[2][2][4][2], const u32x4 (&xk)[4][2], int ai) const {
#pragma unroll
        for (int m = 0; m < 4; ++m)
#pragma unroll
            for (int bj = 0; bj < 2; ++bj) { const u32x4 k = xk[m][bj];
                const f32x4 x0 = f16x4_to_f32((u32x2){k.x, k.y}), x1 = f16x4_to_f32((u32x2){k.z, k.w});
                acc[ai][bj][m][0] = x0 + acc[ai][bj][m][0] * alpha; acc[ai][bj][m][1] = x1 + acc[ai][bj][m][1] * alpha; }
    }
    __device__ __forceinline__ void store_half(const f32x4 (&acc)[2][2][4][2], int ai, int row0, int col0, int slot, int fq) const {
#pragma unroll
        for (int m = 0; m < 4; ++m) { const int row = row0 + ai * HALF + m * 16; bf16_t* bp = hb + (size_t)row * D + col0; float ss = 0.f;
#pragma unroll
            for (int bj = 0; bj < 2; ++bj) { const f32x4 x0 = acc[ai][bj][m][0], x1 = acc[ai][bj][m][1];
                u32x4 w; w.x = cvt_pk_h(x0[0], x0[1]); w.y = cvt_pk_h(x0[2], x0[3]); w.z = cvt_pk_h(x1[0], x1[1]); w.w = cvt_pk_h(x1[2], x1[3]);
                *(u32x4*)(bp + bj * HALF) = w;
                ss += ((x0[0] * x0[0] + x0[1] * x0[1]) + (x0[2] * x0[2] + x0[3] * x0[3])) + ((x1[0] * x1[0] + x1[1] * x1[1]) + (x1[2] * x1[2] + x1[3] * x1[3])); }
            ss += __shfl_xor(ss, 16); ss += __shfl_xor(ss, 32);
            if (fq == 0) part[(size_t)row * 32 + slot] = ss; }
    }
    __device__ __forceinline__ void operator()(f32x4 (&acc)[2][2][4][2], const Unit& u, int wr, int wc, int fr, int fq) const {
        const int row0 = u.pm * BM + wr * 64 + fr, col0 = u.pn * BM + wc * 32 + 8 * fq, slot = u.pn * 4 + wc;
        u32x4 xk[4][2], xk1[4][2];
        load_half(xk, 0, row0, col0);
#pragma unroll
        for (int m = 0; m < 3; ++m) { const bf16_t* bp = hb + (size_t)(row0 + HALF + m * 16) * D + col0; xk1[m][0] = *(const u32x4*)bp; xk1[m][1] = *(const u32x4*)(bp + HALF); }
        asm volatile("" ::: "memory");
        fold_half(acc, xk, 0); asm volatile("" ::: "memory");
        { const bf16_t* bp = hb + (size_t)(row0 + HALF + 3 * 16) * D + col0; xk1[3][0] = *(const u32x4*)bp; xk1[3][1] = *(const u32x4*)(bp + HALF); }
        asm volatile("" ::: "memory");
        store_half(acc, 0, row0, col0, slot, fq); asm volatile("" ::: "memory");
        fold_half(acc, xk1, 1);
        store_half(acc, 1, row0, col0, slot, fq);
    }
};
struct EpiRowScale {
    EPI_NO_PREPARE
    static constexpr bool PERM = true, AFTER_DRAIN = false, IS_RESID = false, IS_GU = false;
    bf16_t* O; int ldo; const float* part;
    __device__ __forceinline__ void operator()(f32x4 (&acc)[2][2][4][2], const Unit& u, int wr, int wc, int fr, int fq) const {
        const int row0 = u.pm * BM + wr * 64 + fr, col0 = u.pn * BM + wc * 32 + 8 * fq;
#pragma unroll
        for (int ai = 0; ai < 2; ++ai)
#pragma unroll
            for (int m = 0; m < 4; ++m) { const int row = row0 + ai * HALF + m * 16; const float rs = row_rstd(part, row, fq); bf16_t* rp = O + (size_t)row * ldo + col0;
#pragma unroll
                for (int bj = 0; bj < 2; ++bj) { const f32x4 v0 = acc[ai][bj][m][0] * rs, v1 = acc[ai][bj][m][1] * rs;
                    u32x4 w; w.x = cvt_pk_bf16(v0[0], v0[1]); w.y = cvt_pk_bf16(v0[2], v0[3]); w.z = cvt_pk_bf16(v1[0], v1[1]); w.w = cvt_pk_bf16(v1[2], v1[3]);
                    *(u32x4*)(rp + bj * HALF) = w; } }
    }
};
template <bool F16OUT> struct EpiPlain {
    EPI_NO_PREPARE
    static constexpr bool PERM = true, AFTER_DRAIN = false, IS_RESID = false, IS_GU = false;
    bf16_t* O; int ldo;
    __device__ __forceinline__ void operator()(f32x4 (&acc)[2][2][4][2], const Unit& u, int wr, int wc, int fr, int fq) const {
        const int row0 = u.pm * BM + wr * 64 + fr, col0 = u.pn * BM + wc * 32 + 8 * fq;
#pragma unroll
        for (int ai = 0; ai < 2; ++ai)
#pragma unroll
            for (int m = 0; m < 4; ++m) { bf16_t* rp = O + (size_t)(row0 + ai * HALF + m * 16) * ldo + col0;
#pragma unroll
                for (int bj = 0; bj < 2; ++bj) { const f32x4 v0 = acc[ai][bj][m][0], v1 = acc[ai][bj][m][1];
                    u32x4 w; w.x = cvt_pk16<F16OUT>(v0[0], v0[1]); w.y = cvt_pk16<F16OUT>(v0[2], v0[3]); w.z = cvt_pk16<F16OUT>(v1[0], v1[1]); w.w = cvt_pk16<F16OUT>(v1[2], v1[3]);
                    *(u32x4*)(rp + bj * HALF) = w; } }
    }
};
struct EpiLruIn {
    static constexpr bool PERM = true, AFTER_DRAIN = false, IS_RESID = false, IS_GU = false;
    bf16_t* gg; bf16_t* xr; const float* part; LAS float* tbl;
    __device__ __forceinline__ void prepare(const Unit& u, int tid) const { rstd_table(tbl, part, u.pm, tid); }
    __device__ __forceinline__ void operator()(f32x4 (&acc)[2][2][4][2], const Unit& u, int wr, int wc, int fr, int fq) const {
        const int row0 = u.pm * BM + wr * 64 + fr; const bool isg = u.pn < 8; const int col0 = (isg ? u.pn : u.pn - 8) * BM + wc * 32 + 8 * fq; bf16_t* O = isg ? gg : xr;
        const bool tb = __builtin_amdgcn_readfirstlane(((const LAS int*)tbl)[256]) == u.pm;
#pragma unroll
        for (int ai = 0; ai < 2; ++ai)
#pragma unroll
            for (int m = 0; m < 4; ++m) { const int row = row0 + ai * HALF + m * 16; const float rs = tb ? tbl[ai * HALF + wr * 64 + m * 16 + fr] : row_rstd(part, row, fq);
#pragma unroll
                for (int bj = 0; bj < 2; ++bj) { const f32x4 v0 = acc[ai][bj][m][0] * rs, v1 = acc[ai][bj][m][1] * rs; float o[8];
#pragma unroll
                    for (int j = 0; j < 8; ++j) { const float x = j < 4 ? v0[j] : v1[j - 4]; o[j] = isg ? x * fast_sigmoid(1.5957691216f * (x + 0.044715f * x * x * x)) : x; }
                    u32x4 w; w.x = cvt_pk_bf16(o[0], o[1]); w.y = cvt_pk_bf16(o[2], o[3]); w.z = cvt_pk_bf16(o[4], o[5]); w.w = cvt_pk_bf16(o[6], o[7]);
                    *(u32x4*)(O + (size_t)row * D + col0 + bj * HALF) = w; } }
    }
};
struct EpiGates {
    EPI_NO_PREPARE
    static constexpr bool PERM = true, AFTER_DRAIN = false, IS_RESID = false, IS_GU = false;
    bf16_t* LA; bf16_t* Bt; const bf16_t* xc; const float* ba; const float* bx; const float* sp8;
    __device__ __forceinline__ void operator()(f32x4 (&acc)[2][2][4][2], const Unit& u, int wr, int wc, int fr, int fq) const {
        const int row0 = u.pm * BM + wr * 64 + fr, c0 = u.pn * HALF + wc * 32 + 8 * fq;
        f32x4 bav[2], bxv[2], spv[2];
#pragma unroll
        for (int n = 0; n < 2; ++n) { bav[n] = *(const f32x4*)(ba + c0 + 4 * n); bxv[n] = *(const f32x4*)(bx + c0 + 4 * n); spv[n] = *(const f32x4*)(sp8 + c0 + 4 * n) * 1.44269504089f; }
        u32x4 xkv[8];
#pragma unroll
        for (int g = 0; g < 8; ++g) xkv[g] = *(const u32x4*)(xc + (size_t)(row0 + (g >> 2) * HALF + (g & 3) * 16) * D + c0);
        asm volatile("" ::: "memory");
#pragma unroll
        for (int ai = 0; ai < 2; ++ai)
#pragma unroll
            for (int m = 0; m < 4; ++m) { const int row = row0 + ai * HALF + m * 16; const u32x4 xk = xkv[ai * 4 + m]; float lo[8], bo[8];
#pragma unroll
                for (int n = 0; n < 2; ++n) { const unsigned k0 = n == 0 ? xk.x : xk.z, k1 = n == 0 ? xk.y : xk.w;
                    const f32x4 xv = (f32x4){__uint_as_float(k0 << 16), __uint_as_float(k0 & 0xffff0000u), __uint_as_float(k1 << 16), __uint_as_float(k1 & 0xffff0000u)};
#pragma unroll
                    for (int j = 0; j < 4; ++j) { const float r = fast_sigmoid(acc[ai][0][m][n][j] + bav[n][j]), ig = fast_sigmoid(acc[ai][1][m][n][j] + bxv[n][j]);
                        const float l2 = -r * spv[n][j];
                        const float l2r = __uint_as_float(cvt_pk_bf16(l2, l2) << 16);
                        const float t = 1.38629436112f * l2r;
                        const float ser = -t * (1.0f + 0.5f * t * (1.0f + (1.0f / 3.0f) * t * (1.0f + 0.25f * t * (1.0f + 0.2f * t * (1.0f + (1.0f / 6.0f) * t)))));
                        const float om = t > -0.3f ? ser : 1.0f - __builtin_amdgcn_exp2f(2.0f * l2r);
                        lo[n * 4 + j] = l2; bo[n * 4 + j] = sqrtf(om) * ig * xv[j]; } }
                u32x4 wl, wb; wl.x = cvt_pk_bf16(lo[0], lo[1]); wl.y = cvt_pk_bf16(lo[2], lo[3]); wl.z = cvt_pk_bf16(lo[4], lo[5]); wl.w = cvt_pk_bf16(lo[6], lo[7]);
                wb.x = cvt_pk_bf16(bo[0], bo[1]); wb.y = cvt_pk_bf16(bo[2], bo[3]); wb.z = cvt_pk_bf16(bo[4], bo[5]); wb.w = cvt_pk_bf16(bo[6], bo[7]);
                *(u32x4*)(LA + (size_t)row * D + c0) = wl; *(u32x4*)(Bt + (size_t)row * D + c0) = wb; }
    }
};
struct EpiSoftmax {
    EPI_NO_PREPARE
    static constexpr bool PERM = true, AFTER_DRAIN = true, IS_RESID = false, IS_GU = false;
    bf16_t* P; const float* part;
    __device__ __forceinline__ void fused(f32x4 (&acc)[2][2][4][2], const Unit& u, int wr, int wc, int fr, int fq, LAS unsigned char* lds, int wid, int lane) const {
        LAS float* X = (LAS float*)lds; LAS float* Y = (LAS float*)(lds + 4096);
#pragma unroll
        for (int ai = 0; ai < 2; ++ai)
#pragma unroll
            for (int m = 0; m < 4; ++m) { float mx = -3.0e38f; const float rs = row_rstd(part, u.pm * BM + ai * HALF + wr * 64 + m * 16 + fr, fq);
#pragma unroll
                for (int bj = 0; bj < 2; ++bj)
#pragma unroll
                    for (int n = 0; n < 2; ++n) { acc[ai][bj][m][n] = acc[ai][bj][m][n] * rs; const f32x4 x = acc[ai][bj][m][n]; mx = fmaxf(mx, fmaxf(fmaxf(x[0], x[1]), fmaxf(x[2], x[3]))); }
                mx = fmaxf(mx, __shfl_xor(mx, 16)); mx = fmaxf(mx, __shfl_xor(mx, 32));
                if (fq == 0) X[(ai * HALF + wr * 64 + m * 16 + fr) * 4 + wc] = mx; }
        LDS_WAIT(); __builtin_amdgcn_s_barrier(); asm volatile("" ::: "memory");
#pragma unroll
        for (int ai = 0; ai < 2; ++ai)
#pragma unroll
            for (int m = 0; m < 4; ++m) { const int r = ai * HALF + wr * 64 + m * 16 + fr; const f32x4 v = *(const LAS f32x4*)(X + r * 4);
                const float mx = fmaxf(fmaxf(v[0], v[1]), fmaxf(v[2], v[3])) * 1.44269504089f; float s = 0.f;
#pragma unroll
                for (int bj = 0; bj < 2; ++bj)
#pragma unroll
                    for (int n = 0; n < 2; ++n)
#pragma unroll
                        for (int j = 0; j < 4; ++j) { const float p = __builtin_amdgcn_exp2f(acc[ai][bj][m][n][j] * 1.44269504089f - mx); acc[ai][bj][m][n][j] = p; s += p; }
                s += __shfl_xor(s, 16); s += __shfl_xor(s, 32);
                if (fq == 0) Y[r * 4 + wc] = s; }
        LDS_WAIT(); __builtin_amdgcn_s_barrier(); asm volatile("" ::: "memory");
#pragma unroll
        for (int ai = 0; ai < 2; ++ai)
#pragma unroll
            for (int m = 0; m < 4; ++m) { const int r = ai * HALF + wr * 64 + m * 16 + fr; const f32x4 v = *(const LAS f32x4*)(Y + r * 4);
                const float inv = 1.0f / ((v[0] + v[1]) + (v[2] + v[3])); bf16_t* rp = P + (size_t)(u.pm * BM + r) * 1024 + u.pn * BM + wc * 32 + 8 * fq;
#pragma unroll
                for (int bj = 0; bj < 2; ++bj) { const f32x4 v0 = acc[ai][bj][m][0] * inv, v1 = acc[ai][bj][m][1] * inv;
                    u32x4 w; w.x = cvt_pk_bf16(v0[0], v0[1]); w.y = cvt_pk_bf16(v0[2], v0[3]); w.z = cvt_pk_bf16(v1[0], v1[1]); w.w = cvt_pk_bf16(v1[2], v1[3]);
                    *(u32x4*)(rp + bj * HALF) = w; } }
    }
};

template <bool F16> __device__ __forceinline__ f32x4 mma16(bf16x8 b, bf16x8 a, f32x4 c) {
    if constexpr (F16) return __builtin_amdgcn_mfma_f32_16x16x32_f16(__builtin_bit_cast(f16x8, b), __builtin_bit_cast(f16x8, a), c, 0, 0, 0);
    else return __builtin_amdgcn_mfma_f32_16x16x32_bf16(b, a, c, 0, 0, 0);
}
template <class Epi, bool ALIGN_EPI, int PID, class SchedT>
__device__ __forceinline__ void gemm_phase(LAS unsigned char* lds, const SchedT& S, const Epi& E, unsigned long long& pacc) {
    unsigned long long pt0 = 0, pt1 = 0; (void)pt0; (void)pt1;
    if constexpr (PROF_TAG == PID * 10 + 0) pt0 = PROF_NOW();
    { constexpr int ticks = Epi::IS_RESID ? STAGGER_TICKS : Epi::IS_GU ? STAGGER_GU_TICKS : 0;
      if constexpr (ticks > 0) { const unsigned grp = (blockIdx.x >> 3) & (Epi::IS_RESID ? (STAGGER_GROUPS - 1) : (STAGGER_GU_GROUPS - 1));
        if (grp) { const unsigned long long t0 = __builtin_amdgcn_s_memrealtime(), want = (unsigned long long)ticks * grp; while (__builtin_amdgcn_s_memrealtime() - t0 < want) __builtin_amdgcn_s_sleep(8); } } }
    int tid_ = threadIdx.x; asm volatile("" : "+v"(tid_));
    const int tid = tid_, wid = __builtin_amdgcn_readfirstlane(tid >> 6), lane = tid & 63, wr = wid >> 2, wc = wid & 3, fr = lane & 15, fq = lane >> 4;
    constexpr int K = SchedT::K, nt = K / BK;
    static_assert(K % 128 == 0 && K >= 256, "K multiple of 128, >= 256");
    unsigned voffA[2], voffB[2];
#pragma unroll
    for (int i = 0; i < 2; ++i) { int R, C; stage_rc(tid * 16 + i * 8192, R, C); const int Rb = Epi::PERM ? ((R & ~31) + perm32(R & 31)) : R;
        voffA[i] = (unsigned)(R * SchedT::lda + C) * 2u; voffB[i] = (unsigned)(Rb * SchedT::ldb + C) * 2u; }
    constexpr long kstep = SchedT::KREV ? -(long)(BK * 2) : (long)(BK * 2);
    constexpr size_t hstepA = (size_t)HALF * SchedT::lda * 2, hstepB = (size_t)HALF * SchedT::ldb * 2;
    const unsigned ldsw = (unsigned)wid * 1024u;
    const int aoff = lds_byte(wr * 64 + fr, fq * 8), boff = lds_byte(wc * 32 + fr, fq * 8);
#define PG8_SA(b, h) (((b) * 2 + (h)) * HTB)
#define PG8_SB(b, h) ((4 + (b) * 2 + (h)) * HTB)
#define PG8_STAGE(bufoff, gbase, voff) do { _Pragma("unroll") for (int _i = 0; _i < 2; ++_i) \
        __builtin_amdgcn_global_load_lds((const unsigned*)((const char*)(gbase) + (voff)[_i]), (LAS unsigned*)(lds + (bufoff) + ldsw + _i * 8192), 16, 0, 0); } while (0)
#define PG8_LDA(dst, b, h) do { _Pragma("unroll") for (int m = 0; m < 4; ++m) _Pragma("unroll") for (int k = 0; k < 2; ++k) dst[m][k] = *(const LAS bf16x8*)(lds + PG8_SA(b, h) + aoff + m * 2048 + k * 1024); } while (0)
#define PG8_LDB(dst, b, h) do { _Pragma("unroll") for (int n = 0; n < 2; ++n) _Pragma("unroll") for (int k = 0; k < 2; ++k) dst[n][k] = *(const LAS bf16x8*)(lds + PG8_SB(b, h) + boff + n * 2048 + k * 1024); } while (0)
#define PG8_MMA(ai, bj, At, Bt) do { __builtin_amdgcn_s_setprio(1); _Pragma("unroll") for (int m = 0; m < 4; ++m) _Pragma("unroll") for (int n = 0; n < 2; ++n) _Pragma("unroll") for (int k = 0; k < 2; ++k) \
        acc[ai][bj][m][n] = mma16<SchedT::F16>(Bt[n][k], At[m][k], acc[ai][bj][m][n]); __builtin_amdgcn_s_setprio(0); } while (0)
#define PG8_MMAZ(ai, bj, At, Bt) do { __builtin_amdgcn_s_setprio(1); _Pragma("unroll") for (int m = 0; m < 4; ++m) _Pragma("unroll") for (int n = 0; n < 2; ++n) \
        acc[ai][bj][m][n] = mma16<SchedT::F16>(Bt[n][0], At[m][0], (f32x4){0.f, 0.f, 0.f, 0.f}); \
        _Pragma("unroll") for (int m = 0; m < 4; ++m) _Pragma("unroll") for (int n = 0; n < 2; ++n) acc[ai][bj][m][n] = mma16<SchedT::F16>(Bt[n][1], At[m][1], acc[ai][bj][m][n]); __builtin_amdgcn_s_setprio(0); } while (0)
#define PG8_WAIT_V(n) asm volatile("s_waitcnt vmcnt(" #n ")" ::: "memory")
#define PG8_WAIT_L(n) asm volatile("s_waitcnt lgkmcnt(" #n ")" ::: "memory")
#define PG8_BAR __builtin_amdgcn_s_barrier()
#define PG8_SCHED __builtin_amdgcn_sched_barrier(0)
    Unit cur, nxt; int ui = 0;
    if (!S.next(0, cur)) return;
    E.prepare(cur, tid);
    f32x4 acc[2][2][4][2];
    bf16x8 At[4][2], B0[2][2], B1[2][2];
    const char* cA = cur.a; const char* cB = cur.b;
    PG8_STAGE(PG8_SB(0, 0), cB, voffB); PG8_STAGE(PG8_SB(0, 1), cB + hstepB, voffB); PG8_STAGE(PG8_SA(0, 0), cA, voffA); PG8_STAGE(PG8_SA(0, 1), cA + hstepA, voffA);
    if (wr == 1) PG8_BAR;
    PG8_WAIT_V(2); PG8_BAR;
    PG8_STAGE(PG8_SB(1, 0), cB + kstep, voffB); PG8_STAGE(PG8_SA(1, 0), cA + kstep, voffA); PG8_STAGE(PG8_SB(1, 1), cB + hstepB + kstep, voffB); PG8_STAGE(PG8_SA(1, 1), cA + hstepA + kstep, voffA);
    PG8_WAIT_V(8); PG8_BAR;
    for (;;) {
        const bool has_next = S.next(ui + 1, nxt);
        const char* nA = has_next ? nxt.a : cA; const char* nB = has_next ? nxt.b : cB;
        if constexpr (PROF_TAG == PID * 10 + 1) pt0 = PROF_NOW();
#define PG8_KITER(FIRST) \
              \
            PG8_LDB(B0, 0, 0); PG8_LDB(B1, 0, 1); PG8_SCHED; PG8_LDA(At, 0, 0); if constexpr (!(FIRST)) PG8_STAGE(PG8_SA(1, 1), a1 + hstepA, voffA); \
            PG8_WAIT_V(8); PG8_WAIT_L(0); PG8_BAR; if constexpr (FIRST) { PG8_MMAZ(0, 0, At, B0); PG8_MMAZ(0, 1, At, B1); } else { PG8_MMA(0, 0, At, B0); PG8_MMA(0, 1, At, B1); } PG8_BAR; PG8_SCHED; \
              \
            PG8_LDA(At, 0, 1); PG8_STAGE(PG8_SB(0, 0), b2, voffB); PG8_STAGE(PG8_SB(0, 1), b2 + hstepB, voffB); PG8_STAGE(PG8_SA(0, 0), a2, voffA); \
            PG8_WAIT_V(8); PG8_WAIT_L(0); PG8_BAR; if constexpr (FIRST) { PG8_MMAZ(1, 0, At, B0); PG8_MMAZ(1, 1, At, B1); } else { PG8_MMA(1, 0, At, B0); PG8_MMA(1, 1, At, B1); } PG8_BAR; PG8_SCHED; \
              \
            PG8_LDB(B0, 1, 0); PG8_LDB(B1, 1, 1); PG8_SCHED; PG8_LDA(At, 1, 0); PG8_STAGE(PG8_SA(0, 1), a2 + hstepA, voffA); \
            PG8_WAIT_V(8); PG8_WAIT_L(0); PG8_BAR; PG8_MMA(0, 0, At, B0); PG8_MMA(0, 1, At, B1); PG8_BAR; PG8_SCHED; \
              \
            PG8_LDA(At, 1, 1); PG8_STAGE(PG8_SB(1, 0), b3, voffB); PG8_STAGE(PG8_SB(1, 1), b3 + hstepB, voffB); PG8_STAGE(PG8_SA(1, 0), a3, voffA); \
            PG8_WAIT_V(8); PG8_WAIT_L(0); PG8_BAR; PG8_MMA(1, 0, At, B0); PG8_MMA(1, 1, At, B1); PG8_BAR; PG8_SCHED;
        int tp = 2; asm volatile("" : "+v"(tp)); tp = __builtin_amdgcn_readfirstlane(tp);
#pragma unroll 1
        for (int tq = 0; tq < tp; tq += 2) { asm volatile("" : "+v"(voffA[0]), "+v"(voffA[1]), "+v"(voffB[0]), "+v"(voffB[1]));
          const char* a1 = cA + kstep; (void)a1; const char* a2 = cA + 2 * kstep; const char* b2 = cB + 2 * kstep; const char* a3 = a2 + kstep; const char* b3 = b2 + kstep;
          PG8_KITER(true) }
#pragma unroll 1
        for (int t = 2; t < nt; t += 2) {
            asm volatile("" : "+v"(voffA[0]), "+v"(voffA[1]), "+v"(voffB[0]), "+v"(voffB[1]));
            const bool last = (t == nt - 2);
            if constexpr (PROF_TAG == PID * 10 + 5) { if (t == 2) pt0 = PROF_NOW(); }
            const char* a1 = cA + (long)(t + 1) * kstep;
            const char* a2 = last ? nA : cA + (long)(t + 2) * kstep; const char* b2 = last ? nB : cB + (long)(t + 2) * kstep;
            const char* a3 = a2 + kstep; const char* b3 = b2 + kstep;
            PG8_KITER(false)
            if constexpr (PROF_TAG == PID * 10 + 5) { if (t == 2) pacc += PROF_NOW() - pt0; }
        }
        if constexpr (PROF_TAG == PID * 10 + 1) pacc += PROF_NOW() - pt0;
        if constexpr (PROF_TAG == PID * 10 + 2) pt0 = PROF_NOW();
        if constexpr (ALIGN_EPI) { if (wr == 0) PG8_BAR; }
        if (has_next) PG8_STAGE(PG8_SA(1, 1), nA + kstep + hstepA, voffA);
        if constexpr (PROF_TAG == PID * 10 + 3) pt0 = PROF_NOW();
        if constexpr (!Epi::AFTER_DRAIN) { int te_ = threadIdx.x; asm volatile("" : "+v"(te_));
            const int fr_e = te_ & 15, fq_e = (te_ & 63) >> 4; E(acc, cur, wr, wc, fr_e, fq_e); }
        if constexpr (PROF_TAG == PID * 10 + 2 || PROF_TAG == PID * 10 + 3) pacc += PROF_NOW() - pt0;
        if (!has_next) break;
        cur = nxt; cA = nA; cB = nB; ++ui;
        if constexpr (ALIGN_EPI) { if (wr == 1) PG8_BAR; }
    }
    PG8_WAIT_V(0);
    if constexpr (!ALIGN_EPI) { if (wr == 0) PG8_BAR; }
    PG8_BAR;
    if constexpr (Epi::AFTER_DRAIN) { E.fused(acc, cur, wr, wc, fr, fq, lds, wid, lane); }
    if constexpr (PROF_TAG == PID * 10 + 0) pacc += PROF_NOW() - pt0;
#undef PG8_SA
#undef PG8_SB
#undef PG8_STAGE
#undef PG8_LDA
#undef PG8_LDB
#undef PG8_MMA
#undef PG8_WAIT_V
#undef PG8_WAIT_L
#undef PG8_BAR
#undef PG8_SCHED
}
}

constexpr size_t MiB = 1u << 20;
constexpr size_t WS_CTL = 0, CTL_ZERO_BYTES = 1 * MiB;
constexpr size_t WS_SP = 1 * MiB;
constexpr size_t WS_CHA = 2 * MiB, WS_CHB = 4 * MiB;
constexpr size_t WS_PART = 6 * MiB;
constexpr size_t WS_MB = 8 * MiB;
constexpr size_t WS_KV = 12 * MiB;
constexpr size_t WS_WGU = 48 * MiB;
constexpr size_t WS_WD = 400 * MiB;
constexpr size_t WS_WQN = 576 * MiB;
constexpr size_t WS_WK = 608 * MiB, WS_WV = 640 * MiB, WS_WO = 672 * MiB;
constexpr size_t WS_WIN = 704 * MiB;
constexpr size_t WS_WOUT = 736 * MiB;
constexpr size_t WS_WP = 752 * MiB;
constexpr size_t WS_WGATE = 756 * MiB;
constexpr size_t WS_HB = 760 * MiB;
constexpr size_t WS_ACT = 824 * MiB;
constexpr size_t WS_S = 1000 * MiB;
constexpr size_t WS_P = WS_S;
constexpr size_t WS_POOLED = WS_S;
constexpr size_t WS_GG = WS_S, WS_BT = WS_S + 64 * MiB, WS_XCB = WS_S + 192 * MiB;
constexpr size_t WS_XR = WS_ACT;
constexpr size_t WS_LA = WS_ACT + 64 * MiB;
constexpr size_t WS_GALL = WS_S + 256 * MiB;
constexpr size_t WS_HALL = WS_S + 320 * MiB;
constexpr size_t WS_END = WS_S + 384 * MiB;
constexpr int CW_BAR = 4096;
constexpr int LDS_BYTES = 147456, MISC_OFF = LDS_BYTES - 512, EPI_TBL_OFF = 131072;

#define XB_TMO      128
#define XB_XCNT(j)  (256  + 64 * (j))
#define XB_XSUB(j)  (1280 + 64 * (j))
#define XB_XGEN(j)  (2304 + 64 * (j))
#define XB_TOP      3328
#define XB_TOPGEN   3392
#define XCD_BAR_WORDS 3456
#define XB_SPIN_CAP (1u << 18)
__device__ __forceinline__ unsigned xb_ld(unsigned* p)              { return __hip_atomic_load(p, __ATOMIC_RELAXED, __HIP_MEMORY_SCOPE_AGENT); }
__device__ __forceinline__ unsigned xb_add(unsigned* p, unsigned v) { return __hip_atomic_fetch_add(p, v, __ATOMIC_RELAXED, __HIP_MEMORY_SCOPE_AGENT); }
__device__ __forceinline__ unsigned xb_xcc_id() { return (unsigned)__builtin_amdgcn_s_getreg((3 << 11) | 20) & 0xFu; }
#define XB_SPIN(cond, bar) do { unsigned _sp = 0; while (cond) { __builtin_amdgcn_s_sleep(1); \
    if ((++_sp & 255u) == 0u) { if (xb_ld(&(bar)[XB_TMO])) break; if (_sp > XB_SPIN_CAP) { atomicAdd(&(bar)[XB_TMO], 1u); break; } } } } while (0)
struct XcdBarrier { unsigned* bar; unsigned x; volatile LAS unsigned* st; };
__device__ __forceinline__ XcdBarrier xcd_barrier_post(unsigned* bar, volatile LAS unsigned* st) {
    XcdBarrier b; b.bar = bar; b.x = xb_xcc_id(); b.st = st;
    if (threadIdx.x == 0) (void)xb_add(&bar[XB_XCNT(b.x)], 1u);
    return b;
}
__device__ __forceinline__ void xcd_barrier_complete(unsigned* bar, unsigned x, unsigned& nloc, unsigned& nx) {
    const unsigned G = gridDim.x * gridDim.y * gridDim.z;
    unsigned sum, cnt, mine, sp = 0u;
    for (;;) {
        sum = 0u; cnt = 0u; mine = 0u;
#pragma unroll
        for (unsigned j = 0; j < 16; ++j) { const unsigned c = xb_ld(&bar[XB_XCNT(j)]); sum += c; cnt += (c > 0u) ? 1u : 0u; mine = (j == x) ? c : mine; }
        if (sum == G) break;
        __builtin_amdgcn_s_sleep(1);
        if ((++sp & 255u) == 0u) { if (xb_ld(&bar[XB_TMO])) break; if (sp > XB_SPIN_CAP) { atomicAdd(&bar[XB_TMO], 1u); break; } }
    }
    nloc = mine > 0u ? mine : 1u; nx = cnt > 0u ? cnt : 1u;
}
__device__ __forceinline__ void xcd_barrier(const XcdBarrier& b) {
    asm volatile("s_waitcnt vmcnt(0)" ::: "memory");
    __syncthreads();
    if (threadIdx.x == 0) {
        unsigned* bar = b.bar;
        __builtin_amdgcn_s_waitcnt(0);
        unsigned nloc = b.st[0], nx = b.st[1];
        if (nloc == 0u) { xcd_barrier_complete(bar, b.x, nloc, nx); b.st[0] = nloc; b.st[1] = nx; }
        const unsigned old = xb_add(&bar[XB_XSUB(b.x)], 1u);
        const unsigned gen = old / nloc;
        if (old + 1u == (gen + 1u) * nloc) {
            __builtin_amdgcn_fence(__ATOMIC_RELEASE, "agent");
            asm volatile("s_waitcnt vmcnt(0)" ::: "memory");
            const unsigned og = xb_add(&bar[XB_TOP], 1u);
            const unsigned tg = og / nx;
            if (og + 1u == (tg + 1u) * nx) xb_add(&bar[XB_TOPGEN], 1u);
            else XB_SPIN(xb_ld(&bar[XB_TOPGEN]) == tg, bar);
            __builtin_amdgcn_fence(__ATOMIC_ACQUIRE, "agent");
            xb_add(&bar[XB_XGEN(b.x)], 1u);
            asm volatile("s_waitcnt vmcnt(0)" ::: "memory");
        } else {
            XB_SPIN(xb_ld(&bar[XB_XGEN(b.x)]) == gen, bar);
            __builtin_amdgcn_fence(__ATOMIC_ACQUIRE, "agent");
            asm volatile("s_waitcnt vmcnt(0)" ::: "memory");
        }
    }
    __syncthreads();
}

template <bool F16OUT = false>
__device__ __forceinline__ void tr_item(const float* src, int ldw, bf16_t* dst, int ldd, const float* ks, const float* ns, float sc, bf16_t* dstz, LAS float* scr, int lane) {
    f32x4 v[16];
    const float* s0 = src + (size_t)(lane >> 4) * ldw + (lane & 15) * 4;
#pragma unroll
    for (int i = 0; i < 16; ++i) v[i] = *(const f32x4*)(s0 + (size_t)(4 * i) * ldw);
#pragma unroll
    for (int i = 0; i < 16; ++i) { LAS float* p = scr + ((lane >> 4) + 4 * i) * 65 + (lane & 15) * 4; p[0] = v[i][0]; p[1] = v[i][1]; p[2] = v[i][2]; p[3] = v[i][3]; }
    LDS_WAIT(); asm volatile("" ::: "memory");
    const int c = lane & 7;
    f32x4 k0v = (f32x4){sc, sc, sc, sc}, k1v = k0v;
    if (ks) { k0v = *(const f32x4*)(ks + 8 * c) * sc; k1v = *(const f32x4*)(ks + 8 * c + 4) * sc; }
#pragma unroll
    for (int j = 0; j < 8; ++j) { const int n = (lane >> 3) + 8 * j; const LAS float* s = scr + (8 * c) * 65 + n; const float nsv = ns ? ns[n] : 1.0f;
        u32x4 o; o.x = cvt_pk16<F16OUT>(s[0 * 65] * k0v[0] * nsv, s[1 * 65] * k0v[1] * nsv); o.y = cvt_pk16<F16OUT>(s[2 * 65] * k0v[2] * nsv, s[3 * 65] * k0v[3] * nsv);
        o.z = cvt_pk16<F16OUT>(s[4 * 65] * k1v[0] * nsv, s[5 * 65] * k1v[1] * nsv); o.w = cvt_pk16<F16OUT>(s[6 * 65] * k1v[2] * nsv, s[7 * 65] * k1v[3] * nsv);
        *(u32x4*)(dst + (size_t)n * ldd + 8 * c) = o;
        if (dstz) *(u32x4*)(dstz + (size_t)n * ldd + 8 * c) = (u32x4){0u, 0u, 0u, 0u}; }
    LDS_WAIT(); asm volatile("" ::: "memory");
}

struct TrItem { const float* src; bf16_t* dst; const float* ks; const float* ns; bf16_t* dstz; int ldw, ldd, f16; };
__device__ __forceinline__ void tr_load(const TrItem& t, f32x4 (&v)[16], int lane) {
    const float* s0 = t.src + (size_t)(lane >> 4) * t.ldw + (lane & 15) * 4;
#pragma unroll
    for (int i = 0; i < 16; ++i) v[i] = *(const f32x4*)(s0 + (size_t)(4 * i) * t.ldw);
}
template <bool F16OUT>
__device__ __forceinline__ void tr_finish_t(const TrItem& t, const f32x4 (&v)[16], LAS float* scr, int lane) {
#pragma unroll
    for (int i = 0; i < 16; ++i) { LAS float* p = scr + ((lane >> 4) + 4 * i) * 65 + (lane & 15) * 4; p[0] = v[i][0]; p[1] = v[i][1]; p[2] = v[i][2]; p[3] = v[i][3]; }
    LDS_WAIT(); asm volatile("" ::: "memory");
    const int c = lane & 7;
    f32x4 k0v = (f32x4){1.f, 1.f, 1.f, 1.f}, k1v = k0v;
    if (t.ks) { k0v = *(const f32x4*)(t.ks + 8 * c); k1v = *(const f32x4*)(t.ks + 8 * c + 4); }
#pragma unroll
    for (int j = 0; j < 8; ++j) { const int n = (lane >> 3) + 8 * j; const LAS float* s = scr + (8 * c) * 65 + n; const float nsv = t.ns ? t.ns[n] : 1.0f;
        u32x4 o; o.x = cvt_pk16<F16OUT>(s[0 * 65] * k0v[0] * nsv, s[1 * 65] * k0v[1] * nsv); o.y = cvt_pk16<F16OUT>(s[2 * 65] * k0v[2] * nsv, s[3 * 65] * k0v[3] * nsv);
        o.z = cvt_pk16<F16OUT>(s[4 * 65] * k1v[0] * nsv, s[5 * 65] * k1v[1] * nsv); o.w = cvt_pk16<F16OUT>(s[6 * 65] * k1v[2] * nsv, s[7 * 65] * k1v[3] * nsv);
        *(u32x4*)(t.dst + (size_t)n * t.ldd + 8 * c) = o;
        if (t.dstz) *(u32x4*)(t.dstz + (size_t)n * t.ldd + 8 * c) = (u32x4){0u, 0u, 0u, 0u}; }
    LDS_WAIT(); asm volatile("" ::: "memory");
}
__device__ __forceinline__ void tr_finish(const TrItem& t, const f32x4 (&v)[16], LAS float* scr, int lane) { if (t.f16) tr_finish_t<true>(t, v, scr, lane); else tr_finish_t<false>(t, v, scr, lane); }
template <class T> __device__ __forceinline__ T* uniform_ptr(T* p) {
    const unsigned long long v = (unsigned long long)p; const unsigned lo = __builtin_amdgcn_readfirstlane((unsigned)v), hi = __builtin_amdgcn_readfirstlane((unsigned)(v >> 32));
    return (T*)(((unsigned long long)hi << 32) | lo);
}
struct Args { const float* in[25]; float* out; unsigned char* ws; int step, phase; };

__device__ __forceinline__ void prologue(const Args& args, LAS unsigned char* lds, int lane, int wave, int bx, int G) {
    unsigned char* ws = args.ws;
    LAS float* scr = (LAS float*)(lds + wave * 16640);
    const int gw = bx * 8 + wave, NGW = G * 8;
    constexpr int I_GU = 32 * 88, N_GU = 16 * I_GU, I_D = 88 * 32, N_D = 8 * I_D, I_SQ = 32 * 32, N_SQ = 12 * I_SQ, I_IN = 32 * 64, N_IN = 2 * I_IN, I_OUT = 32 * 32, N_OUT = 2 * I_OUT,
                  I_P = 8 * 8, N_P = 8 * I_P, I_G = 4, N_G = 64 * I_G, NITEMS = N_GU + N_D + N_SQ + N_IN + N_OUT + N_P + N_G;
#define TR_KB(item, NB) (2 * (((item) >> 3) / ((NB) / 4)) + (((item) & 7) >> 2))
#define TR_NB(item, NB) (4 * (((item) >> 3) % ((NB) / 4)) + ((item) & 3))
    auto decode = [&](int it) -> TrItem { TrItem t; t.ks = nullptr; t.ns = nullptr; t.dstz = nullptr; t.f16 = 0; int r = it;
        if (r < N_GU) { const int mat = r / I_GU, item = r % I_GU, lw = mat >> 1, up = mat & 1, k0 = TR_KB(item, 88) * 64, n0 = TR_NB(item, 88) * 64;
            t.src = (up ? args.in[4] : args.in[3]) + (size_t)lw * D * FF + (size_t)k0 * FF + n0; t.ldw = FF;
            t.dst = (bf16_t*)(ws + WS_WGU) + (size_t)lw * (2 * FF) * D + (size_t)(256 * (n0 >> 7) + (n0 & 127) + up * 128) * D + k0; t.ldd = D; t.ks = args.in[2] + lw * D + k0; t.f16 = 1; return t; }
        r -= N_GU;
        if (r < N_D) { const int lw = r / I_D, item = r % I_D, k0 = TR_KB(item, 32) * 64, n0 = TR_NB(item, 32) * 64;
            t.src = args.in[5] + (size_t)lw * FF * D + (size_t)k0 * D + n0; t.ldw = D; t.dst = (bf16_t*)(ws + WS_WD) + (size_t)lw * D * FF + (size_t)n0 * FF + k0; t.ldd = FF; return t; }
        r -= N_D;
        if (r < N_SQ) { const int mat = r / I_SQ, item = r % I_SQ, which = mat >> 2, L = mat & 3, k0 = TR_KB(item, 32) * 64, n0 = TR_NB(item, 32) * 64;
            t.src = (which == 0 ? args.in[21] : which == 1 ? args.in[22] : args.in[23]) + (size_t)L * D * D + (size_t)k0 * D + n0; t.ldw = D;
            t.dst = (bf16_t*)(ws + WS_WK + (size_t)which * 32 * MiB) + (size_t)L * D * D + (size_t)n0 * D + k0; t.ldd = D; return t; }
        r -= N_SQ;
        if (r < N_IN) { const int j = r / I_IN, item = r % I_IN, k0 = TR_KB(item, 64) * 64, n0 = TR_NB(item, 64) * 64;
            t.src = args.in[9] + (size_t)j * D * 4096 + (size_t)k0 * 4096 + n0; t.ldw = 4096; t.dst = (bf16_t*)(ws + WS_WIN) + (size_t)j * 4096 * D + (size_t)n0 * D + k0; t.ldd = D; t.ks = args.in[6] + (2 * j + 1) * D + k0; t.f16 = 1; return t; }
        r -= N_IN;
        if (r < N_OUT) { const int j = r / I_OUT, item = r % I_OUT, k0 = TR_KB(item, 32) * 64, n0 = TR_NB(item, 32) * 64;
            t.src = args.in[17] + (size_t)j * D * D + (size_t)k0 * D + n0; t.ldw = D; t.dst = (bf16_t*)(ws + WS_WOUT) + (size_t)j * D * D + (size_t)n0 * D + k0; t.ldd = D; return t; }
        r -= N_OUT;
        if (r < N_P) { const int mat = r / I_P, item = r % I_P, j = mat >> 2, g = mat & 3, k0 = TR_KB(item, 8) * 64, n0 = TR_NB(item, 8) * 64;
            t.src = args.in[7] + (size_t)mat * 512 * 512 + (size_t)k0 * 512 + n0; t.ldw = 512; t.dst = (bf16_t*)(ws + WS_WP) + (size_t)j * D * 512 + (size_t)(g * 512 + n0) * 512 + k0; t.ldd = 512;
            t.ks = args.in[6] + (2 * j) * D + g * 512 + k0; t.ns = args.in[8] + j * D + g * 512 + n0; return t; }
        r -= N_P;
        { const int mat = r / I_G, item = r % I_G, j = mat >> 5, isx = (mat >> 4) & 1, hh = mat & 15, k0 = (item >> 1) * 64, n0 = (item & 1) * 64;
            bf16_t* rowp = (bf16_t*)(ws + WS_WGATE) + (size_t)j * 4096 * 256 + (size_t)(hh * 256 + isx * 128 + n0) * 256;
            t.src = (isx ? args.in[14] : args.in[12]) + (size_t)(j * 16 + hh) * 128 * 128 + (size_t)k0 * 128 + n0; t.ldw = 128; t.dst = rowp + (hh & 1) * 128 + k0; t.ldd = 256; t.dstz = rowp + ((hh & 1) ^ 1) * 128 + k0; return t; } };
    if (gw < NITEMS) { int it = gw; TrItem a = decode(it), b = a; f32x4 va[16], vb[16]; tr_load(a, va, lane);
        for (;;) { const int itb = it + NGW; const bool hasb = itb < NITEMS;
            if (hasb) { b = decode(itb); tr_load(b, vb, lane); }
            asm volatile("" ::: "memory");
            tr_finish(a, va, scr, lane);
            if (!hasb) break;
            const int ita = itb + NGW; const bool hasa = ita < NITEMS;
            if (hasa) { a = decode(ita); tr_load(a, va, lane); }
            asm volatile("" ::: "memory");
            tr_finish(b, vb, scr, lane);
            if (!hasa) break;
            it = ita; } }
    { bf16_t* wqn = (bf16_t*)(ws + WS_WQN);
      for (int row = gw; row < 4 * D; row += NGW) { const float sck = args.in[18][row] * 0.04419417382415922f; const f32x4* xr = (const f32x4*)(args.in[20] + (size_t)row * D) + lane; u32x2* br = (u32x2*)(wqn + (size_t)row * D) + lane;
#pragma unroll
          for (int j = 0; j < 8; ++j) { const f32x4 v = xr[64 * j] * sck; u32x2 w; w.x = cvt_pk_bf16(v[0], v[1]); w.y = cvt_pk_bf16(v[2], v[3]); br[64 * j] = w; } } }
    { const float* x = args.in[0]; bf16_t* hb = (bf16_t*)(ws + WS_HB); float* part = (float*)(ws + WS_PART);
      for (int row = gw; row < M; row += NGW) { const f32x4* xr = (const f32x4*)(x + (size_t)row * D) + lane; f32x4 v[8]; float ss = 0.f;
#pragma unroll
          for (int j = 0; j < 8; ++j) { v[j] = xr[64 * j]; ss += (v[j][0] * v[j][0] + v[j][1] * v[j][1]) + (v[j][2] * v[j][2] + v[j][3] * v[j][3]); }
          ss = wave_sum(ss);
          u32x2* br = (u32x2*)(hb + (size_t)row * D) + lane;
#pragma unroll
          for (int j = 0; j < 8; ++j) { u32x2 w; w.x = cvt_pk_h(v[j][0], v[j][1]); w.y = cvt_pk_h(v[j][2], v[j][3]); br[64 * j] = w; }
          if (lane < 32) part[(size_t)row * 32 + lane] = lane == 0 ? ss : 0.f; } }
    { const float* mem = args.in[1]; const float* g = args.in[19]; bf16_t* mb = (bf16_t*)(ws + WS_MB);
      for (int row = gw; row < MM; row += NGW) { const f32x4* xr = (const f32x4*)(mem + (size_t)row * D) + lane; f32x4 v[8]; float ss = 0.f;
#pragma unroll
          for (int j = 0; j < 8; ++j) { v[j] = xr[64 * j]; ss += (v[j][0] * v[j][0] + v[j][1] * v[j][1]) + (v[j][2] * v[j][2] + v[j][3] * v[j][3]); }
          const float rs = rsqrtf(wave_sum(ss) * (1.0f / 2048.0f) + EPS); u32x2* br = (u32x2*)(mb + (size_t)row * D) + lane;
#pragma unroll
          for (int j = 0; j < 8; ++j) { const f32x4 gv = *((const f32x4*)g + lane + 64 * j); const f32x4 o = v[j] * rs * gv; u32x2 w; w.x = cvt_pk_bf16(o[0], o[1]); w.y = cvt_pk_bf16(o[2], o[3]); br[64 * j] = w; } } }
    { const float* lam = args.in[16]; float* sp = (float*)(ws + WS_SP);
      for (int i = gw * 64 + lane; i < 2 * D; i += NGW * 64) { const float z = -lam[i]; sp[i] = 8.0f * (fmaxf(z, 0.f) + log1pf(expf(-fabsf(z)))); } }
}

constexpr int PD = 256 * D * 2;
typedef pg8::Sched<M,      2 * FF,  D,   D,    D,      PD,            0,       0,   PD,             0,                0, false, true> ShGU;
typedef pg8::Sched<M,      D,       FF,  FF,   FF,     256 * FF * 2,  0,       0,   256 * FF * 2,   0,                0, DOWN_KREV, false, DOWN_WGM> ShDown;
typedef pg8::Sched<M,      D,       512, D,    512,    PD,            512 * 2, 1,   256 * 512 * 2,  0,                0> ShPool;
typedef pg8::Sched<M,      2 * D,   D,   D,    D,      PD,            0,       0,   PD,             0,                0, false, true> ShLruIn;
typedef pg8::Sched<M,      2 * D,   256, D,    256,    PD,            256 * 2, 1,   256 * 256 * 2,  0,                0> ShGates;
typedef pg8::Sched<M,      D,       D,   D,    D,      PD,            0,       0,   PD,             0,                0> ShDD;
typedef pg8::Sched<M,      NH*MEML, D,   D,    D,      PD,            0,       0,   256 * D * 2,    1024 * D * 2,     4, false, true> ShScore;
typedef pg8::Sched<M,      D,       1024, 1024, 4096,  256 * 1024 * 2, 0,      0,   256 * 4096 * 2, 1024 * 2,         4> ShAO;
typedef pg8::Sched<MM,     8 * D,   D,   D,    D,      PD,            0,       0,   PD,             0,                0> ShKV;

#define LD_BF4P(p) f16x4_to_f32(*(const u32x2*)(p))
__device__ __forceinline__ unsigned long long launder_u64(unsigned long long v) {
    unsigned z; asm volatile("v_mov_b32 %0, 0" : "=v"(z));
    unsigned lo = (unsigned)v ^ z, hi = (unsigned)(v >> 32) ^ z; asm volatile("" : "+v"(lo), "+v"(hi));
    return ((unsigned long long)(unsigned)__builtin_amdgcn_readfirstlane(hi) << 32) | (unsigned)__builtin_amdgcn_readfirstlane(lo);
}
#define PHASE_VARS() int tid = threadIdx.x; asm volatile("" : "+v"(tid)); unsigned char* ws = (unsigned char*)(GAS unsigned char*)launder_u64((unsigned long long)args.ws); \
    bf16_t* hb = (bf16_t*)(ws + WS_HB); float* part = (float*)(ws + WS_PART); (void)tid; (void)hb; (void)part
__global__ void __launch_bounds__(512, 2) mk_fwd(Args args) {
    extern __shared__ __attribute__((aligned(16))) unsigned char lds_raw[];
    LAS unsigned char* lds = (LAS unsigned char*)lds_raw;
    const int G = gridDim.x, bx = blockIdx.x;
    unsigned long long prof_acc = 0;
#if MK_SINGLE
    volatile LAS unsigned* MISC = (volatile LAS unsigned*)(lds + MISC_OFF);
    if (threadIdx.x < 32) MISC[threadIdx.x] = 0u;
    __syncthreads();
    XcdBarrier bar = xcd_barrier_post((unsigned*)(args.ws + WS_CTL) + CW_BAR, MISC + 8);
#define GRID_BAR() xcd_barrier(bar)
#define PH(k) true
    const int s_lo = 0, s_hi = 8; const bool do_pro = true, do_fin = true;
#else
#define GRID_BAR() do {} while (0)
#define PH(k) (args.phase == (k))
    const int s_lo = args.step, s_hi = (args.step >= 0 && args.step < 8) ? args.step + 1 : args.step; const bool do_pro = args.step == -1, do_fin = args.step == 8;
#endif

    if (do_pro) {
        if (PH(0)) { for (int rep = 0; rep < REP_PRO; ++rep) { PHASE_VARS(); unsigned long long pt_ = 0; if constexpr (PROF_TAG == 110) pt_ = PROF_NOW(); prologue(args, lds, tid & 63, __builtin_amdgcn_readfirstlane(tid >> 6), bx, G); GRID_BAR(); if constexpr (PROF_TAG == 110) prof_acc += PROF_NOW() - pt_; } }
        if (PH(1)) {
            PHASE_VARS(); ShKV S{(const char*)(ws + WS_MB), (const char*)(ws + WS_WK), G, bx}; pg8::EpiPlain<false> E{(bf16_t*)(ws + WS_KV), 8 * D}; pg8::gemm_phase<pg8::EpiPlain<false>, true, 9>(lds, S, E, prof_acc); GRID_BAR(); }
        if (PH(2)) {
            { PHASE_VARS(); pg8::SchedG S{(const char*)(ws + WS_KV), (const char*)(ws + WS_WQN), G, bx}; pg8::EpiPlain<true> E{(bf16_t*)(ws + WS_GALL), D}; pg8::gemm_phase<pg8::EpiPlain<true>, true, 10>(lds, S, E, prof_acc); }
            { PHASE_VARS(); pg8::SchedH S{(const char*)(ws + WS_WO), (const char*)(ws + WS_KV), G, bx}; pg8::EpiPlain<false> E{(bf16_t*)(ws + WS_HALL), 4096}; pg8::gemm_phase<pg8::EpiPlain<false>, true, 10>(lds, S, E, prof_acc); }
        }
    }
#pragma unroll 1
    for (int s = s_lo; s < s_hi; ++s) {
        const int L = s >> 1, lw = s;
        if (PH(0)) for (int rep = 0; rep < REP_GU; ++rep) { PHASE_VARS(); ShGU S{(const char*)hb, (const char*)(ws + WS_WGU) + (size_t)lw * (2 * FF) * D * 2, G, bx};
            pg8::EpiSwiGLU E{(bf16_t*)(ws + WS_ACT), part, (LAS float*)(lds + EPI_TBL_OFF)};
            pg8::gemm_phase<pg8::EpiSwiGLU, true, 1>(lds, S, E, prof_acc); GRID_BAR(); }
        if (PH(1)) for (int rep = 0; rep < REP_DOWN; ++rep) { PHASE_VARS(); ShDown S{(const char*)(ws + WS_ACT), (const char*)(ws + WS_WD) + (size_t)lw * D * FF * 2, G, bx};
            pg8::EpiResid E{hb, part, 0.5f};
            pg8::gemm_phase<pg8::EpiResid, true, 2>(lds, S, E, prof_acc); GRID_BAR(); }
        if ((s & 1) == 0) {
            const int j = L >> 1;
            if ((L & 1) == 0) {
                if (PH(2)) for (int rep = 0; rep < REP_THIN; ++rep) { PHASE_VARS(); unsigned long long pt_ = 0; if constexpr (PROF_TAG == 120) pt_ = PROF_NOW(); bf16_t* pooled = (bf16_t*)(ws + WS_POOLED); LAS float* R = (LAS float*)lds;
                    for (int blk = bx; blk < M / 64; blk += G) { const int t0 = blk * 64, seq0 = (t0 / SEQ) * SEQ;
                        if (tid < 79) { const int row = t0 - 15 + tid; float rs = 0.f;
                            if (row >= seq0) { const f32x4* p = (const f32x4*)(part + (size_t)row * 32); float sacc = 0.f;
#pragma unroll
                                for (int q = 0; q < 8; ++q) { const f32x4 a = p[q]; sacc += (a[0] + a[1]) + (a[2] + a[3]); }
                                rs = rsqrtf(sacc * (1.0f / 2048.0f) + EPS); }
                            R[tid] = rs; }
                        __syncthreads();
                        const int w = 2 << (tid >> 7); const bf16_t* hc = hb + 4 * tid; f32x4 S4 = (f32x4){0.f, 0.f, 0.f, 0.f};
                        { u32x2 hk[15];
#pragma unroll
                          for (int i = 0; i < 15; ++i) { const int r = t0 - 15 + i; hk[i] = (i >= 16 - w && r >= seq0) ? *(const u32x2*)(hc + (size_t)r * D) : (u32x2){0u, 0u}; }
#pragma unroll
                          for (int i = 0; i < 15; ++i) S4 = S4 + f16x4_to_f32(hk[i]) * R[i]; }
                        u32x2 nb[2][8], ob[2][8];
#define POOL_LOAD(b) do { _Pragma("unroll") for (int i = 0; i < 8; ++i) { const int t_ = t0 + 8 * (b) + i, to_ = t_ - w; nb[(b) & 1][i] = *(const u32x2*)(hc + (size_t)t_ * D); \
                              ob[(b) & 1][i] = to_ >= seq0 ? *(const u32x2*)(hc + (size_t)to_ * D) : (u32x2){0u, 0u}; } } while (0)
                        POOL_LOAD(0);
#pragma unroll
                        for (int b = 0; b < 8; ++b) { if (b + 1 < 8) POOL_LOAD(b + 1);
                            asm volatile("" ::: "memory");
#pragma unroll
                            for (int i = 0; i < 8; ++i) { const int idx = 8 * b + i, t = t0 + idx, tt = t - seq0; const f32x4 uv = f16x4_to_f32(nb[b & 1][i]) * R[idx + 15]; S4 = S4 + uv;
                                if (idx > 0 && tt >= w) S4 = S4 - f16x4_to_f32(ob[b & 1][i]) * R[idx - w + 15];
                                const float ic = 1.0f / (float)(tt + 1 < w ? tt + 1 : w); const f32x4 o = S4 * ic - uv;
                                u32x2 pk; pk.x = cvt_pk_bf16(o[0], o[1]); pk.y = cvt_pk_bf16(o[2], o[3]); *(u32x2*)(pooled + (size_t)t * D + 4 * tid) = pk; }
                            asm volatile("" ::: "memory"); }
#undef POOL_LOAD
                        __syncthreads(); }
                    GRID_BAR(); if constexpr (PROF_TAG == 120) prof_acc += PROF_NOW() - pt_; }
                if (PH(3)) { PHASE_VARS(); ShPool S{(const char*)(ws + WS_POOLED), (const char*)(ws + WS_WP) + (size_t)j * D * 512 * 2, G, bx};
                    pg8::EpiResid E{hb, part, 1.0f};
                    pg8::gemm_phase<pg8::EpiResid, true, 3>(lds, S, E, prof_acc); GRID_BAR(); }
            } else {
                if (PH(2)) { PHASE_VARS(); ShLruIn S{(const char*)hb, (const char*)(ws + WS_WIN) + (size_t)j * 4096 * D * 2, G, bx};
                    pg8::EpiLruIn E{(bf16_t*)(ws + WS_GG), (bf16_t*)(ws + WS_XR), part, (LAS float*)(lds + EPI_TBL_OFF)};
                    pg8::gemm_phase<pg8::EpiLruIn, true, 4>(lds, S, E, prof_acc); GRID_BAR(); }
                if (PH(3)) for (int rep = 0; rep < REP_THIN; ++rep) { PHASE_VARS(); unsigned long long pt_ = 0; if constexpr (PROF_TAG == 130) pt_ = PROF_NOW(); const bf16_t* xr = (const bf16_t*)(ws + WS_XR); bf16_t* xcb = (bf16_t*)(ws + WS_XCB);
                    const float* cw = args.in[10] + (size_t)j * 4 * D + 4 * tid; const f32x4 w0 = *(const f32x4*)cw, w1 = *(const f32x4*)(cw + D), w2 = *(const f32x4*)(cw + 2 * D), w3 = *(const f32x4*)(cw + 3 * D);
                    const f32x4 cb = *(const f32x4*)(args.in[11] + (size_t)j * D + 4 * tid);
                    for (int blk = bx; blk < M / 64; blk += G) { const int t0 = blk * 64, seq0 = (t0 / SEQ) * SEQ; const bf16_t* xp = xr + 4 * tid; const f32x4 z = (f32x4){0.f, 0.f, 0.f, 0.f};
                        f32x4 x0 = z, x1 = z, x2 = z; if (t0 > seq0) { x0 = bf16x4_to_f32(*(const u32x2*)(xp + (size_t)(t0 - 3) * D)); x1 = bf16x4_to_f32(*(const u32x2*)(xp + (size_t)(t0 - 2) * D)); x2 = bf16x4_to_f32(*(const u32x2*)(xp + (size_t)(t0 - 1) * D)); }
                        u32x2 xb[2][16];
#define CONV_LOAD(b) do { _Pragma("unroll") for (int i = 0; i < 16; ++i) xb[(b) & 1][i] = *(const u32x2*)(xp + (size_t)(t0 + 16 * (b) + i) * D); } while (0)
                        CONV_LOAD(0);
#pragma unroll
                        for (int b = 0; b < 4; ++b) { if (b + 1 < 4) CONV_LOAD(b + 1);
                            asm volatile("" ::: "memory");
#pragma unroll
                            for (int i = 0; i < 16; ++i) { const int t = t0 + 16 * b + i; const f32x4 x3 = bf16x4_to_f32(xb[b & 1][i]); const f32x4 o = cb + x0 * w0 + x1 * w1 + x2 * w2 + x3 * w3;
                                u32x2 pk; pk.x = cvt_pk_bf16(o[0], o[1]); pk.y = cvt_pk_bf16(o[2], o[3]); *(u32x2*)(xcb + (size_t)t * D + 4 * tid) = pk;
                                x0 = x1; x1 = x2; x2 = x3; }
                            asm volatile("" ::: "memory"); }
#undef CONV_LOAD
                    }
                    GRID_BAR(); if constexpr (PROF_TAG == 130) prof_acc += PROF_NOW() - pt_; }
                if (PH(4)) { PHASE_VARS(); ShGates S{(const char*)(ws + WS_XCB), (const char*)(ws + WS_WGATE) + (size_t)j * 4096 * 256 * 2, G, bx};
                    pg8::EpiGates E{(bf16_t*)(ws + WS_LA), (bf16_t*)(ws + WS_BT), (const bf16_t*)(ws + WS_XCB), args.in[13] + (size_t)j * D, args.in[15] + (size_t)j * D, (const float*)(ws + WS_SP) + (size_t)j * D};
                    pg8::gemm_phase<pg8::EpiGates, true, 5>(lds, S, E, prof_acc); GRID_BAR(); }
#define EXP2_4(v) ((f32x4){__builtin_amdgcn_exp2f((v)[0]), __builtin_amdgcn_exp2f((v)[1]), __builtin_amdgcn_exp2f((v)[2]), __builtin_amdgcn_exp2f((v)[3])})
                if (PH(5)) for (int rep = 0; rep < REP_THIN; ++rep) { PHASE_VARS(); unsigned long long pt_ = 0; if constexpr (PROF_TAG == 140) pt_ = PROF_NOW(); const bf16_t* lav = (const bf16_t*)(ws + WS_LA) + 4 * tid; const bf16_t* bv = (const bf16_t*)(ws + WS_BT) + 4 * tid; float* chA = (float*)(ws + WS_CHA); float* chB = (float*)(ws + WS_CHB);
                    for (int blk = bx; blk < M / 64; blk += G) { const int t0 = blk * 64; f32x4 Ls = (f32x4){0.f, 0.f, 0.f, 0.f}, Hs = (f32x4){0.f, 0.f, 0.f, 0.f};
                        u32x2 lb[2][8], bb[2][8];
#define SC1_LOAD(b) do { _Pragma("unroll") for (int i = 0; i < 8; ++i) { const size_t o_ = (size_t)(t0 + 8 * (b) + i) * D; lb[(b) & 1][i] = *(const u32x2*)(lav + o_); bb[(b) & 1][i] = *(const u32x2*)(bv + o_); } } while (0)
                        SC1_LOAD(0);
#pragma unroll
                        for (int b = 0; b < 8; ++b) { if (b + 1 < 8) SC1_LOAD(b + 1);
                            asm volatile("" ::: "memory");
#pragma unroll
                            for (int i = 0; i < 8; ++i) { const f32x4 l4 = bf16x4_to_f32(lb[b & 1][i]), b4 = bf16x4_to_f32(bb[b & 1][i]); const f32x4 a4 = EXP2_4(l4); Hs = a4 * Hs + b4; Ls = Ls + l4; } }
#undef SC1_LOAD
                        *(f32x4*)(chA + (size_t)blk * D + 4 * tid) = EXP2_4(Ls); *(f32x4*)(chB + (size_t)blk * D + 4 * tid) = Hs; }
                    GRID_BAR(); if constexpr (PROF_TAG == 140) prof_acc += PROF_NOW() - pt_; }
                if (PH(6)) for (int rep = 0; rep < REP_THIN; ++rep) { PHASE_VARS(); unsigned long long pt_ = 0; if constexpr (PROF_TAG == 150) pt_ = PROF_NOW(); const bf16_t* lav = (const bf16_t*)(ws + WS_LA) + 4 * tid; const bf16_t* bv = (const bf16_t*)(ws + WS_BT) + 4 * tid;
                    const float* chA = (const float*)(ws + WS_CHA) + 4 * tid; const float* chB = (const float*)(ws + WS_CHB) + 4 * tid; const bf16_t* gg = (const bf16_t*)(ws + WS_GG) + 4 * tid; bf16_t* yb = (bf16_t*)(ws + WS_XCB) + 4 * tid;
                    for (int blk = bx; blk < M / 64; blk += G) { const int t0 = blk * 64, c0 = (blk / 64) * 64; f32x4 Hs = (f32x4){0.f, 0.f, 0.f, 0.f};
                        u32x2 lb[2][8], bb[2][8], gb[2][8];
#define SC2_LOAD(b) do { _Pragma("unroll") for (int i = 0; i < 8; ++i) { const size_t o_ = (size_t)(t0 + 8 * (b) + i) * D; lb[(b) & 1][i] = *(const u32x2*)(lav + o_); bb[(b) & 1][i] = *(const u32x2*)(bv + o_); gb[(b) & 1][i] = *(const u32x2*)(gg + o_); } } while (0)
                        SC2_LOAD(0);
                        int c = c0;
                        for (; c + 8 <= blk; c += 8) { f32x4 ca[8], cb8[8];
#pragma unroll
                            for (int i = 0; i < 8; ++i) { ca[i] = *(const f32x4*)(chA + (size_t)(c + i) * D); cb8[i] = *(const f32x4*)(chB + (size_t)(c + i) * D); }
#pragma unroll
                            for (int i = 0; i < 8; ++i) Hs = ca[i] * Hs + cb8[i]; }
                        for (; c < blk; ++c) { const f32x4 a4 = *(const f32x4*)(chA + (size_t)c * D), b4 = *(const f32x4*)(chB + (size_t)c * D); Hs = a4 * Hs + b4; }
#pragma unroll
                        for (int b = 0; b < 8; ++b) { if (b + 1 < 8) SC2_LOAD(b + 1);
                            asm volatile("" ::: "memory");
#pragma unroll
                            for (int i = 0; i < 8; ++i) { const int t = t0 + 8 * b + i; const f32x4 l4 = bf16x4_to_f32(lb[b & 1][i]), b4 = bf16x4_to_f32(bb[b & 1][i]), g4 = bf16x4_to_f32(gb[b & 1][i]); const f32x4 a4 = EXP2_4(l4); Hs = a4 * Hs + b4;
                                u32x2 pk; pk.x = cvt_pk_bf16(Hs[0] * g4[0], Hs[1] * g4[1]); pk.y = cvt_pk_bf16(Hs[2] * g4[2], Hs[3] * g4[3]); *(u32x2*)(yb + (size_t)t * D) = pk; }
                            asm volatile("" ::: "memory"); }
#undef SC2_LOAD
                    }
                    GRID_BAR(); if constexpr (PROF_TAG == 150) prof_acc += PROF_NOW() - pt_; }
#undef EXP2_4
                if (PH(7)) { PHASE_VARS(); ShDD S{(const char*)(ws + WS_XCB), (const char*)(ws + WS_WOUT) + (size_t)j * D * D * 2, G, bx};
                    pg8::EpiResid E{hb, part, 1.0f};
                    pg8::gemm_phase<pg8::EpiResid, true, 6>(lds, S, E, prof_acc); GRID_BAR(); }
            }
            if (PH(8)) { PHASE_VARS(); ShScore S{(const char*)hb, (const char*)(ws + WS_GALL) + (size_t)L * 4096 * D * 2, G, bx};
                pg8::EpiSoftmax E{(bf16_t*)(ws + WS_P), part};
                pg8::gemm_phase<pg8::EpiSoftmax, false, 7>(lds, S, E, prof_acc); GRID_BAR(); }
            if (PH(9)) for (int rep = 0; rep < REP_RES2K; ++rep) { PHASE_VARS(); ShAO S{(const char*)(ws + WS_P), (const char*)(ws + WS_HALL) + (size_t)L * D * 4096 * 2, G, bx};
                pg8::EpiResid E{hb, part, 1.0f};
                pg8::gemm_phase<pg8::EpiResid, true, 8>(lds, S, E, prof_acc); GRID_BAR(); }
        }
    }
    if (do_fin) { unsigned long long pt_ = 0; if constexpr (PROF_TAG == 160) pt_ = PROF_NOW(); PHASE_VARS(); float* h = (float*)(GAS float*)launder_u64((unsigned long long)args.out); const float* g = args.in[24]; const int lane = tid & 63, gw = bx * 8 + (tid >> 6), NGW = G * 8;
        for (int row = gw; row < M; row += NGW) { const u32x2* br = (const u32x2*)(hb + (size_t)row * D) + lane; f32x4* orow = (f32x4*)(h + (size_t)row * D) + lane; f32x4 v[8]; float ss = 0.f;
#pragma unroll
            for (int jj = 0; jj < 8; ++jj) { v[jj] = f16x4_to_f32(br[64 * jj]);
                ss += (v[jj][0] * v[jj][0] + v[jj][1] * v[jj][1]) + (v[jj][2] * v[jj][2] + v[jj][3] * v[jj][3]); }
            const float rs = rsqrtf(wave_sum(ss) * (1.0f / 2048.0f) + EPS);
#pragma unroll
            for (int jj = 0; jj < 8; ++jj) { const f32x4 gv = *((const f32x4*)g + lane + 64 * jj); orow[64 * jj] = v[jj] * rs * gv; } }
        if constexpr (PROF_TAG == 160) { VM_WAIT(); prof_acc += PROF_NOW() - pt_; } }
    if constexpr (PROF_TAG != 0) { const unsigned long long t0 = PROF_NOW(); while (PROF_NOW() - t0 < prof_acc) __builtin_amdgcn_s_sleep(4); }
}

extern "C" void kernel_launch(void* const* d_in, const int* in_sizes, int n_in, void* d_out, int out_size, void* d_ws, size_t ws_size, hipStream_t stream) {
    static int grid = 0;
    if (grid == 0) {
        if (n_in != 25 || in_sizes[0] != M * D || out_size != M * D || ws_size < WS_END) { fprintf(stderr, "kernel_launch: unexpected shapes (n_in %d, in0 %d, out %d, ws %zu, need %zu); nothing launched\n", n_in, n_in > 0 ? in_sizes[0] : -1, out_size, ws_size, (size_t)WS_END); grid = -1; return; }
        int dev = 0, cus = 0, per_cu = 0;
        if (hipGetDevice(&dev) != hipSuccess || hipDeviceGetAttribute(&cus, hipDeviceAttributeMultiprocessorCount, dev) != hipSuccess) { fprintf(stderr, "kernel_launch: device query failed\n"); grid = -1; return; }
        if (hipFuncSetAttribute((const void*)mk_fwd, hipFuncAttributeMaxDynamicSharedMemorySize, LDS_BYTES) != hipSuccess) { fprintf(stderr, "kernel_launch: hipFuncSetAttribute failed\n"); grid = -1; return; }
        if (hipOccupancyMaxActiveBlocksPerMultiprocessor(&per_cu, (const void*)mk_fwd, 512, LDS_BYTES) != hipSuccess || per_cu < 1) fprintf(stderr, "kernel_launch: occupancy query says %d\n", per_cu);
        (void)hipGetLastError();
        grid = cus;
        if (grid != 256) { fprintf(stderr, "kernel_launch: built for 256 CUs, found %d; nothing launched\n", cus); grid = -1; return; }
    }
    if (grid < 0) return;
    Args a{};
    for (int i = 0; i < 25; ++i) a.in[i] = (const float*)d_in[i];
    a.out = (float*)d_out; a.ws = (unsigned char*)d_ws;
#if MK_SINGLE
    if (hipMemsetAsync((char*)d_ws + WS_CTL, 0, CTL_ZERO_BYTES, stream) != hipSuccess) { fprintf(stderr, "kernel_launch: memset failed\n"); return; }
    a.step = 0; a.phase = 0;
    hipLaunchKernelGGL(mk_fwd, dim3(grid), dim3(512), LDS_BYTES, stream, a);
#else
    auto launch = [&](int s, int p) { a.step = s; a.phase = p; hipLaunchKernelGGL(mk_fwd, dim3(grid), dim3(512), LDS_BYTES, stream, a); };
    launch(-1, 0); launch(-1, 1); launch(-1, 2);
    for (int s = 0; s < 8; ++s) { launch(s, 0); launch(s, 1);
        if ((s & 1) == 0) { const int L = s >> 1;
            if ((L & 1) == 0) { launch(s, 2); launch(s, 3); } else { for (int p = 2; p <= 7; ++p) launch(s, p); }
            for (int p = 8; p <= 9; ++p) launch(s, p); } }
    launch(8, 0);
#endif
    const hipError_t le = hipPeekAtLastError();
    if (le != hipSuccess) fprintf(stderr, "kernel_launch: launch failed: %s\n", hipGetErrorName(le));
}
```

```cpp
#include <hip/hip_runtime.h>
#include <cstdio>
#include <cstdint>

#ifndef MK_SINGLE
#define MK_SINGLE 1
#endif

#ifndef PROF_TAG
#define PROF_TAG 0
#endif
#define PROF_NOW() __builtin_amdgcn_s_memrealtime()
#ifndef DOWN_WGM
#define DOWN_WGM 4
#endif
#ifndef DOWN_KREV
#define DOWN_KREV true
#endif
#ifndef REP_PRO
#define REP_PRO 1
#endif
#ifndef REP_GU
#define REP_GU 1
#endif
#ifndef REP_DOWN
#define REP_DOWN 1
#endif
#ifndef REP_THIN
#define REP_THIN 1
#endif
#ifndef STAGGER_TICKS
#define STAGGER_TICKS 0
#endif
#ifndef STAGGER_GROUPS
#define STAGGER_GROUPS 2
#endif
#ifndef STAGGER_GU_TICKS
#define STAGGER_GU_TICKS 0
#endif
#ifndef STAGGER_GU_GROUPS
#define STAGGER_GU_GROUPS 4
#endif
#ifndef REP_RES2K
#define REP_RES2K 1
#endif
#define LAS __attribute__((address_space(3)))
#define GAS __attribute__((address_space(1)))
typedef unsigned short bf16_t;
typedef short bf16x8 __attribute__((ext_vector_type(8)));
typedef float f32x4 __attribute__((ext_vector_type(4)));
typedef float f32x2 __attribute__((ext_vector_type(2)));
typedef unsigned u32x4 __attribute__((ext_vector_type(4)));
typedef unsigned u32x2 __attribute__((ext_vector_type(2)));
typedef GAS unsigned gu32;
#define LDS_WAIT() asm volatile("s_waitcnt lgkmcnt(0)" ::: "memory")
#define VM_WAIT() asm volatile("s_waitcnt vmcnt(0)" ::: "memory")

__device__ __forceinline__ unsigned cvt_pk_bf16(float lo, float hi) { unsigned r; asm volatile("v_cvt_pk_bf16_f32 %0, %1, %2" : "=v"(r) : "v"(lo), "v"(hi)); return r; }
typedef _Float16 f16x2 __attribute__((ext_vector_type(2)));
typedef _Float16 f16x8 __attribute__((ext_vector_type(8)));
__device__ __forceinline__ unsigned cvt_pk_f16(float lo, float hi) { const f16x2 v = {(_Float16)lo, (_Float16)hi}; return __builtin_bit_cast(unsigned, v); }
#ifndef H_TRIM
#define H_TRIM 2
#endif
__device__ __forceinline__ unsigned cvt_pk_h(float lo, float hi) { const unsigned w = cvt_pk_f16(lo, hi);
    if constexpr (H_TRIM > 0) { constexpr unsigned almost_half = ((1u << (H_TRIM - 1)) - 1u) * 0x00010001u, mask = ~(((1u << H_TRIM) - 1u) * 0x00010001u);
        return (w + almost_half + ((w >> H_TRIM) & 0x00010001u)) & mask; } else return w; }
template <bool F16> __device__ __forceinline__ unsigned cvt_pk16(float lo, float hi) { const unsigned b = cvt_pk_bf16(lo, hi); if constexpr (F16) return cvt_pk_f16(__uint_as_float(b << 16), __uint_as_float(b & 0xffff0000u)); else return b; }
__device__ __forceinline__ f32x4 f16x4_to_f32(u32x2 k) { const unsigned ka = k.x, kb = k.y; const f16x2 a = __builtin_bit_cast(f16x2, ka); const f16x2 b = __builtin_bit_cast(f16x2, kb);
    return (f32x4){(float)a.x, (float)a.y, (float)b.x, (float)b.y}; }
__device__ __forceinline__ f32x4 bf16x4_to_f32(u32x2 k) { return (f32x4){__uint_as_float(k.x << 16), __uint_as_float(k.x & 0xffff0000u), __uint_as_float(k.y << 16), __uint_as_float(k.y & 0xffff0000u)}; }
__device__ __forceinline__ float wave_sum(float v) {
#pragma unroll
    for (int o = 1; o < 64; o <<= 1) v += __shfl_xor(v, o);
    return v;
}
__device__ __forceinline__ float fast_sigmoid(float x) { return __builtin_amdgcn_rcpf(1.0f + __builtin_amdgcn_exp2f(-1.44269504089f * x)); }

constexpr int BATCH = 4, SEQ = 4096, D = 2048, DEPTH = 4, FF = 5632, MEML = 256, NH = 4, HD = 512, LH = 16;
constexpr int M = BATCH * SEQ;
constexpr int MM = BATCH * MEML;
constexpr float EPS = 1e-6f;

namespace pg8 {
constexpr int BM = 256, BK = 64, HALF = 128, HTB = HALF * BK * 2, STAGE_BYTES = 8 * HTB, NXCD = 8;
__host__ __device__ __forceinline__ int lds_byte(int r, int c) { const int st = (r >> 4) * 2 + (c >> 5), rr = r & 15, cc = c & 31, ob = rr * 64 + cc * 2; return st * 1024 + (ob ^ (((ob >> 9) & 1) << 5)); }
__host__ __device__ __forceinline__ void stage_rc(int b, int& R, int& C) { const int st = b / 1024, sb = b % 1024, swz = sb ^ (((sb >> 9) & 1) << 5); R = (st >> 1) * 16 + swz / 64; C = (st & 1) * 32 + (swz % 64) / 2; }
__host__ __device__ __forceinline__ int perm32(int rho) { const int n = rho >> 4, i = rho & 15; return 8 * (i >> 2) + 4 * n + (i & 3); }

struct Unit { int pm, pn; const char* a; const char* b; };

template <int nM, int nN, int WGM = 8> __device__ __forceinline__ bool unit_order(int i, int G, int c, int& pm, int& pn) {
    constexpr int nwg = nM * nN;
    const int L = i * G + c; if (L >= nwg) return false;
    int wgid = L; { constexpr int q = nwg / NXCD, r = nwg % NXCD; const int xcd = wgid % NXCD, off = wgid / NXCD; wgid = (xcd < r ? xcd * (q + 1) : r * (q + 1) + (xcd - r) * q) + off; }
    constexpr int nig = WGM * nN; const int gid = wgid / nig, fm = gid * WGM, gsz = (nM - fm) < WGM ? (nM - fm) : WGM;
    pm = fm + ((wgid % nig) % gsz); pn = (wgid % nig) / gsz; return true;
}
template <int MR, int NC, int K_, int LDA, int LDB, int APM, int APN, int ASH, int BPN, int BPM, int BSH, bool KREV_ = false, bool F16_ = false, int WGM_ = 8>
struct Sched {
    static constexpr int K = K_, lda = LDA, ldb = LDB; static constexpr bool KREV = KREV_, F16 = F16_;
    const char* A; const char* B; int G, c;
    __device__ __forceinline__ bool next(int i, Unit& u) const {
        if (!unit_order<MR / BM, NC / BM, WGM_>(i, G, c, u.pm, u.pn)) return false;
        u.a = A + (size_t)u.pm * APM + (size_t)(u.pn >> ASH) * APN + (KREV ? (K - BK) * 2 : 0); u.b = B + (size_t)u.pn * BPN + (size_t)(u.pm >> BSH) * BPM + (KREV ? (K - BK) * 2 : 0); return true;
    }
};
struct SchedG {
    static constexpr int K = 512, lda = 16384, ldb = 2048; static constexpr bool KREV = false, F16 = false;
    const char* KV; const char* WQN; int G, c;
    __device__ __forceinline__ bool next(int i, Unit& u) const {
        if (!unit_order<64, 8>(i, G, c, u.pm, u.pn)) return false;
        const int L = u.pm >> 4, b = (u.pm >> 2) & 3, h = u.pm & 3;
        u.a = KV + ((size_t)(b * 256) * 16384 + L * 2048 + h * 512) * 2; u.b = WQN + ((size_t)L * 2048 * 2048 + (size_t)u.pn * 256 * 2048 + h * 512) * 2; return true;
    }
};
struct SchedH {
    static constexpr int K = 512, lda = 2048, ldb = 16384; static constexpr bool KREV = false, F16 = false;
    const char* WOT; const char* KV; int G, c;
    __device__ __forceinline__ bool next(int i, Unit& u) const {
        if (!unit_order<32, 16>(i, G, c, u.pm, u.pn)) return false;
        const int L = u.pm >> 3, b = u.pn >> 2, h = u.pn & 3;
        u.a = WOT + ((size_t)u.pm * 256 * 2048 + h * 512) * 2; u.b = KV + ((size_t)(b * 256) * 16384 + 8192 + L * 2048 + h * 512) * 2; return true;
    }
};

__device__ __forceinline__ float row_rstd(const float* part, int row, int fq) {
    const f32x4* p = (const f32x4*)(part + (size_t)row * 32 + fq * 8);
    const f32x4 a = p[0], b = p[1];
    float s = ((a.x + a.y) + (a.z + a.w)) + ((b.x + b.y) + (b.z + b.w));
    s += __shfl_xor(s, 16); s += __shfl_xor(s, 32);
    return rsqrtf(s * (1.0f / 2048.0f) + EPS);
}

__device__ __forceinline__ void rstd_table(LAS float* tbl, const float* part, int pm, int tid) {
    if (tid < 256) { const f32x4* p = (const f32x4*)(part + (size_t)(pm * BM + tid) * 32); float sm = 0.f;
#pragma unroll
        for (int q = 0; q < 8; ++q) { const f32x4 a = p[q]; sm += (a[0] + a[1]) + (a[2] + a[3]); }
        tbl[tid] = rsqrtf(sm * (1.0f / 2048.0f) + EPS); }
    if (tid == 0) ((LAS int*)tbl)[256] = pm;
}
#define EPI_NO_PREPARE __device__ __forceinline__ void prepare(const Unit&, int) const {}
struct EpiSwiGLU {
    static constexpr bool PERM = true, AFTER_DRAIN = false, IS_RESID = false, IS_GU = true;
    bf16_t* O; const float* part; LAS float* tbl;
    __device__ __forceinline__ void prepare(const Unit& u, int tid) const { rstd_table(tbl, part, u.pm, tid); }
    __device__ __forceinline__ void operator()(f32x4 (&acc)[2][2][4][2], const Unit& u, int wr, int wc, int fr, int fq) const {
        const int row0 = u.pm * BM + wr * 64 + fr, col0 = u.pn * HALF + wc * 32 + 8 * fq;
        const bool tb = __builtin_amdgcn_readfirstlane(((const LAS int*)tbl)[256]) == u.pm;
#pragma unroll
        for (int ai = 0; ai < 2; ++ai)
#pragma unroll
            for (int m = 0; m < 4; ++m) { const int row = row0 + ai * HALF + m * 16; const float rs = tb ? tbl[ai * HALF + wr * 64 + m * 16 + fr] : row_rstd(part, row, fq);
                const f32x2 rsl = (f32x2){-1.44269504089f * rs, -1.44269504089f * rs}, rs2 = (f32x2){rs * rs, rs * rs}; f32x2 o[4];
#pragma unroll
                for (int n = 0; n < 2; ++n)
#pragma unroll
                    for (int jp = 0; jp < 2; ++jp) { const f32x2 ag = (f32x2){acc[ai][0][m][n][2 * jp], acc[ai][0][m][n][2 * jp + 1]}, au = (f32x2){acc[ai][1][m][n][2 * jp], acc[ai][1][m][n][2 * jp + 1]};
                        const f32x2 t = ag * rsl; f32x2 d = (f32x2){__builtin_amdgcn_exp2f(t.x), __builtin_amdgcn_exp2f(t.y)}; d = d + 1.0f;
                        const f32x2 r = (f32x2){__builtin_amdgcn_rcpf(d.x), __builtin_amdgcn_rcpf(d.y)}; o[n * 2 + jp] = (ag * au) * (r * rs2); }
                u32x4 w; w.x = cvt_pk_bf16(o[0].x, o[0].y); w.y = cvt_pk_bf16(o[1].x, o[1].y); w.z = cvt_pk_bf16(o[2].x, o[2].y); w.w = cvt_pk_bf16(o[3].x, o[3].y);
                *(u32x4*)(O + (size_t)row * FF + col0) = w; }
    }
};
struct EpiResid {
    EPI_NO_PREPARE
    static constexpr bool PERM = true, AFTER_DRAIN = false, IS_RESID = true, IS_GU = false;
    bf16_t* hb; float* part; float alpha;
    __device__ __forceinline__ void load_half(u32x4 (&xk)[4][2], int ai, int row0, int col0) const {
#pragma unroll
        for (int m = 0; m < 4; ++m) { const bf16_t* bp = hb + (size_t)(row0 + ai * HALF + m * 16) * D + col0; xk[m][0] = *(const u32x4*)bp; xk[m][1] = *(const u32x4*)(bp + HALF); }
    }
    __device__ __forceinline__ void fold_half(f32x4 (&acc)[2][2][4][2], const u32x4 (&xk)[4][2], int ai) const {
#pragma unroll
        for (int m = 0; m < 4; ++m)
#pragma unroll
            for (int bj = 0; bj < 2; ++bj) { const u32x4 k = xk[m][bj];
                const f32x4 x0 = f16x4_to_f32((u32x2){k.x, k.y}), x1 = f16x4_to_f32((u32x2){k.z, k.w});
                acc[ai][bj][m][0] = x0 + acc[ai][bj][m][0] * alpha; acc[ai][bj][m][1] = x1 + acc[ai][bj][m][1] * alpha; }
    }
    __device__ __forceinline__ void store_half(const f32x4 (&acc)[2][2][4][2], int ai, int row0, int col0, int slot, int fq) const {
#pragma unroll
        for (int m = 0; m < 4; ++m) { const int row = row0 + ai * HALF + m * 16; bf16_t* bp = hb + (size_t)row * D + col0; float ss = 0.f;
#pragma unroll
            for (int bj = 0; bj < 2; ++bj) { const f32x4 x0 = acc[ai][bj][m][0], x1 = acc[ai][bj][m][1];
                u32x4 w; w.x = cvt_pk_h(x0[0], x0[1]); w.y = cvt_pk_h(x0[2], x0[3]); w.z = cvt_pk_h(x1[0], x1[1]); w.w = cvt_pk_h(x1[2], x1[3]);
                *(u32x4*)(bp + bj * HALF) = w;
                ss += ((x0[0] * x0[0] + x0[1] * x0[1]) + (x0[2] * x0[2] + x0[3] * x0[3])) + ((x1[0] * x1[0] + x1[1] * x1[1]) + (x1[2] * x1[2] + x1[3] * x1[3])); }
            ss += __shfl_xor(ss, 16); ss += __shfl_xor(ss, 32);
            if (fq == 0) part[(size_t)row * 32 + slot] = ss; }
    }
    __device__ __forceinline__ void operator()(f32x4 (&acc)[2][2][4][2], const Unit& u, int wr, int wc, int fr, int fq) const {
        const int row0 = u.pm * BM + wr * 64 + fr, col0 = u.pn * BM + wc * 32 + 8 * fq, slot = u.pn * 4 + wc;
        u32x4 xk[4][2], xk1[4][2];
        load_half(xk, 0, row0, col0);
#pragma unroll
        for (int m = 0; m < 3; ++m) { const bf16_t* bp = hb + (size_t)(row0 + HALF + m * 16) * D + col0; xk1[m][0] = *(const u32x4*)bp; xk1[m][1] = *(const u32x4*)(bp + HALF); }
        asm volatile("" ::: "memory");
        fold_half(acc, xk, 0); asm volatile("" ::: "memory");
        { const bf16_t* bp = hb + (size_t)(row0 + HALF + 3 * 16) * D + col0; xk1[3][0] = *(const u32x4*)bp; xk1[3][1] = *(const u32x4*)(bp + HALF); }
        asm volatile("" ::: "memory");
        store_half(acc, 0, row0, col0, slot, fq); asm volatile("" ::: "memory");
        fold_half(acc, xk1, 1);
        store_half(acc, 1, row0, col0, slot, fq);
    }
};
struct EpiRowScale {
    EPI_NO_PREPARE
    static constexpr bool PERM = true, AFTER_DRAIN = false, IS_RESID = false, IS_GU = false;
    bf16_t* O; int ldo; const float* part;
    __device__ __forceinline__ void operator()(f32x4 (&acc)[2][2][4][2], const Unit& u, int wr, int wc, int fr, int fq) const {
        const int row0 = u.pm * BM + wr * 64 + fr, col0 = u.pn * BM + wc * 32 + 8 * fq;
#pragma unroll
        for (int ai = 0; ai < 2; ++ai)
#pragma unroll
            for (int m = 0; m < 4; ++m) { const int row = row0 + ai * HALF + m * 16; const float rs = row_rstd(part, row, fq); bf16_t* rp = O + (size_t)row * ldo + col0;
#pragma unroll
                for (int bj = 0; bj < 2; ++bj) { const f32x4 v0 = acc[ai][bj][m][0] * rs, v1 = acc[ai][bj][m][1] * rs;
                    u32x4 w; w.x = cvt_pk_bf16(v0[0], v0[1]); w.y = cvt_pk_bf16(v0[2], v0[3]); w.z = cvt_pk_bf16(v1[0], v1[1]); w.w = cvt_pk_bf16(v1[2], v1[3]);
                    *(u32x4*)(rp + bj * HALF) = w; } }
    }
};
template <bool F16OUT> struct EpiPlain {
    EPI_NO_PREPARE
    static constexpr bool PERM = true, AFTER_DRAIN = false, IS_RESID = false, IS_GU = false;
    bf16_t* O; int ldo;
    __device__ __forceinline__ void operator()(f32x4 (&acc)[2][2][4][2], const Unit& u, int wr, int wc, int fr, int fq) const {
        const int row0 = u.pm * BM + wr * 64 + fr, col0 = u.pn * BM + wc * 32 + 8 * fq;
#pragma unroll
        for (int ai = 0; ai < 2; ++ai)
#pragma unroll
            for (int m = 0; m < 4; ++m) { bf16_t* rp = O + (size_t)(row0 + ai * HALF + m * 16) * ldo + col0;
#pragma unroll
                for (int bj = 0; bj < 2; ++bj) { const f32x4 v0 = acc[ai][bj][m][0], v1 = acc[ai][bj][m][1];
                    u32x4 w; w.x = cvt_pk16<F16OUT>(v0[0], v0[1]); w.y = cvt_pk16<F16OUT>(v0[2], v0[3]); w.z = cvt_pk16<F16OUT>(v1[0], v1[1]); w.w = cvt_pk16<F16OUT>(v1[2], v1[3]);
                    *(u32x4*)(rp + bj * HALF) = w; } }
    }
};
struct EpiLruIn {
    static constexpr bool PERM = true, AFTER_DRAIN = false, IS_RESID = false, IS_GU = false;
    bf16_t* gg; bf16_t* xr; const float* part; LAS float* tbl;
    __device__ __forceinline__ void prepare(const Unit& u, int tid) const { rstd_table(tbl, part, u.pm, tid); }
    __device__ __forceinline__ void operator()(f32x4 (&acc)[2][2][4][2], const Unit& u, int wr, int wc, int fr, int fq) const {
        const int row0 = u.pm * BM + wr * 64 + fr; const bool isg = u.pn < 8; const int col0 = (isg ? u.pn : u.pn - 8) * BM + wc * 32 + 8 * fq; bf16_t* O = isg ? gg : xr;
        const bool tb = __builtin_amdgcn_readfirstlane(((const LAS int*)tbl)[256]) == u.pm;
#pragma unroll
        for (int ai = 0; ai < 2; ++ai)
#pragma unroll
            for (int m = 0; m < 4; ++m) { const int row = row0 + ai * HALF + m * 16; const float rs = tb ? tbl[ai * HALF + wr * 64 + m * 16 + fr] : row_rstd(part, row, fq);
#pragma unroll
                for (int bj = 0; bj < 2; ++bj) { const f32x4 v0 = acc[ai][bj][m][0] * rs, v1 = acc[ai][bj][m][1] * rs; float o[8];
#pragma unroll
                    for (int j = 0; j < 8; ++j) { const float x = j < 4 ? v0[j] : v1[j - 4]; o[j] = isg ? x * fast_sigmoid(1.5957691216f * (x + 0.044715f * x * x * x)) : x; }
                    u32x4 w; w.x = cvt_pk_bf16(o[0], o[1]); w.y = cvt_pk_bf16(o[2], o[3]); w.z = cvt_pk_bf16(o[4], o[5]); w.w = cvt_pk_bf16(o[6], o[7]);
                    *(u32x4*)(O + (size_t)row * D + col0 + bj * HALF) = w; } }
    }
};
struct EpiGates {
    EPI_NO_PREPARE
    static constexpr bool PERM = true, AFTER_DRAIN = false, IS_RESID = false, IS_GU = false;
    bf16_t* LA; bf16_t* Bt; const bf16_t* xc; const float* ba; const float* bx; const float* sp8;
    __device__ __forceinline__ void operator()(f32x4 (&acc)[2][2][4][2], const Unit& u, int wr, int wc, int fr, int fq) const {
        const int row0 = u.pm * BM + wr * 64 + fr, c0 = u.pn * HALF + wc * 32 + 8 * fq;
        f32x4 bav[2], bxv[2], spv[2];
#pragma unroll
        for (int n = 0; n < 2; ++n) { bav[n] = *(const f32x4*)(ba + c0 + 4 * n); bxv[n] = *(const f32x4*)(bx + c0 + 4 * n); spv[n] = *(const f32x4*)(sp8 + c0 + 4 * n) * 1.44269504089f; }
        u32x4 xkv[8];
#pragma unroll
        for (int g = 0; g < 8; ++g) xkv[g] = *(const u32x4*)(xc + (size_t)(row0 + (g >> 2) * HALF + (g & 3) * 16) * D + c0);
        asm volatile("" ::: "memory");
#pragma unroll
        for (int ai = 0; ai < 2; ++ai)
#pragma unroll
            for (int m = 0; m < 4; ++m) { const int row = row0 + ai * HALF + m * 16; const u32x4 xk = xkv[ai * 4 + m]; float lo[8], bo[8];
#pragma unroll
                for (int n = 0; n < 2; ++n) { const unsigned k0 = n == 0 ? xk.x : xk.z, k1 = n == 0 ? xk.y : xk.w;
                    const f32x4 xv = (f32x4){__uint_as_float(k0 << 16), __uint_as_float(k0 & 0xffff0000u), __uint_as_float(k1 << 16), __uint_as_float(k1 & 0xffff0000u)};
#pragma unroll
                    for (int j = 0; j < 4; ++j) { const float r = fast_sigmoid(acc[ai][0][m][n][j] + bav[n][j]), ig = fast_sigmoid(acc[ai][1][m][n][j] + bxv[n][j]);
                        const float l2 = -r * spv[n][j];
                        const float l2r = __uint_as_float(cvt_pk_bf16(l2, l2) << 16);
                        const float t = 1.38629436112f * l2r;
                        const float ser = -t * (1.0f + 0.5f * t * (1.0f + (1.0f / 3.0f) * t * (1.0f + 0.25f * t * (1.0f + 0.2f * t * (1.0f + (1.0f / 6.0f) * t)))));
                        const float om = t > -0.3f ? ser : 1.0f - __builtin_amdgcn_exp2f(2.0f * l2r);
                        lo[n * 4 + j] = l2; bo[n * 4 + j] = sqrtf(om) * ig * xv[j]; } }
                u32x4 wl, wb; wl.x = cvt_pk_bf16(lo[0], lo[1]); wl.y = cvt_pk_bf16(lo[2], lo[3]); wl.z = cvt_pk_bf16(lo[4], lo[5]); wl.w = cvt_pk_bf16(lo[6], lo[7]);
                wb.x = cvt_pk_bf16(bo[0], bo[1]); wb.y = cvt_pk_bf16(bo[2], bo[3]); wb.z = cvt_pk_bf16(bo[4], bo[5]); wb.w = cvt_pk_bf16(bo[6], bo[7]);
                *(u32x4*)(LA + (size_t)row * D + c0) = wl; *(u32x4*)(Bt + (size_t)row * D + c0) = wb; }
    }
};
struct EpiSoftmax {
    EPI_NO_PREPARE
    static constexpr bool PERM = true, AFTER_DRAIN = true, IS_RESID = false, IS_GU = false;
    bf16_t* P; const float* part;
    __device__ __forceinline__ void fused(f32x4 (&acc)[2][2][4][2], const Unit& u, int wr, int wc, int fr, int fq, LAS unsigned char* lds, int wid, int lane) const {
        LAS float* X = (LAS float*)lds; LAS float* Y = (LAS float*)(lds + 4096);
#pragma unroll
        for (int ai = 0; ai < 2; ++ai)
#pragma unroll
            for (int m = 0; m < 4; ++m) { float mx = -3.0e38f; const float rs = row_rstd(part, u.pm * BM + ai * HALF + wr * 64 + m * 16 + fr, fq);
#pragma unroll
                for (int bj = 0; bj < 2; ++bj)
#pragma unroll
                    for (int n = 0; n < 2; ++n) { acc[ai][bj][m][n] = acc[ai][bj][m][n] * rs; const f32x4 x = acc[ai][bj][m][n]; mx = fmaxf(mx, fmaxf(fmaxf(x[0], x[1]), fmaxf(x[2], x[3]))); }
                mx = fmaxf(mx, __shfl_xor(mx, 16)); mx = fmaxf(mx, __shfl_xor(mx, 32));
                if (fq == 0) X[(ai * HALF + wr * 64 + m * 16 + fr) * 4 + wc] = mx; }
        LDS_WAIT(); __builtin_amdgcn_s_barrier(); asm volatile("" ::: "memory");
#pragma unroll
        for (int ai = 0; ai < 2; ++ai)
#pragma unroll
            for (int m = 0; m < 4; ++m) { const int r = ai * HALF + wr * 64 + m * 16 + fr; const f32x4 v = *(const LAS f32x4*)(X + r * 4);
                const float mx = fmaxf(fmaxf(v[0], v[1]), fmaxf(v[2], v[3])) * 1.44269504089f; float s = 0.f;
#pragma unroll
                for (int bj = 0; bj < 2; ++bj)
#pragma unroll
                    for (int n = 0; n < 2; ++n)
#pragma unroll
                        for (int j = 0; j < 4; ++j) { const float p = __builtin_amdgcn_exp2f(acc[ai][bj][m][n][j] * 1.44269504089f - mx); acc[ai][bj][m][n][j] = p; s += p; }
                s += __shfl_xor(s, 16); s += __shfl_xor(s, 32);
                if (fq == 0) Y[r * 4 + wc] = s; }
        LDS_WAIT(); __builtin_amdgcn_s_barrier(); asm volatile("" ::: "memory");
#pragma unroll
        for (int ai = 0; ai < 2; ++ai)
#pragma unroll
            for (int m = 0; m < 4; ++m) { const int r = ai * HALF + wr * 64 + m * 16 + fr; const f32x4 v = *(const LAS f32x4*)(Y + r * 4);
                const float inv = 1.0f / ((v[0] + v[1]) + (v[2] + v[3])); bf16_t* rp = P + (size_t)(u.pm * BM + r) * 1024 + u.pn * BM + wc * 32 + 8 * fq;
#pragma unroll
                for (int bj = 0; bj < 2; ++bj) { const f32x4 v0 = acc[ai][bj][m][0] * inv, v1 = acc[ai][bj][m][1] * inv;
                    u32x4 w; w.x = cvt_pk_bf16(v0[0], v0[1]); w.y = cvt_pk_bf16(v0[2], v0[3]); w.z = cvt_pk_bf16(v1[0], v1[1]); w.w = cvt_pk_bf16(v1[2], v1[3]);
                    *(u32x4*)(rp + bj * HALF) = w; } }
    }
};

template <bool F16> __device__ __forceinline__ f32x4 mma16(bf16x8 b, bf16x8 a, f32x4 c) {
    if constexpr (F16) return __builtin_amdgcn_mfma_f32_16x16x32_f16(__builtin_bit_cast(f16x8, b), __builtin_bit_cast(f16x8, a), c, 0, 0, 0);
    else return __builtin_amdgcn_mfma_f32_16x16x32_bf16(b, a, c, 0, 0, 0);
}
template <class Epi, bool ALIGN_EPI, int PID, class SchedT>
__device__ __forceinline__ void gemm_phase(LAS unsigned char* lds, const SchedT& S, const Epi& E, unsigned long long& pacc) {
    unsigned long long pt0 = 0, pt1 = 0; (void)pt0; (void)pt1;
    if constexpr (PROF_TAG == PID * 10 + 0) pt0 = PROF_NOW();
    { constexpr int ticks = Epi::IS_RESID ? STAGGER_TICKS : Epi::IS_GU ? STAGGER_GU_TICKS : 0;
      if constexpr (ticks > 0) { const unsigned grp = (blockIdx.x >> 3) & (Epi::IS_RESID ? (STAGGER_GROUPS - 1) : (STAGGER_GU_GROUPS - 1));
        if (grp) { const unsigned long long t0 = __builtin_amdgcn_s_memrealtime(), want = (unsigned long long)ticks * grp; while (__builtin_amdgcn_s_memrealtime() - t0 < want) __builtin_amdgcn_s_sleep(8); } } }
    int tid_ = threadIdx.x; asm volatile("" : "+v"(tid_));
    const int tid = tid_, wid = __builtin_amdgcn_readfirstlane(tid >> 6), lane = tid & 63, wr = wid >> 2, wc = wid & 3, fr = lane & 15, fq = lane >> 4;
    constexpr int K = SchedT::K, nt = K / BK;
    static_assert(K % 128 == 0 && K >= 256, "K multiple of 128, >= 256");
    unsigned voffA[2], voffB[2];
#pragma unroll
    for (int i = 0; i < 2; ++i) { int R, C; stage_rc(tid * 16 + i * 8192, R, C); const int Rb = Epi::PERM ? ((R & ~31) + perm32(R & 31)) : R;
        voffA[i] = (unsigned)(R * SchedT::lda + C) * 2u; voffB[i] = (unsigned)(Rb * SchedT::ldb + C) * 2u; }
    constexpr long kstep = SchedT::KREV ? -(long)(BK * 2) : (long)(BK * 2);
    constexpr size_t hstepA = (size_t)HALF * SchedT::lda * 2, hstepB = (size_t)HALF * SchedT::ldb * 2;
    const unsigned ldsw = (unsigned)wid * 1024u;
    const int aoff = lds_byte(wr * 64 + fr, fq * 8), boff = lds_byte(wc * 32 + fr, fq * 8);
#define PG8_SA(b, h) (((b) * 2 + (h)) * HTB)
#define PG8_SB(b, h) ((4 + (b) * 2 + (h)) * HTB)
#define PG8_STAGE(bufoff, gbase, voff) do { _Pragma("unroll") for (int _i = 0; _i < 2; ++_i) \
        __builtin_amdgcn_global_load_lds((const unsigned*)((const char*)(gbase) + (voff)[_i]), (LAS unsigned*)(lds + (bufoff) + ldsw + _i * 8192), 16, 0, 0); } while (0)
#define PG8_LDA(dst, b, h) do { _Pragma("unroll") for (int m = 0; m < 4; ++m) _Pragma("unroll") for (int k = 0; k < 2; ++k) dst[m][k] = *(const LAS bf16x8*)(lds + PG8_SA(b, h) + aoff + m * 2048 + k * 1024); } while (0)
#define PG8_LDB(dst, b, h) do { _Pragma("unroll") for (int n = 0; n < 2; ++n) _Pragma("unroll") for (int k = 0; k < 2; ++k) dst[n][k] = *(const LAS bf16x8*)(lds + PG8_SB(b, h) + boff + n * 2048 + k * 1024); } while (0)
#define PG8_MMA(ai, bj, At, Bt) do { __builtin_amdgcn_s_setprio(1); _Pragma("unroll") for (int m = 0; m < 4; ++m) _Pragma("unroll") for (int n = 0; n < 2; ++n) _Pragma("unroll") for (int k = 0; k < 2; ++k) \
        acc[ai][bj][m][n] = mma16<SchedT::F16>(Bt[n][k], At[m][k], acc[ai][bj][m][n]); __builtin_amdgcn_s_setprio(0); } while (0)
#define PG8_MMAZ(ai, bj, At, Bt) do { __builtin_amdgcn_s_setprio(1); _Pragma("unroll") for (int m = 0; m < 4; ++m) _Pragma("unroll") for (int n = 0; n < 2; ++n) \
        acc[ai][bj][m][n] = mma16<SchedT::F16>(Bt[n][0], At[m][0], (f32x4){0.f, 0.f, 0.f, 0.f}); \
        _Pragma("unroll") for (int m = 0; m < 4; ++m) _Pragma("unroll") for (int n = 0; n < 2; ++n) acc[ai][bj][m][n] = mma16<SchedT::F16>(Bt[n][1], At[m][1], acc[ai][bj][m][n]); __builtin_amdgcn_s_setprio(0); } while (0)
#define PG8_WAIT_V(n) asm volatile("s_waitcnt vmcnt(" #n ")" ::: "memory")
#define PG8_WAIT_L(n) asm volatile("s_waitcnt lgkmcnt(" #n ")" ::: "memory")
#define PG8_BAR __builtin_amdgcn_s_barrier()
#define PG8_SCHED __builtin_amdgcn_sched_barrier(0)
    Unit cur, nxt; int ui = 0;
    if (!S.next(0, cur)) return;
    E.prepare(cur, tid);
    f32x4 acc[2][2][4][2];
    bf16x8 At[4][2], B0[2][2], B1[2][2];
    const char* cA = cur.a; const char* cB = cur.b;
    PG8_STAGE(PG8_SB(0, 0), cB, voffB); PG8_STAGE(PG8_SB(0, 1), cB + hstepB, voffB); PG8_STAGE(PG8_SA(0, 0), cA, voffA); PG8_STAGE(PG8_SA(0, 1), cA + hstepA, voffA);
    if (wr == 1) PG8_BAR;
    PG8_WAIT_V(2); PG8_BAR;
    PG8_STAGE(PG8_SB(1, 0), cB + kstep, voffB); PG8_STAGE(PG8_SA(1, 0), cA + kstep, voffA); PG8_STAGE(PG8_SB(1, 1), cB + hstepB + kstep, voffB); PG8_STAGE(PG8_SA(1, 1), cA + hstepA + kstep, voffA);
    PG8_WAIT_V(8); PG8_BAR;
    for (;;) {
        const bool has_next = S.next(ui + 1, nxt);
        const char* nA = has_next ? nxt.a : cA; const char* nB = has_next ? nxt.b : cB;
        if constexpr (PROF_TAG == PID * 10 + 1) pt0 = PROF_NOW();
#define PG8_KITER(FIRST) \
              \
            PG8_LDB(B0, 0, 0); PG8_LDB(B1, 0, 1); PG8_SCHED; PG8_LDA(At, 0, 0); if constexpr (!(FIRST)) PG8_STAGE(PG8_SA(1, 1), a1 + hstepA, voffA); \
            PG8_WAIT_V(8); PG8_WAIT_L(0); PG8_BAR; if constexpr (FIRST) { PG8_MMAZ(0, 0, At, B0); PG8_MMAZ(0, 1, At, B1); } else { PG8_MMA(0, 0, At, B0); PG8_MMA(0, 1, At, B1); } PG8_BAR; PG8_SCHED; \
              \
            PG8_LDA(At, 0, 1); PG8_STAGE(PG8_SB(0, 0), b2, voffB); PG8_STAGE(PG8_SB(0, 1), b2 + hstepB, voffB); PG8_STAGE(PG8_SA(0, 0), a2, voffA); \
            PG8_WAIT_V(8); PG8_WAIT_L(0); PG8_BAR; if constexpr (FIRST) { PG8_MMAZ(1, 0, At, B0); PG8_MMAZ(1, 1, At, B1); } else { PG8_MMA(1, 0, At, B0); PG8_MMA(1, 1, At, B1); } PG8_BAR; PG8_SCHED; \
              \
            PG8_LDB(B0, 1, 0); PG8_LDB(B1, 1, 1); PG8_SCHED; PG8_LDA(At, 1, 0); PG8_STAGE(PG8_SA(0, 1), a2 + hstepA, voffA); \
            PG8_WAIT_V(8); PG8_WAIT_L(0); PG8_BAR; PG8_MMA(0, 0, At, B0); PG8_MMA(0, 1, At, B1); PG8_BAR; PG8_SCHED; \
              \
            PG8_LDA(At, 1, 1); PG8_STAGE(PG8_SB(1, 0), b3, voffB); PG8_STAGE(PG8_SB(1, 1), b3 + hstepB, voffB); PG8_STAGE(PG8_SA(1, 0), a3, voffA); \
            PG8_WAIT_V(8); PG8_WAIT_L(0); PG8_BAR; PG8_MMA(1, 0, At, B0); PG8_MMA(1, 1, At, B1); PG8_BAR; PG8_SCHED;
        int tp = 2; asm volatile("" : "+v"(tp)); tp = __builtin_amdgcn_readfirstlane(tp);
#pragma unroll 1
        for (int tq = 0; tq < tp; tq += 2) { asm volatile("" : "+v"(voffA[0]), "+v"(voffA[1]), "+v"(voffB[0]), "+v"(voffB[1]));
          const char* a1 = cA + kstep; (void)a1; const char* a2 = cA + 2 * kstep; const char* b2 = cB + 2 * kstep; const char* a3 = a2 + kstep; const char* b3 = b2 + kstep;
          PG8_KITER(true) }
#pragma unroll 1
        for (int t = 2; t < nt; t += 2) {
            asm volatile("" : "+v"(voffA[0]), "+v"(voffA[1]), "+v"(voffB[0]), "+v"(voffB[1]));
            const bool last = (t == nt - 2);
            if constexpr (PROF_TAG == PID * 10 + 5) { if (t == 2) pt0 = PROF_NOW(); }
            const char* a1 = cA + (long)(t + 1) * kstep;
            const char* a2 = last ? nA : cA + (long)(t + 2) * kstep; const char* b2 = last ? nB : cB + (long)(t + 2) * kstep;
            const char* a3 = a2 + kstep; const char* b3 = b2 + kstep;
            PG8_KITER(false)
            if constexpr (PROF_TAG == PID * 10 + 5) { if (t == 2) pacc += PROF_NOW() - pt0; }
        }
        if constexpr (PROF_TAG == PID * 10 + 1) pacc += PROF_NOW() - pt0;
        if constexpr (PROF_TAG == PID * 10 + 2) pt0 = PROF_NOW();
        if constexpr (ALIGN_EPI) { if (wr == 0) PG8_BAR; }
        if (has_next) PG8_STAGE(PG8_SA(1, 1), nA + kstep + hstepA, voffA);
        if constexpr (PROF_TAG == PID * 10 + 3) pt0 = PROF_NOW();
        if constexpr (!Epi::AFTER_DRAIN) { int te_ = threadIdx.x; asm volatile("" : "+v"(te_));
            const int fr_e = te_ & 15, fq_e = (te_ & 63) >> 4; E(acc, cur, wr, wc, fr_e, fq_e); }
        if constexpr (PROF_TAG == PID * 10 + 2 || PROF_TAG == PID * 10 + 3) pacc += PROF_NOW() - pt0;
        if (!has_next) break;
        cur = nxt; cA = nA; cB = nB; ++ui;
        if constexpr (ALIGN_EPI) { if (wr == 1) PG8_BAR; }
    }
    PG8_WAIT_V(0);
    if constexpr (!ALIGN_EPI) { if (wr == 0) PG8_BAR; }
    PG8_BAR;
    if constexpr (Epi::AFTER_DRAIN) { E.fused(acc, cur, wr, wc, fr, fq, lds, wid, lane); }
    if constexpr (PROF_TAG == PID * 10 + 0) pacc += PROF_NOW() - pt0;
#undef PG8_SA
#undef PG8_SB
#undef PG8_STAGE
#undef PG8_LDA
#undef PG8_LDB
#undef PG8_MMA
#undef PG8_WAIT_V
#undef PG8_WAIT_L
#undef PG8_BAR
#undef PG8_SCHED
}
}

constexpr size_t MiB = 1u << 20;
constexpr size_t WS_CTL = 0, CTL_ZERO_BYTES = 1 * MiB;
constexpr size_t WS_SP = 1 * MiB;
constexpr size_t WS_CHA = 2 * MiB, WS_CHB = 4 * MiB;
constexpr size_t WS_PART = 6 * MiB;
constexpr size_t WS_MB = 8 * MiB;
constexpr size_t WS_KV = 12 * MiB;
constexpr size_t WS_WGU = 48 * MiB;
constexpr size_t WS_WD = 400 * MiB;
constexpr size_t WS_WQN = 576 * MiB;
constexpr size_t WS_WK = 608 * MiB, WS_WV = 640 * MiB, WS_WO = 672 * MiB;
constexpr size_t WS_WIN = 704 * MiB;
constexpr size_t WS_WOUT = 736 * MiB;
constexpr size_t WS_WP = 752 * MiB;
constexpr size_t WS_WGATE = 756 * MiB;
constexpr size_t WS_HB = 760 * MiB;
constexpr size_t WS_ACT = 824 * MiB;
constexpr size_t WS_S = 1000 * MiB;
constexpr size_t WS_P = WS_S;
constexpr size_t WS_POOLED = WS_S;
constexpr size_t WS_GG = WS_S, WS_BT = WS_S + 64 * MiB, WS_XCB = WS_S + 192 * MiB;
constexpr size_t WS_XR = WS_ACT;
constexpr size_t WS_LA = WS_ACT + 64 * MiB;
constexpr size_t WS_GALL = WS_S + 256 * MiB;
constexpr size_t WS_HALL = WS_S + 320 * MiB;
constexpr size_t WS_END = WS_S + 384 * MiB;
constexpr int CW_BAR = 4096;
constexpr int LDS_BYTES = 147456, MISC_OFF = LDS_BYTES - 512, EPI_TBL_OFF = 131072;

#define XB_TMO      128
#define XB_XCNT(j)  (256  + 64 * (j))
#define XB_XSUB(j)  (1280 + 64 * (j))
#define XB_XGEN(j)  (2304 + 64 * (j))
#define XB_TOP      3328
#define XB_TOPGEN   3392
#define XCD_BAR_WORDS 3456
#define XB_SPIN_CAP (1u << 18)
__device__ __forceinline__ unsigned xb_ld(unsigned* p)              { return __hip_atomic_load(p, __ATOMIC_RELAXED, __HIP_MEMORY_SCOPE_AGENT); }
__device__ __forceinline__ unsigned xb_add(unsigned* p, unsigned v) { return __hip_atomic_fetch_add(p, v, __ATOMIC_RELAXED, __HIP_MEMORY_SCOPE_AGENT); }
__device__ __forceinline__ unsigned xb_xcc_id() { return (unsigned)__builtin_amdgcn_s_getreg((3 << 11) | 20) & 0xFu; }
#define XB_SPIN(cond, bar) do { unsigned _sp = 0; while (cond) { __builtin_amdgcn_s_sleep(1); \
    if ((++_sp & 255u) == 0u) { if (xb_ld(&(bar)[XB_TMO])) break; if (_sp > XB_SPIN_CAP) { atomicAdd(&(bar)[XB_TMO], 1u); break; } } } } while (0)
struct XcdBarrier { unsigned* bar; unsigned x; volatile LAS unsigned* st; };
__device__ __forceinline__ XcdBarrier xcd_barrier_post(unsigned* bar, volatile LAS unsigned* st) {
    XcdBarrier b; b.bar = bar; b.x = xb_xcc_id(); b.st = st;
    if (threadIdx.x == 0) (void)xb_add(&bar[XB_XCNT(b.x)], 1u);
    return b;
}
__device__ __forceinline__ void xcd_barrier_complete(unsigned* bar, unsigned x, unsigned& nloc, unsigned& nx) {
    const unsigned G = gridDim.x * gridDim.y * gridDim.z;
    unsigned sum, cnt, mine, sp = 0u;
    for (;;) {
        sum = 0u; cnt = 0u; mine = 0u;
#pragma unroll
        for (unsigned j = 0; j < 16; ++j) { const unsigned c = xb_ld(&bar[XB_XCNT(j)]); sum += c; cnt += (c > 0u) ? 1u : 0u; mine = (j == x) ? c : mine; }
        if (sum == G) break;
        __builtin_amdgcn_s_sleep(1);
        if ((++sp & 255u) == 0u) { if (xb_ld(&bar[XB_TMO])) break; if (sp > XB_SPIN_CAP) { atomicAdd(&bar[XB_TMO], 1u); break; } }
    }
    nloc = mine > 0u ? mine : 1u; nx = cnt > 0u ? cnt : 1u;
}
__device__ __forceinline__ void xcd_barrier(const XcdBarrier& b) {
    asm volatile("s_waitcnt vmcnt(0)" ::: "memory");
    __syncthreads();
    if (threadIdx.x == 0) {
        unsigned* bar = b.bar;
        __builtin_amdgcn_s_waitcnt(0);
        unsigned nloc = b.st[0], nx = b.st[1];
        if (nloc == 0u) { xcd_barrier_complete(bar, b.x, nloc, nx); b.st[0] = nloc; b.st[1] = nx; }
        const unsigned old = xb_add(&bar[XB_XSUB(b.x)], 1u);
        const unsigned gen = old / nloc;
        if (old + 1u == (gen + 1u) * nloc) {
            __builtin_amdgcn_fence(__ATOMIC_RELEASE, "agent");
            asm volatile("s_waitcnt vmcnt(0)" ::: "memory");
            const unsigned og = xb_add(&bar[XB_TOP], 1u);
            const unsigned tg = og / nx;
            if (og + 1u == (tg + 1u) * nx) xb_add(&bar[XB_TOPGEN], 1u);
            else XB_SPIN(xb_ld(&bar[XB_TOPGEN]) == tg, bar);
            __builtin_amdgcn_fence(__ATOMIC_ACQUIRE, "agent");
            xb_add(&bar[XB_XGEN(b.x)], 1u);
            asm volatile("s_waitcnt vmcnt(0)" ::: "memory");
        } else {
            XB_SPIN(xb_ld(&bar[XB_XGEN(b.x)]) == gen, bar);
            __builtin_amdgcn_fence(__ATOMIC_ACQUIRE, "agent");
            asm volatile("s_waitcnt vmcnt(0)" ::: "memory");
        }
    }
    __syncthreads();
}

template <bool F16OUT = false>
__device__ __forceinline__ void tr_item(const float* src, int ldw, bf16_t* dst, int ldd, const float* ks, const float* ns, float sc, bf16_t* dstz, LAS float* scr, int lane) {
    f32x4 v[16];
    const float* s0 = src + (size_t)(lane >> 4) * ldw + (lane & 15) * 4;
#pragma unroll
    for (int i = 0; i < 16; ++i) v[i] = *(const f32x4*)(s0 + (size_t)(4 * i) * ldw);
#pragma unroll
    for (int i = 0; i < 16; ++i) { LAS float* p = scr + ((lane >> 4) + 4 * i) * 65 + (lane & 15) * 4; p[0] = v[i][0]; p[1] = v[i][1]; p[2] = v[i][2]; p[3] = v[i][3]; }
    LDS_WAIT(); asm volatile("" ::: "memory");
    const int c = lane & 7;
    f32x4 k0v = (f32x4){sc, sc, sc, sc}, k1v = k0v;
    if (ks) { k0v = *(const f32x4*)(ks + 8 * c) * sc; k1v = *(const f32x4*)(ks + 8 * c + 4) * sc; }
#pragma unroll
    for (int j = 0; j < 8; ++j) { const int n = (lane >> 3) + 8 * j; const LAS float* s = scr + (8 * c) * 65 + n; const float nsv = ns ? ns[n] : 1.0f;
        u32x4 o; o.x = cvt_pk16<F16OUT>(s[0 * 65] * k0v[0] * nsv, s[1 * 65] * k0v[1] * nsv); o.y = cvt_pk16<F16OUT>(s[2 * 65] * k0v[2] * nsv, s[3 * 65] * k0v[3] * nsv);
        o.z = cvt_pk16<F16OUT>(s[4 * 65] * k1v[0] * nsv, s[5 * 65] * k1v[1] * nsv); o.w = cvt_pk16<F16OUT>(s[6 * 65] * k1v[2] * nsv, s[7 * 65] * k1v[3] * nsv);
        *(u32x4*)(dst + (size_t)n * ldd + 8 * c) = o;
        if (dstz) *(u32x4*)(dstz + (size_t)n * ldd + 8 * c) = (u32x4){0u, 0u, 0u, 0u}; }
    LDS_WAIT(); asm volatile("" ::: "memory");
}

struct TrItem { const float* src; bf16_t* dst; const float* ks; const float* ns; bf16_t* dstz; int ldw, ldd, f16; };
__device__ __forceinline__ void tr_load(const TrItem& t, f32x4 (&v)[16], int lane) {
    const float* s0 = t.src + (size_t)(lane >> 4) * t.ldw + (lane & 15) * 4;
#pragma unroll
    for (int i = 0; i < 16; ++i) v[i] = *(const f32x4*)(s0 + (size_t)(4 * i) * t.ldw);
}
template <bool F16OUT>
__device__ __forceinline__ void tr_finish_t(const TrItem& t, const f32x4 (&v)[16], LAS float* scr, int lane) {
#pragma unroll
    for (int i = 0; i < 16; ++i) { LAS float* p = scr + ((lane >> 4) + 4 * i) * 65 + (lane & 15) * 4; p[0] = v[i][0]; p[1] = v[i][1]; p[2] = v[i][2]; p[3] = v[i][3]; }
    LDS_WAIT(); asm volatile("" ::: "memory");
    const int c = lane & 7;
    f32x4 k0v = (f32x4){1.f, 1.f, 1.f, 1.f}, k1v = k0v;
    if (t.ks) { k0v = *(const f32x4*)(t.ks + 8 * c); k1v = *(const f32x4*)(t.ks + 8 * c + 4); }
#pragma unroll
    for (int j = 0; j < 8; ++j) { const int n = (lane >> 3) + 8 * j; const LAS float* s = scr + (8 * c) * 65 + n; const float nsv = t.ns ? t.ns[n] : 1.0f;
        u32x4 o; o.x = cvt_pk16<F16OUT>(s[0 * 65] * k0v[0] * nsv, s[1 * 65] * k0v[1] * nsv); o.y = cvt_pk16<F16OUT>(s[2 * 65] * k0v[2] * nsv, s[3 * 65] * k0v[3] * nsv);
        o.z = cvt_pk16<F16OUT>(s[4 * 65] * k1v[0] * nsv, s[5 * 65] * k1v[1] * nsv); o.w = cvt_pk16<F16OUT>(s[6 * 65] * k1v[2] * nsv, s[7 * 65] * k1v[3] * nsv);
        *(u32x4*)(t.dst + (size_t)n * t.ldd + 8 * c) = o;
        if (t.dstz) *(u32x4*)(t.dstz + (size_t)n * t.ldd + 8 * c) = (u32x4){0u, 0u, 0u, 0u}; }
    LDS_WAIT(); asm volatile("" ::: "memory");
}
__device__ __forceinline__ void tr_finish(const TrItem& t, const f32x4 (&v)[16], LAS float* scr, int lane) { if (t.f16) tr_finish_t<true>(t, v, scr, lane); else tr_finish_t<false>(t, v, scr, lane); }
template <class T> __device__ __forceinline__ T* uniform_ptr(T* p) {
    const unsigned long long v = (unsigned long long)p; const unsigned lo = __builtin_amdgcn_readfirstlane((unsigned)v), hi = __builtin_amdgcn_readfirstlane((unsigned)(v >> 32));
    return (T*)(((unsigned long long)hi << 32) | lo);
}
struct Args { const float* in[25]; float* out; unsigned char* ws; int step, phase; };

__device__ __forceinline__ void prologue(const Args& args, LAS unsigned char* lds, int lane, int wave, int bx, int G) {
    unsigned char* ws = args.ws;
    LAS float* scr = (LAS float*)(lds + wave * 16640);
    const int gw = bx * 8 + wave, NGW = G * 8;
    constexpr int I_GU = 32 * 88, N_GU = 16 * I_GU, I_D = 88 * 32, N_D = 8 * I_D, I_SQ = 32 * 32, N_SQ = 12 * I_SQ, I_IN = 32 * 64, N_IN = 2 * I_IN, I_OUT = 32 * 32, N_OUT = 2 * I_OUT,
                  I_P = 8 * 8, N_P = 8 * I_P, I_G = 4, N_G = 64 * I_G, NITEMS = N_GU + N_D + N_SQ + N_IN + N_OUT + N_P + N_G;
#define TR_KB(item, NB) (2 * (((item) >> 3) / ((NB) / 4)) + (((item) & 7) >> 2))
#define TR_NB(item, NB) (4 * (((item) >> 3) % ((NB) / 4)) + ((item) & 3))
    auto decode = [&](int it) -> TrItem { TrItem t; t.ks = nullptr; t.ns = nullptr; t.dstz = nullptr; t.f16 = 0; int r = it;
        if (r < N_GU) { const int mat = r / I_GU, item = r % I_GU, lw = mat >> 1, up = mat & 1, k0 = TR_KB(item, 88) * 64, n0 = TR_NB(item, 88) * 64;
            t.src = (up ? args.in[4] : args.in[3]) + (size_t)lw * D * FF + (size_t)k0 * FF + n0; t.ldw = FF;
            t.dst = (bf16_t*)(ws + WS_WGU) + (size_t)lw * (2 * FF) * D + (size_t)(256 * (n0 >> 7) + (n0 & 127) + up * 128) * D + k0; t.ldd = D; t.ks = args.in[2] + lw * D + k0; t.f16 = 1; return t; }
        r -= N_GU;
        if (r < N_D) { const int lw = r / I_D, item = r % I_D, k0 = TR_KB(item, 32) * 64, n0 = TR_NB(item, 32) * 64;
            t.src = args.in[5] + (size_t)lw * FF * D + (size_t)k0 * D + n0; t.ldw = D; t.dst = (bf16_t*)(ws + WS_WD) + (size_t)lw * D * FF + (size_t)n0 * FF + k0; t.ldd = FF; return t; }
        r -= N_D;
        if (r < N_SQ) { const int mat = r / I_SQ, item = r % I_SQ, which = mat >> 2, L = mat & 3, k0 = TR_KB(item, 32) * 64, n0 = TR_NB(item, 32) * 64;
            t.src = (which == 0 ? args.in[21] : which == 1 ? args.in[22] : args.in[23]) + (size_t)L * D * D + (size_t)k0 * D + n0; t.ldw = D;
            t.dst = (bf16_t*)(ws + WS_WK + (size_t)which * 32 * MiB) + (size_t)L * D * D + (size_t)n0 * D + k0; t.ldd = D; return t; }
        r -= N_SQ;
        if (r < N_IN) { const int j = r / I_IN, item = r % I_IN, k0 = TR_KB(item, 64) * 64, n0 = TR_NB(item, 64) * 64;
            t.src = args.in[9] + (size_t)j * D * 4096 + (size_t)k0 * 4096 + n0; t.ldw = 4096; t.dst = (bf16_t*)(ws + WS_WIN) + (size_t)j * 4096 * D + (size_t)n0 * D + k0; t.ldd = D; t.ks = args.in[6] + (2 * j + 1) * D + k0; t.f16 = 1; return t; }
        r -= N_IN;
        if (r < N_OUT) { const int j = r / I_OUT, item = r % I_OUT, k0 = TR_KB(item, 32) * 64, n0 = TR_NB(item, 32) * 64;
            t.src = args.in[17] + (size_t)j * D * D + (size_t)k0 * D + n0; t.ldw = D; t.dst = (bf16_t*)(ws + WS_WOUT) + (size_t)j * D * D + (size_t)n0 * D + k0; t.ldd = D; return t; }
        r -= N_OUT;
        if (r < N_P) { const int mat = r / I_P, item = r % I_P, j = mat >> 2, g = mat & 3, k0 = TR_KB(item, 8) * 64, n0 = TR_NB(item, 8) * 64;
            t.src = args.in[7] + (size_t)mat * 512 * 512 + (size_t)k0 * 512 + n0; t.ldw = 512; t.dst = (bf16_t*)(ws + WS_WP) + (size_t)j * D * 512 + (size_t)(g * 512 + n0) * 512 + k0; t.ldd = 512;
            t.ks = args.in[6] + (2 * j) * D + g * 512 + k0; t.ns = args.in[8] + j * D + g * 512 + n0; return t; }
        r -= N_P;
        { const int mat = r / I_G, item = r % I_G, j = mat >> 5, isx = (mat >> 4) & 1, hh = mat & 15, k0 = (item >> 1) * 64, n0 = (item & 1) * 64;
            bf16_t* rowp = (bf16_t*)(ws + WS_WGATE) + (size_t)j * 4096 * 256 + (size_t)(hh * 256 + isx * 128 + n0) * 256;
            t.src = (isx ? args.in[14] : args.in[12]) + (size_t)(j * 16 + hh) * 128 * 128 + (size_t)k0 * 128 + n0; t.ldw = 128; t.dst = rowp + (hh & 1) * 128 + k0; t.ldd = 256; t.dstz = rowp + ((hh & 1) ^ 1) * 128 + k0; return t; } };
    if (gw < NITEMS) { int it = gw; TrItem a = decode(it), b = a; f32x4 va[16], vb[16]; tr_load(a, va, lane);
        for (;;) { const int itb = it + NGW; const bool hasb = itb < NITEMS;
            if (hasb) { b = decode(itb); tr_load(b, vb, lane); }
            asm volatile("" ::: "memory");
            tr_finish(a, va, scr, lane);
            if (!hasb) break;
            const int ita = itb + NGW; const bool hasa = ita < NITEMS;
            if (hasa) { a = decode(ita); tr_load(a, va, lane); }
            asm volatile("" ::: "memory");
            tr_finish(b, vb, scr, lane);
            if (!hasa) break;
            it = ita; } }
    { bf16_t* wqn = (bf16_t*)(ws + WS_WQN);
      for (int row0 = gw; row0 < 4 * D; row0 += 4 * NGW) { f32x4 vv[4][8];
#pragma unroll
          for (int r = 0; r < 4; ++r) { const int row = row0 + r * NGW; if (row < 4 * D) { const f32x4* xr = (const f32x4*)(args.in[20] + (size_t)row * D) + lane;
#pragma unroll
              for (int j = 0; j < 8; ++j) vv[r][j] = xr[64 * j]; } }
#pragma unroll
          for (int r = 0; r < 4; ++r) { const int row = row0 + r * NGW; if (row < 4 * D) { const float sck = args.in[18][row] * 0.04419417382415922f; u32x2* br = (u32x2*)(wqn + (size_t)row * D) + lane;
#pragma unroll
              for (int j = 0; j < 8; ++j) { const f32x4 v = vv[r][j] * sck; u32x2 w; w.x = cvt_pk_bf16(v[0], v[1]); w.y = cvt_pk_bf16(v[2], v[3]); br[64 * j] = w; } } } } }
    { const float* x = args.in[0]; bf16_t* hb = (bf16_t*)(ws + WS_HB); float* part = (float*)(ws + WS_PART);
      for (int row0 = gw; row0 < M; row0 += 4 * NGW) { f32x4 vv[4][8];
#pragma unroll
          for (int r = 0; r < 4; ++r) { const int row = row0 + r * NGW; if (row < M) { const f32x4* xr = (const f32x4*)(x + (size_t)row * D) + lane;
#pragma unroll
              for (int j = 0; j < 8; ++j) vv[r][j] = xr[64 * j]; } }
#pragma unroll
          for (int r = 0; r < 4; ++r) { const int row = row0 + r * NGW; if (row < M) { float ss = 0.f;
#pragma unroll
              for (int j = 0; j < 8; ++j) { const f32x4 v = vv[r][j]; ss += (v[0] * v[0] + v[1] * v[1]) + (v[2] * v[2] + v[3] * v[3]); }
              ss = wave_sum(ss);
              u32x2* br = (u32x2*)(hb + (size_t)row * D) + lane;
#pragma unroll
              for (int j = 0; j < 8; ++j) { const f32x4 v = vv[r][j]; u32x2 w; w.x = cvt_pk_h(v[0], v[1]); w.y = cvt_pk_h(v[2], v[3]); br[64 * j] = w; }
              if (lane < 32) part[(size_t)row * 32 + lane] = lane == 0 ? ss : 0.f; } } } }
    { const float* mem = args.in[1]; const float* g = args.in[19]; bf16_t* mb = (bf16_t*)(ws + WS_MB);
      for (int row = gw; row < MM; row += NGW) { const f32x4* xr = (const f32x4*)(mem + (size_t)row * D) + lane; f32x4 v[8]; float ss = 0.f;
#pragma unroll
          for (int j = 0; j < 8; ++j) { v[j] = xr[64 * j]; ss += (v[j][0] * v[j][0] + v[j][1] * v[j][1]) + (v[j][2] * v[j][2] + v[j][3] * v[j][3]); }
          const float rs = rsqrtf(wave_sum(ss) * (1.0f / 2048.0f) + EPS); u32x2* br = (u32x2*)(mb + (size_t)row * D) + lane;
#pragma unroll
          for (int j = 0; j < 8; ++j) { const f32x4 gv = *((const f32x4*)g + lane + 64 * j); const f32x4 o = v[j] * rs * gv; u32x2 w; w.x = cvt_pk_bf16(o[0], o[1]); w.y = cvt_pk_bf16(o[2], o[3]); br[64 * j] = w; } } }
    { const float* lam = args.in[16]; float* sp = (float*)(ws + WS_SP);
      for (int i = gw * 64 + lane; i < 2 * D; i += NGW * 64) { const float z = -lam[i]; sp[i] = 8.0f * (fmaxf(z, 0.f) + log1pf(expf(-fabsf(z)))); } }
}

constexpr int PD = 256 * D * 2;
typedef pg8::Sched<M,      2 * FF,  D,   D,    D,      PD,            0,       0,   PD,             0,                0, false, true> ShGU;
typedef pg8::Sched<M,      D,       FF,  FF,   FF,     256 * FF * 2,  0,       0,   256 * FF * 2,   0,                0, DOWN_KREV, false, DOWN_WGM> ShDown;
typedef pg8::Sched<M,      D,       512, D,    512,    PD,            512 * 2, 1,   256 * 512 * 2,  0,                0> ShPool;
typedef pg8::Sched<M,      2 * D,   D,   D,    D,      PD,            0,       0,   PD,             0,                0, false, true> ShLruIn;
typedef pg8::Sched<M,      2 * D,   256, D,    256,    PD,            256 * 2, 1,   256 * 256 * 2,  0,                0> ShGates;
typedef pg8::Sched<M,      D,       D,   D,    D,      PD,            0,       0,   PD,             0,                0> ShDD;
typedef pg8::Sched<M,      NH*MEML, D,   D,    D,      PD,            0,       0,   256 * D * 2,    1024 * D * 2,     4, false, true> ShScore;
typedef pg8::Sched<M,      D,       1024, 1024, 4096,  256 * 1024 * 2, 0,      0,   256 * 4096 * 2, 1024 * 2,         4> ShAO;
typedef pg8::Sched<MM,     8 * D,   D,   D,    D,      PD,            0,       0,   PD,             0,                0> ShKV;

#define LD_BF4P(p) f16x4_to_f32(*(const u32x2*)(p))
__device__ __forceinline__ unsigned long long launder_u64(unsigned long long v) {
    unsigned z; asm volatile("v_mov_b32 %0, 0" : "=v"(z));
    unsigned lo = (unsigned)v ^ z, hi = (unsigned)(v >> 32) ^ z; asm volatile("" : "+v"(lo), "+v"(hi));
    return ((unsigned long long)(unsigned)__builtin_amdgcn_readfirstlane(hi) << 32) | (unsigned)__builtin_amdgcn_readfirstlane(lo);
}
#define PHASE_VARS() int tid = threadIdx.x; asm volatile("" : "+v"(tid)); unsigned char* ws = (unsigned char*)(GAS unsigned char*)launder_u64((unsigned long long)args.ws); \
    bf16_t* hb = (bf16_t*)(ws + WS_HB); float* part = (float*)(ws + WS_PART); (void)tid; (void)hb; (void)part
__global__ void __launch_bounds__(512, 2) mk_fwd(Args args) {
    extern __shared__ __attribute__((aligned(16))) unsigned char lds_raw[];
    LAS unsigned char* lds = (LAS unsigned char*)lds_raw;
    const int G = gridDim.x, bx = blockIdx.x;
    unsigned long long prof_acc = 0;
#if MK_SINGLE
    volatile LAS unsigned* MISC = (volatile LAS unsigned*)(lds + MISC_OFF);
    if (threadIdx.x < 32) MISC[threadIdx.x] = 0u;
    __syncthreads();
    XcdBarrier bar = xcd_barrier_post((unsigned*)(args.ws + WS_CTL) + CW_BAR, MISC + 8);
#define GRID_BAR() xcd_barrier(bar)
#define PH(k) true
    const int s_lo = 0, s_hi = 8; const bool do_pro = true, do_fin = true;
#else
#define GRID_BAR() do {} while (0)
#define PH(k) (args.phase == (k))
    const int s_lo = args.step, s_hi = (args.step >= 0 && args.step < 8) ? args.step + 1 : args.step; const bool do_pro = args.step == -1, do_fin = args.step == 8;
#endif

    if (do_pro) {
        if (PH(0)) { for (int rep = 0; rep < REP_PRO; ++rep) { PHASE_VARS(); unsigned long long pt_ = 0; if constexpr (PROF_TAG == 110) pt_ = PROF_NOW(); prologue(args, lds, tid & 63, __builtin_amdgcn_readfirstlane(tid >> 6), bx, G); GRID_BAR(); if constexpr (PROF_TAG == 110) prof_acc += PROF_NOW() - pt_; } }
        if (PH(1)) {
            PHASE_VARS(); ShKV S{(const char*)(ws + WS_MB), (const char*)(ws + WS_WK), G, bx}; pg8::EpiPlain<false> E{(bf16_t*)(ws + WS_KV), 8 * D}; pg8::gemm_phase<pg8::EpiPlain<false>, true, 9>(lds, S, E, prof_acc); GRID_BAR(); }
        if (PH(2)) {
            { PHASE_VARS(); pg8::SchedG S{(const char*)(ws + WS_KV), (const char*)(ws + WS_WQN), G, bx}; pg8::EpiPlain<true> E{(bf16_t*)(ws + WS_GALL), D}; pg8::gemm_phase<pg8::EpiPlain<true>, true, 10>(lds, S, E, prof_acc); }
            { PHASE_VARS(); pg8::SchedH S{(const char*)(ws + WS_WO), (const char*)(ws + WS_KV), G, bx}; pg8::EpiPlain<false> E{(bf16_t*)(ws + WS_HALL), 4096}; pg8::gemm_phase<pg8::EpiPlain<false>, true, 10>(lds, S, E, prof_acc); }
        }
    }
#pragma unroll 1
    for (int s = s_lo; s < s_hi; ++s) {
        const int L = s >> 1, lw = s;
        if (PH(0)) for (int rep = 0; rep < REP_GU; ++rep) { PHASE_VARS(); ShGU S{(const char*)hb, (const char*)(ws + WS_WGU) + (size_t)lw * (2 * FF) * D * 2, G, bx};
            pg8::EpiSwiGLU E{(bf16_t*)(ws + WS_ACT), part, (LAS float*)(lds + EPI_TBL_OFF)};
            pg8::gemm_phase<pg8::EpiSwiGLU, true, 1>(lds, S, E, prof_acc); GRID_BAR(); }
        if (PH(1)) for (int rep = 0; rep < REP_DOWN; ++rep) { PHASE_VARS(); ShDown S{(const char*)(ws + WS_ACT), (const char*)(ws + WS_WD) + (size_t)lw * D * FF * 2, G, bx};
            pg8::EpiResid E{hb, part, 0.5f};
            pg8::gemm_phase<pg8::EpiResid, true, 2>(lds, S, E, prof_acc); GRID_BAR(); }
        if ((s & 1) == 0) {
            const int j = L >> 1;
            if ((L & 1) == 0) {
                if (PH(2)) for (int rep = 0; rep < REP_THIN; ++rep) { PHASE_VARS(); unsigned long long pt_ = 0; if constexpr (PROF_TAG == 120) pt_ = PROF_NOW(); bf16_t* pooled = (bf16_t*)(ws + WS_POOLED); LAS float* R = (LAS float*)lds;
                    for (int blk = bx; blk < M / 64; blk += G) { const int t0 = blk * 64, seq0 = (t0 / SEQ) * SEQ;
                        if (tid < 79) { const int row = t0 - 15 + tid; float rs = 0.f;
                            if (row >= seq0) { const f32x4* p = (const f32x4*)(part + (size_t)row * 32); float sacc = 0.f;
#pragma unroll
                                for (int q = 0; q < 8; ++q) { const f32x4 a = p[q]; sacc += (a[0] + a[1]) + (a[2] + a[3]); }
                                rs = rsqrtf(sacc * (1.0f / 2048.0f) + EPS); }
                            R[tid] = rs; }
                        __syncthreads();
                        const int w = 2 << (tid >> 7); const bf16_t* hc = hb + 4 * tid; f32x4 S4 = (f32x4){0.f, 0.f, 0.f, 0.f};
                        { u32x2 hk[15];
#pragma unroll
                          for (int i = 0; i < 15; ++i) { const int r = t0 - 15 + i; hk[i] = (i >= 16 - w && r >= seq0) ? *(const u32x2*)(hc + (size_t)r * D) : (u32x2){0u, 0u}; }
#pragma unroll
                          for (int i = 0; i < 15; ++i) S4 = S4 + f16x4_to_f32(hk[i]) * R[i]; }
                        u32x2 nb[2][8], ob[2][8];
#define POOL_LOAD(b) do { _Pragma("unroll") for (int i = 0; i < 8; ++i) { const int t_ = t0 + 8 * (b) + i, to_ = t_ - w; nb[(b) & 1][i] = *(const u32x2*)(hc + (size_t)t_ * D); \
                              ob[(b) & 1][i] = to_ >= seq0 ? *(const u32x2*)(hc + (size_t)to_ * D) : (u32x2){0u, 0u}; } } while (0)
                        POOL_LOAD(0);
#pragma unroll
                        for (int b = 0; b < 8; ++b) { if (b + 1 < 8) POOL_LOAD(b + 1);
                            asm volatile("" ::: "memory");
#pragma unroll
                            for (int i = 0; i < 8; ++i) { const int idx = 8 * b + i, t = t0 + idx, tt = t - seq0; const f32x4 uv = f16x4_to_f32(nb[b & 1][i]) * R[idx + 15]; S4 = S4 + uv;
                                if (idx > 0 && tt >= w) S4 = S4 - f16x4_to_f32(ob[b & 1][i]) * R[idx - w + 15];
                                const float ic = 1.0f / (float)(tt + 1 < w ? tt + 1 : w); const f32x4 o = S4 * ic - uv;
                                u32x2 pk; pk.x = cvt_pk_bf16(o[0], o[1]); pk.y = cvt_pk_bf16(o[2], o[3]); *(u32x2*)(pooled + (size_t)t * D + 4 * tid) = pk; }
                            asm volatile("" ::: "memory"); }
#undef POOL_LOAD
                        __syncthreads(); }
                    GRID_BAR(); if constexpr (PROF_TAG == 120) prof_acc += PROF_NOW() - pt_; }
                if (PH(3)) { PHASE_VARS(); ShPool S{(const char*)(ws + WS_POOLED), (const char*)(ws + WS_WP) + (size_t)j * D * 512 * 2, G, bx};
                    pg8::EpiResid E{hb, part, 1.0f};
                    pg8::gemm_phase<pg8::EpiResid, true, 3>(lds, S, E, prof_acc); GRID_BAR(); }
            } else {
                if (PH(2)) { PHASE_VARS(); ShLruIn S{(const char*)hb, (const char*)(ws + WS_WIN) + (size_t)j * 4096 * D * 2, G, bx};
                    pg8::EpiLruIn E{(bf16_t*)(ws + WS_GG), (bf16_t*)(ws + WS_XR), part, (LAS float*)(lds + EPI_TBL_OFF)};
                    pg8::gemm_phase<pg8::EpiLruIn, true, 4>(lds, S, E, prof_acc); GRID_BAR(); }
                if (PH(3)) for (int rep = 0; rep < REP_THIN; ++rep) { PHASE_VARS(); unsigned long long pt_ = 0; if constexpr (PROF_TAG == 130) pt_ = PROF_NOW(); const bf16_t* xr = (const bf16_t*)(ws + WS_XR); bf16_t* xcb = (bf16_t*)(ws + WS_XCB);
                    const float* cw = args.in[10] + (size_t)j * 4 * D + 4 * tid; const f32x4 w0 = *(const f32x4*)cw, w1 = *(const f32x4*)(cw + D), w2 = *(const f32x4*)(cw + 2 * D), w3 = *(const f32x4*)(cw + 3 * D);
                    const f32x4 cb = *(const f32x4*)(args.in[11] + (size_t)j * D + 4 * tid);
                    for (int blk = bx; blk < M / 64; blk += G) { const int t0 = blk * 64, seq0 = (t0 / SEQ) * SEQ; const bf16_t* xp = xr + 4 * tid; const f32x4 z = (f32x4){0.f, 0.f, 0.f, 0.f};
                        f32x4 x0 = z, x1 = z, x2 = z; if (t0 > seq0) { x0 = bf16x4_to_f32(*(const u32x2*)(xp + (size_t)(t0 - 3) * D)); x1 = bf16x4_to_f32(*(const u32x2*)(xp + (size_t)(t0 - 2) * D)); x2 = bf16x4_to_f32(*(const u32x2*)(xp + (size_t)(t0 - 1) * D)); }
                        u32x2 xb[2][16];
#define CONV_LOAD(b) do { _Pragma("unroll") for (int i = 0; i < 16; ++i) xb[(b) & 1][i] = *(const u32x2*)(xp + (size_t)(t0 + 16 * (b) + i) * D); } while (0)
                        CONV_LOAD(0);
#pragma unroll
                        for (int b = 0; b < 4; ++b) { if (b + 1 < 4) CONV_LOAD(b + 1);
                            asm volatile("" ::: "memory");
#pragma unroll
                            for (int i = 0; i < 16; ++i) { const int t = t0 + 16 * b + i; const f32x4 x3 = bf16x4_to_f32(xb[b & 1][i]); const f32x4 o = cb + x0 * w0 + x1 * w1 + x2 * w2 + x3 * w3;
                                u32x2 pk; pk.x = cvt_pk_bf16(o[0], o[1]); pk.y = cvt_pk_bf16(o[2], o[3]); *(u32x2*)(xcb + (size_t)t * D + 4 * tid) = pk;
                                x0 = x1; x1 = x2; x2 = x3; }
                            asm volatile("" ::: "memory"); }
#undef CONV_LOAD
                    }
                    GRID_BAR(); if constexpr (PROF_TAG == 130) prof_acc += PROF_NOW() - pt_; }
                if (PH(4)) { PHASE_VARS(); ShGates S{(const char*)(ws + WS_XCB), (const char*)(ws + WS_WGATE) + (size_t)j * 4096 * 256 * 2, G, bx};
                    pg8::EpiGates E{(bf16_t*)(ws + WS_LA), (bf16_t*)(ws + WS_BT), (const bf16_t*)(ws + WS_XCB), args.in[13] + (size_t)j * D, args.in[15] + (size_t)j * D, (const float*)(ws + WS_SP) + (size_t)j * D};
                    pg8::gemm_phase<pg8::EpiGates, true, 5>(lds, S, E, prof_acc); GRID_BAR(); }
#define EXP2_4(v) ((f32x4){__builtin_amdgcn_exp2f((v)[0]), __builtin_amdgcn_exp2f((v)[1]), __builtin_amdgcn_exp2f((v)[2]), __builtin_amdgcn_exp2f((v)[3])})
                if (PH(5)) for (int rep = 0; rep < REP_THIN; ++rep) { PHASE_VARS(); unsigned long long pt_ = 0; if constexpr (PROF_TAG == 140) pt_ = PROF_NOW(); const bf16_t* lav = (const bf16_t*)(ws + WS_LA) + 4 * tid; const bf16_t* bv = (const bf16_t*)(ws + WS_BT) + 4 * tid; float* chA = (float*)(ws + WS_CHA); float* chB = (float*)(ws + WS_CHB);
                    for (int blk = bx; blk < M / 64; blk += G) { const int t0 = blk * 64; f32x4 Ls = (f32x4){0.f, 0.f, 0.f, 0.f}, Hs = (f32x4){0.f, 0.f, 0.f, 0.f};
                        u32x2 lb[2][8], bb[2][8];
#define SC1_LOAD(b) do { _Pragma("unroll") for (int i = 0; i < 8; ++i) { const size_t o_ = (size_t)(t0 + 8 * (b) + i) * D; lb[(b) & 1][i] = *(const u32x2*)(lav + o_); bb[(b) & 1][i] = *(const u32x2*)(bv + o_); } } while (0)
                        SC1_LOAD(0);
#pragma unroll
                        for (int b = 0; b < 8; ++b) { if (b + 1 < 8) SC1_LOAD(b + 1);
                            asm volatile("" ::: "memory");
#pragma unroll
                            for (int i = 0; i < 8; ++i) { const f32x4 l4 = bf16x4_to_f32(lb[b & 1][i]), b4 = bf16x4_to_f32(bb[b & 1][i]); const f32x4 a4 = EXP2_4(l4); Hs = a4 * Hs + b4; Ls = Ls + l4; } }
#undef SC1_LOAD
                        *(f32x4*)(chA + (size_t)blk * D + 4 * tid) = EXP2_4(Ls); *(f32x4*)(chB + (size_t)blk * D + 4 * tid) = Hs; }
                    GRID_BAR(); if constexpr (PROF_TAG == 140) prof_acc += PROF_NOW() - pt_; }
                if (PH(6)) for (int rep = 0; rep < REP_THIN; ++rep) { PHASE_VARS(); unsigned long long pt_ = 0; if constexpr (PROF_TAG == 150) pt_ = PROF_NOW(); const bf16_t* lav = (const bf16_t*)(ws + WS_LA) + 4 * tid; const bf16_t* bv = (const bf16_t*)(ws + WS_BT) + 4 * tid;
                    const float* chA = (const float*)(ws + WS_CHA) + 4 * tid; const float* chB = (const float*)(ws + WS_CHB) + 4 * tid; const bf16_t* gg = (const bf16_t*)(ws + WS_GG) + 4 * tid; bf16_t* yb = (bf16_t*)(ws + WS_XCB) + 4 * tid;
                    for (int blk = bx; blk < M / 64; blk += G) { const int t0 = blk * 64, c0 = (blk / 64) * 64; f32x4 Hs = (f32x4){0.f, 0.f, 0.f, 0.f};
                        u32x2 lb[2][8], bb[2][8], gb[2][8];
#define SC2_LOAD(b) do { _Pragma("unroll") for (int i = 0; i < 8; ++i) { const size_t o_ = (size_t)(t0 + 8 * (b) + i) * D; lb[(b) & 1][i] = *(const u32x2*)(lav + o_); bb[(b) & 1][i] = *(const u32x2*)(bv + o_); gb[(b) & 1][i] = *(const u32x2*)(gg + o_); } } while (0)
                        SC2_LOAD(0);
                        int c = c0;
                        for (; c + 8 <= blk; c += 8) { f32x4 ca[8], cb8[8];
#pragma unroll
                            for (int i = 0; i < 8; ++i) { ca[i] = *(const f32x4*)(chA + (size_t)(c + i) * D); cb8[i] = *(const f32x4*)(chB + (size_t)(c + i) * D); }
#pragma unroll
                            for (int i = 0; i < 8; ++i) Hs = ca[i] * Hs + cb8[i]; }
                        for (; c < blk; ++c) { const f32x4 a4 = *(const f32x4*)(chA + (size_t)c * D), b4 = *(const f32x4*)(chB + (size_t)c * D); Hs = a4 * Hs + b4; }
#pragma unroll
                        for (int b = 0; b < 8; ++b) { if (b + 1 < 8) SC2_LOAD(b + 1);
                            asm volatile("" ::: "memory");
#pragma unroll
                            for (int i = 0; i < 8; ++i) { const int t = t0 + 8 * b + i; const f32x4 l4 = bf16x4_to_f32(lb[b & 1][i]), b4 = bf16x4_to_f32(bb[b & 1][i]), g4 = bf16x4_to_f32(gb[b & 1][i]); const f32x4 a4 = EXP2_4(l4); Hs = a4 * Hs + b4;
                                u32x2 pk; pk.x = cvt_pk_bf16(Hs[0] * g4[0], Hs[1] * g4[1]); pk.y = cvt_pk_bf16(Hs[2] * g4[2], Hs[3] * g4[3]); *(u32x2*)(yb + (size_t)t * D) = pk; }
                            asm volatile("" ::: "memory"); }
#undef SC2_LOAD
                    }
                    GRID_BAR(); if constexpr (PROF_TAG == 150) prof_acc += PROF_NOW() - pt_; }
#undef EXP2_4
                if (PH(7)) { PHASE_VARS(); ShDD S{(const char*)(ws + WS_XCB), (const char*)(ws + WS_WOUT) + (size_t)j * D * D * 2, G, bx};
                    pg8::EpiResid E{hb, part, 1.0f};
                    pg8::gemm_phase<pg8::EpiResid, true, 6>(lds, S, E, prof_acc); GRID_BAR(); }
            }
            if (PH(8)) { PHASE_VARS(); ShScore S{(const char*)hb, (const char*)(ws + WS_GALL) + (size_t)L * 4096 * D * 2, G, bx};
                pg8::EpiSoftmax E{(bf16_t*)(ws + WS_P), part};
                pg8::gemm_phase<pg8::EpiSoftmax, false, 7>(lds, S, E, prof_acc); GRID_BAR(); }
            if (PH(9)) for (int rep = 0; rep < REP_RES2K; ++rep) { PHASE_VARS(); ShAO S{(const char*)(ws + WS_P), (const char*)(ws + WS_HALL) + (size_t)L * D * 4096 * 2, G, bx};
                pg8::EpiResid E{hb, part, 1.0f};
                pg8::gemm_phase<pg8::EpiResid, true, 8>(lds, S, E, prof_acc); GRID_BAR(); }
        }
    }
    if (do_fin) { unsigned long long pt_ = 0; if constexpr (PROF_TAG == 160) pt_ = PROF_NOW(); PHASE_VARS(); float* h = (float*)(GAS float*)launder_u64((unsigned long long)args.out); const float* g = args.in[24]; const int lane = tid & 63, gw = bx * 8 + (tid >> 6), NGW = G * 8;
        f32x4 gv[8];
#pragma unroll
        for (int jj = 0; jj < 8; ++jj) gv[jj] = *((const f32x4*)g + lane + 64 * jj);
        for (int row0 = gw; row0 < M; row0 += 8 * NGW) { u32x2 pk[8][8];
#pragma unroll
            for (int r = 0; r < 8; ++r) { const int row = row0 + r * NGW; if (row < M) { const u32x2* br = (const u32x2*)(hb + (size_t)row * D) + lane;
#pragma unroll
                for (int jj = 0; jj < 8; ++jj) pk[r][jj] = br[64 * jj]; } }
#pragma unroll
            for (int r = 0; r < 8; ++r) { const int row = row0 + r * NGW; if (row < M) { f32x4* orow = (f32x4*)(h + (size_t)row * D) + lane; f32x4 v[8]; float ss = 0.f;
#pragma unroll
                for (int jj = 0; jj < 8; ++jj) { v[jj] = f16x4_to_f32(pk[r][jj]);
                    ss += (v[jj][0] * v[jj][0] + v[jj][1] * v[jj][1]) + (v[jj][2] * v[jj][2] + v[jj][3] * v[jj][3]); }
                const float rs = rsqrtf(wave_sum(ss) * (1.0f / 2048.0f) + EPS);
#pragma unroll
                for (int jj = 0; jj < 8; ++jj) orow[64 * jj] = v[jj] * rs * gv[jj]; } } }
        if constexpr (PROF_TAG == 160) { VM_WAIT(); prof_acc += PROF_NOW() - pt_; } }
    if constexpr (PROF_TAG != 0) { const unsigned long long t0 = PROF_NOW(); while (PROF_NOW() - t0 < prof_acc) __builtin_amdgcn_s_sleep(4); }
}

extern "C" void kernel_launch(void* const* d_in, const int* in_sizes, int n_in, void* d_out, int out_size, void* d_ws, size_t ws_size, hipStream_t stream) {
    static int grid = 0;
    if (grid == 0) {
        if (n_in != 25 || in_sizes[0] != M * D || out_size != M * D || ws_size < WS_END) { fprintf(stderr, "kernel_launch: unexpected shapes (n_in %d, in0 %d, out %d, ws %zu, need %zu); nothing launched\n", n_in, n_in > 0 ? in_sizes[0] : -1, out_size, ws_size, (size_t)WS_END); grid = -1; return; }
        int dev = 0, cus = 0, per_cu = 0;
        if (hipGetDevice(&dev) != hipSuccess || hipDeviceGetAttribute(&cus, hipDeviceAttributeMultiprocessorCount, dev) != hipSuccess) { fprintf(stderr, "kernel_launch: device query failed\n"); grid = -1; return; }
        if (hipFuncSetAttribute((const void*)mk_fwd, hipFuncAttributeMaxDynamicSharedMemorySize, LDS_BYTES) != hipSuccess) { fprintf(stderr, "kernel_launch: hipFuncSetAttribute failed\n"); grid = -1; return; }
        if (hipOccupancyMaxActiveBlocksPerMultiprocessor(&per_cu, (const void*)mk_fwd, 512, LDS_BYTES) != hipSuccess || per_cu < 1) fprintf(stderr, "kernel_launch: occupancy query says %d\n", per_cu);
        (void)hipGetLastError();
        grid = cus;
        if (grid != 256) { fprintf(stderr, "kernel_launch: built for 256 CUs, found %d; nothing launched\n", cus); grid = -1; return; }
    }
    if (grid < 0) return;
    Args a{};
    for (int i = 0; i < 25; ++i) a.in[i] = (const float*)d_in[i];
    a.out = (float*)d_out; a.ws = (unsigned char*)d_ws;
#if MK_SINGLE
    if (hipMemsetAsync((char*)d_ws + WS_CTL, 0, CTL_ZERO_BYTES, stream) != hipSuccess) { fprintf(stderr, "kernel_launch: memset failed\n"); return; }
    a.step = 0; a.phase = 0;
    hipLaunchKernelGGL(mk_fwd, dim3(grid), dim3(512), LDS_BYTES, stream, a);
#else
    auto launch = [&](int s, int p) { a.step = s; a.phase = p; hipLaunchKernelGGL(mk_fwd, dim3(grid), dim3(512), LDS_BYTES, stream, a); };
    launch(-1, 0); launch(-1, 1); launch(-1, 2);
    for (int s = 0; s < 8; ++s) { launch(s, 0); launch(s, 1);
        if ((s & 1) == 0) { const int L = s >> 1;
            if ((L & 1) == 0) { launch(s, 2); launch(s, 3); } else { for (int p = 2; p <= 7; ++p) launch(s, p); }
            for (int p = 8; p <= 9; ++p) launch(s, p); } }
    launch(8, 0);
#endif
    const hipError_t le = hipPeekAtLastError();
    if (le != hipSuccess) fprintf(stderr, "kernel_launch: launch failed: %s\n", hipGetErrorName(le));
}
```
